# Optimizing an MI355X kernel written in HIP

```python
import jax, jax.numpy as jnp
from jax import lax
import numpy as np

D_MODEL = 2048
BATCH = 8
SEQ = 2048
DEPTH = 1

MEM_LEN = 256
POOL_WINDOWS = (2, 4, 8, 16)
N_POOL_GROUPS = 4
POOL_GROUP_DIM = D_MODEL // 8
POOL_WIDTH = N_POOL_GROUPS * POOL_GROUP_DIM
N_FOURIER_GROUPS = 4
FOURIER_GROUP_DIM = D_MODEL // 16
FOURIER_WIDTH = N_FOURIER_GROUPS * FOURIER_GROUP_DIM
N_MEM_HEADS = 4
MEM_HEAD_DIM = D_MODEL // 16
MEM_WIDTH = N_MEM_HEADS * MEM_HEAD_DIM
MIX_WIDTH = POOL_WIDTH + FOURIER_WIDTH + MEM_WIDTH
N_BRANCHES = 3
IN_WIDTH = MIX_WIDTH + N_BRANCHES * D_MODEL
N_EXPERTS = 16
CAPACITY_FACTOR = 2
D_EXPERT = D_MODEL
EPS = 1e-6

kernel_name = "hybrid_pool_fourier_memattn_ecmoe_block"


def _rmsnorm(x, g):
    x32 = x.astype(jnp.float32)
    inv = lax.rsqrt(jnp.mean(x32 * x32, axis=-1, keepdims=True) + EPS)
    return (x32 * inv).astype(x.dtype) * g


def _centred_mean_minus_self(u, window):
    S = u.shape[1]
    u32 = u.astype(jnp.float32)
    csum = jnp.concatenate([jnp.zeros_like(u32[:, :1]), jnp.cumsum(u32, axis=1)], axis=1)
    pos = jnp.arange(S)
    lo = jnp.clip(pos - window // 2, 0, S)
    hi = jnp.clip(pos + window - window // 2, 0, S)
    total = jnp.take(csum, hi, axis=1) - jnp.take(csum, lo, axis=1)
    count = (hi - lo).astype(jnp.float32)[None, :, None]
    return (total / count - u32).astype(u.dtype)


def _fourier_2d_real(u):
    spec = jnp.fft.fft2(u.astype(jnp.float32), axes=(1, 3), norm="ortho")
    return spec.real.astype(u.dtype)


def _mixing_sublayer(x, mem, norm_mix_g, norm_mem_g, w_in, pool_w, pool_scale, fourier_w,
                     w_kv_mem, proj_pool, proj_fourier, proj_mem, w_out):
    B, S, D = x.shape
    h = _rmsnorm(x, norm_mix_g)
    z = h @ w_in
    u_pool = z[..., :POOL_WIDTH]
    u_four = z[..., POOL_WIDTH:POOL_WIDTH + FOURIER_WIDTH]
    q = z[..., POOL_WIDTH + FOURIER_WIDTH:MIX_WIDTH]
    gate_pre = z[..., MIX_WIDTH:]

    u_pool = u_pool.reshape(B, S, N_POOL_GROUPS, POOL_GROUP_DIM)
    pooled = jnp.stack([_centred_mean_minus_self(u_pool[:, :, g], w)
                        for g, w in enumerate(POOL_WINDOWS)], axis=2)
    y_a = jnp.einsum('bsgc,gcd->bsgd', pooled, pool_w).reshape(B, S, POOL_WIDTH) * pool_scale
    y_a = y_a @ proj_pool

    u_four = u_four.reshape(B, S, N_FOURIER_GROUPS, FOURIER_GROUP_DIM)
    f = _fourier_2d_real(u_four)
    y_b = jnp.einsum('bsgc,gcd->bsgd', f, fourier_w).reshape(B, S, FOURIER_WIDTH)
    y_b = y_b @ proj_fourier

    mem_n = _rmsnorm(mem, norm_mem_g)
    kv = mem_n @ w_kv_mem
    M = mem.shape[1]
    k = kv[..., :MEM_WIDTH].reshape(B, M, N_MEM_HEADS, MEM_HEAD_DIM)
    v = kv[..., MEM_WIDTH:].reshape(B, M, N_MEM_HEADS, MEM_HEAD_DIM)
    qh = q.reshape(B, S, N_MEM_HEADS, MEM_HEAD_DIM)
    scores = jnp.einsum('bshd,bmhd->bhsm', qh, k).astype(jnp.float32) * (MEM_HEAD_DIM ** -0.5)
    probs = jax.nn.softmax(scores, axis=-1).astype(v.dtype)
    o = jnp.einsum('bhsm,bmhd->bshd', probs, v).reshape(B, S, MEM_WIDTH)
    y_c = o @ proj_mem

    gates = jax.nn.sigmoid(gate_pre.astype(jnp.float32)).astype(x.dtype).reshape(B, S, N_BRANCHES, D)
    merged = gates[:, :, 0] * y_a + gates[:, :, 1] * y_b + gates[:, :, 2] * y_c
    return merged @ w_out


def _expert_choice_moe(h, w_router, w_expert_gate, w_expert_up, w_expert_down):
    B, S, D = h.shape
    affinity = jax.nn.softmax((h @ w_router).astype(jnp.float32), axis=-1)
    capacity = CAPACITY_FACTOR * S // N_EXPERTS
    top_aff, top_idx = lax.top_k(jnp.swapaxes(affinity, 1, 2), capacity)
    xin = jax.vmap(lambda hb, ib: hb[ib])(h, top_idx)
    hidden = jax.nn.silu(jnp.einsum('becd,edf->becf', xin, w_expert_gate)) * \
        jnp.einsum('becd,edf->becf', xin, w_expert_up)
    y = jnp.einsum('becf,efd->becd', hidden, w_expert_down) * top_aff[..., None].astype(h.dtype)
    return jax.vmap(lambda yb, ib: jnp.zeros((S, D), yb.dtype).at[ib.reshape(-1)].add(yb.reshape(-1, D)))(y, top_idx)


def setup_inputs(seed: int = 0) -> dict:
    key = jax.random.key(seed)
    ks = jax.random.split(key, 20)
    L, D, E, F = DEPTH, D_MODEL, N_EXPERTS, D_EXPERT
    nrm = lambda k, shape, fan_in: jax.random.normal(k, shape, jnp.float32) * (fan_in ** -0.5)
    gain = lambda k, shape: 1.0 + 0.02 * jax.random.normal(k, shape, jnp.float32)
    return {
        "x": jax.random.normal(ks[0], (BATCH, SEQ, D), jnp.float32),
        "mem": jax.random.normal(ks[1], (BATCH, MEM_LEN, D), jnp.float32),
        "norm_mix_g": gain(ks[2], (L, D)),
        "norm_mem_g": gain(ks[3], (L, D)),
        "w_in": nrm(ks[4], (L, D, IN_WIDTH), D),
        "pool_w": nrm(ks[5], (L, N_POOL_GROUPS, POOL_GROUP_DIM, POOL_GROUP_DIM), POOL_GROUP_DIM),
        "pool_scale": gain(ks[6], (L, POOL_WIDTH)),
        "fourier_w": nrm(ks[7], (L, N_FOURIER_GROUPS, FOURIER_GROUP_DIM, FOURIER_GROUP_DIM), FOURIER_GROUP_DIM),
        "w_kv_mem": nrm(ks[8], (L, D, 2 * MEM_WIDTH), D),
        "proj_pool": nrm(ks[9], (L, POOL_WIDTH, D), POOL_WIDTH),
        "proj_fourier": nrm(ks[10], (L, FOURIER_WIDTH, D), FOURIER_WIDTH),
        "proj_mem": nrm(ks[11], (L, MEM_WIDTH, D), MEM_WIDTH),
        "w_out": nrm(ks[12], (L, D, D), D),
        "norm_ffn_g": gain(ks[13], (L, D)),
        "w_router": nrm(ks[14], (L, D, E), D),
        "w_expert_gate": nrm(ks[15], (L, E, D, F), D),
        "w_expert_up": nrm(ks[16], (L, E, D, F), D),
        "w_expert_down": nrm(ks[17], (L, E, F, D), F),
        "norm_final_g": gain(ks[18], (D,)),
    }


def reference(x, mem, norm_mix_g, norm_mem_g, w_in, pool_w, pool_scale, fourier_w, w_kv_mem,
              proj_pool, proj_fourier, proj_mem, w_out, norm_ffn_g, w_router, w_expert_gate,
              w_expert_up, w_expert_down, norm_final_g):
    for l in range(DEPTH):
        x = x + _mixing_sublayer(x, mem, norm_mix_g[l], norm_mem_g[l], w_in[l], pool_w[l],
                                 pool_scale[l], fourier_w[l], w_kv_mem[l], proj_pool[l],
                                 proj_fourier[l], proj_mem[l], w_out[l])
        h2 = _rmsnorm(x, norm_ffn_g[l])
        x = x + _expert_choice_moe(h2, w_router[l], w_expert_gate[l], w_expert_up[l], w_expert_down[l])
    return _rmsnorm(x, norm_final_g)
```

```cpp
#include <hip/hip_runtime.h>
#include <hip/hip_cooperative_groups.h>
#include <cstdio>
#include <cstdint>
namespace cg = cooperative_groups;

#ifndef MK_MULTI_LAUNCH
#define MK_MULTI_LAUNCH 0
#endif

#ifndef DBG_P5_FROM_XN
#define DBG_P5_FROM_XN 0
#endif
#ifndef DBG_ONLY_BRANCH
#define DBG_ONLY_BRANCH -1
#endif
#ifndef DBG_SKIP_MOE
#define DBG_SKIP_MOE 0
#endif
#define LAS __attribute__((address_space(3)))
#define GAS __attribute__((address_space(1)))
typedef unsigned short bf16_t;
typedef short bf16x8 __attribute__((ext_vector_type(8)));
typedef short s16x4 __attribute__((ext_vector_type(4)));
typedef float f32x2 __attribute__((ext_vector_type(2)));
typedef float f32x4 __attribute__((ext_vector_type(4)));
typedef float f32x16 __attribute__((ext_vector_type(16)));
typedef unsigned u32x2 __attribute__((ext_vector_type(2)));
typedef unsigned u32x4 __attribute__((ext_vector_type(4)));

constexpr int T = 16384, DM = 2048, NBATCH = 8, SEQ = 2048, MEML = 256;
constexpr int NE = 16, CAP = 256;
constexpr float EPS = 1e-6f;
constexpr int NWAVES = 8, NTHR = 512;
constexpr int NPH = 11;

constexpr size_t MiB = 1u << 20;
constexpr size_t WS_CTL  = 0;
constexpr size_t WS_WINT = 1 * MiB;
constexpr size_t WS_WKVT = 33 * MiB;
constexpr size_t WS_PPST = 37 * MiB;
constexpr size_t WS_PFT  = 41 * MiB;
constexpr size_t WS_PWBD = 45 * MiB;
constexpr size_t WS_M1BD = 47 * MiB;
constexpr size_t WS_BCAT = 49 * MiB;
constexpr size_t WS_WOT  = 59 * MiB;
constexpr size_t WS_TW   = 67 * MiB;
constexpr size_t WS_WGUT = 83 * MiB;
constexpr size_t WS_WDT  = 339 * MiB;
constexpr size_t WS_ACT  = 467 * MiB;
constexpr size_t WS_XN   = WS_ACT;
constexpr size_t WS_MN   = WS_ACT + 64 * MiB;
constexpr size_t WS_ZM   = WS_ACT + 72 * MiB;
constexpr size_t WS_G    = WS_ACT + 136 * MiB;
constexpr size_t WS_UT   = WS_ACT + 328 * MiB;
constexpr size_t WS_KMEM = WS_ACT + 344 * MiB;
constexpr size_t WS_VT   = WS_ACT + 346 * MiB;
constexpr size_t WS_ACAT = WS_ACT + 348 * MiB;
constexpr size_t WS_MG   = WS_ACT + 428 * MiB;
constexpr size_t WS_H2   = WS_ACT;
constexpr size_t WS_XIN  = WS_ACT + 64 * MiB;
constexpr size_t WS_HID  = WS_ACT + 192 * MiB;
constexpr size_t WS_AFF  = WS_ACT + 320 * MiB;
constexpr size_t WS_SELW = WS_ACT + 321 * MiB;
constexpr size_t WS_INV  = WS_ACT + 322 * MiB;
constexpr size_t WS_END  = WS_ACT + 492 * MiB;

constexpr int LDS_BYTES = 147456;

#define LDS_WAIT() asm volatile("s_waitcnt lgkmcnt(0)" ::: "memory")
#define VM_WAIT() asm volatile("s_waitcnt vmcnt(0)" ::: "memory")
__device__ __forceinline__ unsigned f2bf(float f) { unsigned u = __builtin_bit_cast(unsigned, f); return (u + 0x7fffu + ((u >> 16) & 1u)) >> 16; }
__device__ __forceinline__ unsigned pk2(float lo, float hi) { return f2bf(lo) | (f2bf(hi) << 16); }
typedef __bf16 bf16x2_t __attribute__((ext_vector_type(2)));
__device__ __forceinline__ unsigned cvt_pk_bf16(float lo, float hi) { const bf16x2_t v = __builtin_convertvector((f32x2){lo, hi}, bf16x2_t); return __builtin_bit_cast(unsigned, v); }
__device__ __forceinline__ float bf_lo(unsigned w) { return __builtin_bit_cast(float, w << 16); }
__device__ __forceinline__ float bf_hi(unsigned w) { return __builtin_bit_cast(float, w & 0xffff0000u); }
__device__ __forceinline__ float wave_sum(float v) {
#pragma unroll
    for (int o = 1; o < 64; o <<= 1) v += __shfl_xor(v, o);
    return v;
}
__device__ __forceinline__ float fast_sigmoid(float v) { return __builtin_amdgcn_rcpf(1.0f + __builtin_amdgcn_exp2f(-1.44269504089f * v)); }

namespace pg8 {
constexpr int BM = 256, BK = 64, HALF = 128, HTB = HALF * BK * 2, STAGE_BYTES = 8 * HTB;
__device__ __forceinline__ int lds_byte(int r, int c) { const int st = (r >> 4) * 2 + (c >> 5), rr = r & 15, cc = c & 31, ob = rr * 64 + cc * 2; return st * 1024 + (ob ^ (((ob >> 9) & 1) << 5)); }
__device__ __forceinline__ void stage_rc(int b, int& R, int& C) { const int st = b / 1024, sb = b % 1024, swz = sb ^ (((sb >> 9) & 1) << 5); R = (st >> 1) * 16 + swz / 64; C = (st & 1) * 32 + (swz % 64) / 2; }
__device__ __forceinline__ int perm32(int rho) { const int n = rho >> 4, i = rho & 15; return 8 * (i >> 2) + 4 * n + (i & 3); }

struct Unit { const char* A; const char* B0; const char* B1; int nt; int r0, c0, aux; };

__device__ __forceinline__ void tile_order(int L, int nM, int nN, int& pm, int& pn) {
    const int nwg = nM * nN;
    int wgid = L; { const int q = nwg / 8, r = nwg % 8, xcd = wgid % 8, off = wgid / 8; wgid = (xcd < r ? xcd * (q + 1) : r * (q + 1) + (xcd - r) * q) + off; }
    const int nig = 8 * nN, gid = wgid / nig, fm = gid * 8, gsz = (nM - fm) < 8 ? (nM - fm) : 8;
    pm = fm + ((wgid % nig) % gsz); pn = (wgid % nig) / gsz;
}

template <class Epi, class Sched>
__device__ __forceinline__ void gemm_phase(LAS unsigned char* lds, const int lda, const int ldb, const Sched& S, const Epi& E) {
    const int tid = threadIdx.x, wid = __builtin_amdgcn_readfirstlane(tid >> 6), lane = tid & 63, wr = wid >> 2, wc = wid & 3, fr = lane & 15, fq = lane >> 4;
    unsigned voffA[2], voffB[2];
#pragma unroll
    for (int i = 0; i < 2; ++i) { int R, C; stage_rc(tid * 16 + i * 8192, R, C); const int Rb = (R & ~31) + perm32(R & 31);
        voffA[i] = (unsigned)(R * lda + C) * 2u; voffB[i] = (unsigned)(Rb * ldb + C) * 2u; }
    const size_t kstep = (size_t)(BK * 2);
    const size_t hstepA = (size_t)HALF * lda * 2;
    const unsigned ldsw = (unsigned)wid * 1024u;
    const int aoff = lds_byte(wr * 64 + fr, fq * 8), boff = lds_byte(wc * 32 + fr, fq * 8);
#define PG8_SA(b, h) (((b) * 2 + (h)) * HTB)
#define PG8_SB(b, h) ((4 + (b) * 2 + (h)) * HTB)
#define PG8_STAGE(bufoff, gbase, voff) do { _Pragma("unroll") for (int _i = 0; _i < 2; ++_i) \
        __builtin_amdgcn_global_load_lds((const unsigned*)((const char*)(gbase) + (voff)[_i]), (LAS unsigned*)(lds + (bufoff) + ldsw + _i * 8192), 16, 0, 0); } while (0)
#define PG8_LDA(dst, b, h) do { _Pragma("unroll") for (int m = 0; m < 4; ++m) _Pragma("unroll") for (int k = 0; k < 2; ++k) dst[m][k] = *(const LAS bf16x8*)(lds + PG8_SA(b, h) + aoff + m * 2048 + k * 1024); } while (0)
#define PG8_LDB(dst, b, h) do { _Pragma("unroll") for (int n = 0; n < 2; ++n) _Pragma("unroll") for (int k = 0; k < 2; ++k) dst[n][k] = *(const LAS bf16x8*)(lds + PG8_SB(b, h) + boff + n * 2048 + k * 1024); } while (0)
#define PG8_MMA(ai, bj, At, Bt) do { __builtin_amdgcn_s_setprio(1); _Pragma("unroll") for (int m = 0; m < 4; ++m) _Pragma("unroll") for (int n = 0; n < 2; ++n) _Pragma("unroll") for (int k = 0; k < 2; ++k) \
        acc[ai][bj][m][n] = __builtin_amdgcn_mfma_f32_16x16x32_bf16(Bt[n][k], At[m][k], acc[ai][bj][m][n], 0, 0, 0); __builtin_amdgcn_s_setprio(0); } while (0)
#define PG8_WAIT_V(n) asm volatile("s_waitcnt vmcnt(" #n ")" ::: "memory")
#define PG8_WAIT_L(n) asm volatile("s_waitcnt lgkmcnt(" #n ")" ::: "memory")
#define PG8_BAR __builtin_amdgcn_s_barrier()
#define PG8_SCHED __builtin_amdgcn_sched_barrier(0)
    Unit cur, nxt; int ui = 0;
    if (!S.next(0, cur)) return;
    f32x4 acc[2][2][4][2];
#pragma unroll
    for (int a = 0; a < 2; ++a)
#pragma unroll
        for (int b = 0; b < 2; ++b)
#pragma unroll
            for (int m = 0; m < 4; ++m)
#pragma unroll
                for (int n = 0; n < 2; ++n) acc[a][b][m][n] = (f32x4){0.f, 0.f, 0.f, 0.f};
    bf16x8 At[4][2], B0[2][2], B1[2][2];
    const char* cA = cur.A; const char* cB0 = cur.B0; const char* cB1 = cur.B1;
    PG8_STAGE(PG8_SB(0, 0), cB0, voffB); PG8_STAGE(PG8_SB(0, 1), cB1, voffB); PG8_STAGE(PG8_SA(0, 0), cA, voffA); PG8_STAGE(PG8_SA(0, 1), cA + hstepA, voffA);
    if (wr == 1) PG8_BAR;
    PG8_WAIT_V(2); PG8_BAR;
    PG8_STAGE(PG8_SB(1, 0), cB0 + kstep, voffB); PG8_STAGE(PG8_SA(1, 0), cA + kstep, voffA); PG8_STAGE(PG8_SB(1, 1), cB1 + kstep, voffB);
    PG8_WAIT_V(6); PG8_BAR;
    for (;;) {
        const bool has_next = S.next(ui + 1, nxt);
        const char* nA = has_next ? nxt.A : cA; const char* nB0 = has_next ? nxt.B0 : cB0; const char* nB1 = has_next ? nxt.B1 : cB1;
        const int nt = cur.nt;
        for (int t = 0; t < nt; t += 2) {
            const bool last = (t == nt - 2);
            const char* a1 = cA + (size_t)(t + 1) * kstep;
            const char* a2 = last ? nA : cA + (size_t)(t + 2) * kstep;
            const char* b20 = last ? nB0 : cB0 + (size_t)(t + 2) * kstep; const char* b21 = last ? nB1 : cB1 + (size_t)(t + 2) * kstep;
            const char* a3 = a2 + kstep; const char* b30 = b20 + kstep; const char* b31 = b21 + kstep;
            PG8_LDB(B0, 0, 0); PG8_LDB(B1, 0, 1); PG8_SCHED; PG8_LDA(At, 0, 0); PG8_STAGE(PG8_SA(1, 1), a1 + hstepA, voffA);
            PG8_WAIT_V(8); PG8_WAIT_L(0); PG8_BAR; PG8_MMA(0, 0, At, B0); PG8_MMA(0, 1, At, B1); PG8_BAR; PG8_SCHED;
            PG8_LDA(At, 0, 1); PG8_STAGE(PG8_SB(0, 0), b20, voffB); PG8_STAGE(PG8_SB(0, 1), b21, voffB); PG8_STAGE(PG8_SA(0, 0), a2, voffA);
            PG8_WAIT_V(8); PG8_WAIT_L(0); PG8_BAR; PG8_MMA(1, 0, At, B0); PG8_MMA(1, 1, At, B1); PG8_BAR; PG8_SCHED;
            PG8_LDB(B0, 1, 0); PG8_LDB(B1, 1, 1); PG8_SCHED; PG8_LDA(At, 1, 0); PG8_STAGE(PG8_SA(0, 1), a2 + hstepA, voffA);
            PG8_WAIT_V(8); PG8_WAIT_L(0); PG8_BAR; PG8_MMA(0, 0, At, B0); PG8_MMA(0, 1, At, B1); PG8_BAR; PG8_SCHED;
            PG8_LDA(At, 1, 1); PG8_STAGE(PG8_SB(1, 0), b30, voffB); PG8_STAGE(PG8_SB(1, 1), b31, voffB); PG8_STAGE(PG8_SA(1, 0), a3, voffA);
            PG8_WAIT_V(8); PG8_WAIT_L(0); PG8_BAR; PG8_MMA(1, 0, At, B0); PG8_MMA(1, 1, At, B1); PG8_BAR; PG8_SCHED;
        }
        if (wr == 0) PG8_BAR;
        E(acc, cur, wr, wc, fr, fq);
        if (!has_next) break;
#pragma unroll
        for (int a = 0; a < 2; ++a)
#pragma unroll
            for (int b = 0; b < 2; ++b)
#pragma unroll
                for (int m = 0; m < 4; ++m)
#pragma unroll
                    for (int n = 0; n < 2; ++n) acc[a][b][m][n] = (f32x4){0.f, 0.f, 0.f, 0.f};
        cur = nxt; cA = nA; cB0 = nB0; cB1 = nB1; ++ui;
        if (wr == 1) PG8_BAR;
    }
    PG8_WAIT_V(0);
    PG8_BAR;
#undef PG8_SA
#undef PG8_SB
#undef PG8_STAGE
#undef PG8_LDA
#undef PG8_LDB
#undef PG8_MMA
#undef PG8_WAIT_V
#undef PG8_WAIT_L
#undef PG8_BAR
#undef PG8_SCHED
}

struct EpiBf16 {
    bf16_t* O; int ldc; const float* rowscale;
    __device__ __forceinline__ void operator()(const f32x4 (&acc)[2][2][4][2], const Unit& u, int wr, int wc, int fr, int fq) const {
        const int row0 = u.r0 + wr * 64 + fr, col0 = u.c0 + wc * 32 + 8 * fq;
#pragma unroll
        for (int ai = 0; ai < 2; ++ai)
#pragma unroll
            for (int m = 0; m < 4; ++m) { const int row = row0 + ai * HALF + m * 16; const float sc = rowscale ? rowscale[row] : 1.f;
                bf16_t* rowp = O + (size_t)row * ldc + col0;
#pragma unroll
                for (int bj = 0; bj < 2; ++bj) { const f32x4 v0 = acc[ai][bj][m][0] * sc, v1 = acc[ai][bj][m][1] * sc;
                    u32x4 w; w.x = cvt_pk_bf16(v0[0], v0[1]); w.y = cvt_pk_bf16(v0[2], v0[3]); w.z = cvt_pk_bf16(v1[0], v1[1]); w.w = cvt_pk_bf16(v1[2], v1[3]);
                    *(u32x4*)(rowp + bj * HALF) = w; } }
    }
};
struct EpiZ {
    bf16_t* ZM; bf16_t* UT; bf16_t* G;
    __device__ __forceinline__ void operator()(const f32x4 (&acc)[2][2][4][2], const Unit& u, int wr, int wc, int fr, int fq) const {
        const int row0 = u.r0 + wr * 64 + fr, col0 = u.c0 + wc * 32 + 8 * fq;
        if (u.c0 >= 2048) {
#pragma unroll
            for (int ai = 0; ai < 2; ++ai)
#pragma unroll
                for (int m = 0; m < 4; ++m) { bf16_t* rowp = G + (size_t)(row0 + ai * HALF + m * 16) * 6144 + (col0 - 2048);
#pragma unroll
                    for (int bj = 0; bj < 2; ++bj) { const f32x4 a0 = acc[ai][bj][m][0], a1 = acc[ai][bj][m][1];
                        u32x4 w; w.x = cvt_pk_bf16(fast_sigmoid(a0[0]), fast_sigmoid(a0[1])); w.y = cvt_pk_bf16(fast_sigmoid(a0[2]), fast_sigmoid(a0[3]));
                        w.z = cvt_pk_bf16(fast_sigmoid(a1[0]), fast_sigmoid(a1[1])); w.w = cvt_pk_bf16(fast_sigmoid(a1[2]), fast_sigmoid(a1[3]));
                        *(u32x4*)(rowp + bj * HALF) = w; } }
        } else if (u.c0 >= 1024 && u.c0 < 1536) {
#pragma unroll
            for (int ai = 0; ai < 2; ++ai)
#pragma unroll
                for (int m = 0; m < 4; ++m) { const int row = row0 + ai * HALF + m * 16; const int b = row >> 11, s = row & 2047;
                    bf16_t* base = UT + ((size_t)b * 512 + (col0 - 1024)) * 2048 + s;
#pragma unroll
                    for (int bj = 0; bj < 2; ++bj)
#pragma unroll
                        for (int n = 0; n < 2; ++n)
#pragma unroll
                            for (int j = 0; j < 4; ++j) base[(size_t)(bj * HALF + 4 * n + j) * 2048] = (bf16_t)f2bf(acc[ai][bj][m][n][j]); }
        } else {
#pragma unroll
            for (int ai = 0; ai < 2; ++ai)
#pragma unroll
                for (int m = 0; m < 4; ++m) { bf16_t* rowp = ZM + (size_t)(row0 + ai * HALF + m * 16) * 2048 + col0;
#pragma unroll
                    for (int bj = 0; bj < 2; ++bj) { const f32x4 v0 = acc[ai][bj][m][0], v1 = acc[ai][bj][m][1];
                        u32x4 w; w.x = cvt_pk_bf16(v0[0], v0[1]); w.y = cvt_pk_bf16(v0[2], v0[3]); w.z = cvt_pk_bf16(v1[0], v1[1]); w.w = cvt_pk_bf16(v1[2], v1[3]);
                        *(u32x4*)(rowp + bj * HALF) = w; } }
        }
    }
};
struct EpiGate {
    bf16_t* MG; const bf16_t* G;
    __device__ __forceinline__ void operator()(const f32x4 (&acc)[2][2][4][2], const Unit& u, int wr, int wc, int fr, int fq) const {
        const int row0 = u.r0 + wr * 64 + fr, col0 = u.c0 + wc * 32 + 8 * fq; int s = u.aux;
        const int gs = s; if (DBG_ONLY_BRANCH >= 0) { if (s != DBG_ONLY_BRANCH) return; s = 0; }
#pragma unroll
        for (int ai = 0; ai < 2; ++ai)
#pragma unroll
            for (int m = 0; m < 4; ++m) { const int row = row0 + ai * HALF + m * 16;
                bf16_t* mp = MG + (size_t)row * 2048 + col0; const bf16_t* gp = G + (size_t)row * 6144 + gs * 2048 + col0;
#pragma unroll
                for (int bj = 0; bj < 2; ++bj) { const u32x4 g = *(const u32x4*)(gp + bj * HALF);
                    u32x4 o = (u32x4){0u, 0u, 0u, 0u}; if (s > 0) o = *(const u32x4*)(mp + bj * HALF);
                    const f32x4 a0 = acc[ai][bj][m][0], a1 = acc[ai][bj][m][1];
                    u32x4 w;
                    w.x = cvt_pk_bf16(bf_lo(o.x) + bf_lo(g.x) * a0[0], bf_hi(o.x) + bf_hi(g.x) * a0[1]);
                    w.y = cvt_pk_bf16(bf_lo(o.y) + bf_lo(g.y) * a0[2], bf_hi(o.y) + bf_hi(g.y) * a0[3]);
                    w.z = cvt_pk_bf16(bf_lo(o.z) + bf_lo(g.z) * a1[0], bf_hi(o.z) + bf_hi(g.z) * a1[1]);
                    w.w = cvt_pk_bf16(bf_lo(o.w) + bf_lo(g.w) * a1[2], bf_hi(o.w) + bf_hi(g.w) * a1[3]);
                    *(u32x4*)(mp + bj * HALF) = w; } }
    }
};
struct EpiResid {
    const float* X; float* O;
    __device__ __forceinline__ void operator()(const f32x4 (&acc)[2][2][4][2], const Unit& u, int wr, int wc, int fr, int fq) const {
        const int row0 = u.r0 + wr * 64 + fr, col0 = u.c0 + wc * 32 + 8 * fq;
#pragma unroll
        for (int ai = 0; ai < 2; ++ai)
#pragma unroll
            for (int m = 0; m < 4; ++m) { const size_t off = (size_t)(row0 + ai * HALF + m * 16) * 2048 + col0;
#pragma unroll
                for (int bj = 0; bj < 2; ++bj)
#pragma unroll
                    for (int n = 0; n < 2; ++n) { const f32x4 xv = *(const f32x4*)(X + off + bj * HALF + 4 * n); *(f32x4*)(O + off + bj * HALF + 4 * n) = xv + acc[ai][bj][m][n]; } }
    }
};
struct EpiSwiGLU {
    bf16_t* H;
    __device__ __forceinline__ void operator()(const f32x4 (&acc)[2][2][4][2], const Unit& u, int wr, int wc, int fr, int fq) const {
        const int row0 = u.r0 + wr * 64 + fr, col0 = u.c0 + wc * 32 + 8 * fq;
#pragma unroll
        for (int ai = 0; ai < 2; ++ai)
#pragma unroll
            for (int m = 0; m < 4; ++m) { bf16_t* rowp = H + (size_t)(row0 + ai * HALF + m * 16) * 2048 + col0;
                float h[8];
#pragma unroll
                for (int n = 0; n < 2; ++n)
#pragma unroll
                    for (int j = 0; j < 4; ++j) { const float g = acc[ai][0][m][n][j], up = acc[ai][1][m][n][j]; h[4 * n + j] = g * fast_sigmoid(g) * up; }
                u32x4 w; w.x = cvt_pk_bf16(h[0], h[1]); w.y = cvt_pk_bf16(h[2], h[3]); w.z = cvt_pk_bf16(h[4], h[5]); w.w = cvt_pk_bf16(h[6], h[7]);
                *(u32x4*)rowp = w; }
    }
};
}

struct Args {
    const float* x; const float* mem; const float* norm_mix_g; const float* norm_mem_g; const float* w_in; const float* pool_w; const float* pool_scale; const float* fourier_w;
    const float* w_kv; const float* proj_pool; const float* proj_fourier; const float* proj_mem; const float* w_out; const float* norm_ffn_g; const float* w_router;
    const float* w_gate; const float* w_up; const float* w_down; const float* norm_final_g;
    float* out; unsigned char* ws; int ph_lo, ph_hi;
};

__device__ __forceinline__ void p0_transpose_item(const float* W, int N, int k0, int n0, bf16_t* WT, int ldt, int drow0, const float* kscale, LAS float* scr, int lane) {
#pragma unroll 8
    for (int i = 0; i < 32; ++i) { const int kk = 2 * i + (lane >> 5); float v = W[(size_t)(k0 + kk) * N + n0 + (lane & 31)]; if (kscale) v *= kscale[k0 + kk]; scr[kk * 33 + (lane & 31)] = v; }
    LDS_WAIT(); asm volatile("" ::: "memory");
    const int c = lane & 7;
#pragma unroll
    for (int j = 0; j < 4; ++j) { const int n = (lane >> 3) + 8 * j; const LAS float* s = scr + (8 * c) * 33 + n;
        u32x4 o; o.x = pk2(s[0 * 33], s[1 * 33]); o.y = pk2(s[2 * 33], s[3 * 33]); o.z = pk2(s[4 * 33], s[5 * 33]); o.w = pk2(s[6 * 33], s[7 * 33]);
        *(u32x4*)(WT + (size_t)(drow0 + n) * ldt + k0 + 8 * c) = o; }
    LDS_WAIT(); asm volatile("" ::: "memory");
}
__device__ __forceinline__ void rms_row_to_bf16(const float* xrow, const float* g, bf16_t* orow, int lane) {
    const f32x4* xr = (const f32x4*)xrow + lane; const f32x4* gr = (const f32x4*)g + lane;
    f32x4 v[8]; float s = 0.f;
#pragma unroll
    for (int j = 0; j < 8; ++j) { v[j] = xr[64 * j]; s += (v[j].x * v[j].x + v[j].y * v[j].y) + (v[j].z * v[j].z + v[j].w * v[j].w); }
    const float inv = 1.0f / sqrtf(wave_sum(s) * (1.f / DM) + EPS);
    u32x2* o8 = (u32x2*)orow + lane;
#pragma unroll
    for (int j = 0; j < 8; ++j) { const f32x4 gg = gr[64 * j]; u32x2 w; w.x = pk2(v[j].x * inv * gg.x, v[j].y * inv * gg.y); w.y = pk2(v[j].z * inv * gg.z, v[j].w * inv * gg.w); o8[64 * j] = w; }
}

__device__ __forceinline__ void phase0(const Args& a, LAS unsigned char* lds, int gw, int NGW, int wave, int lane) {
    unsigned char* ws = a.ws;
    LAS float* scr = (LAS float*)(lds + wave * 16384);
    constexpr int I_WIN = 32 * 256, I_KV = 32 * 32, I_PP = 16 * 64, I_PF = 8 * 64, I_PM = 8 * 64, I_WO = 32 * 64, I_EX = 32 * 64;
    constexpr int NSMALL = I_WIN + I_KV + I_PP + I_PF + I_PM + I_WO;
    constexpr int NITEMS = NSMALL + 48 * I_EX;
    for (int it = gw; it < NITEMS; it += NGW) {
        int r = it;
        if (r >= NSMALL) { r -= NSMALL; const int mat = r / I_EX, w = r % I_EX, type = mat / 16, e = mat % 16; const int kb = w / 64, nb = w % 64, n0 = nb * 32;
            const float* src = (type == 0 ? a.w_gate : (type == 1 ? a.w_up : a.w_down)) + (size_t)e * 2048 * 2048;
            if (type < 2) p0_transpose_item(src, 2048, kb * 64, n0, (bf16_t*)(ws + WS_WGUT) + (size_t)e * 4096 * 2048, 2048, ((n0 >> 7) << 8) + (n0 & 127) + (type == 1 ? 128 : 0), nullptr, scr, lane);
            else p0_transpose_item(src, 2048, kb * 64, n0, (bf16_t*)(ws + WS_WDT) + (size_t)e * 2048 * 2048, 2048, n0, nullptr, scr, lane);
            continue; }
        if (r < I_WIN) { const int kb = r / 256, nb = r % 256; p0_transpose_item(a.w_in, 8192, kb * 64, nb * 32, (bf16_t*)(ws + WS_WINT), 2048, nb * 32, nullptr, scr, lane); continue; } r -= I_WIN;
        if (r < I_KV) { const int kb = r / 32, nb = r % 32; p0_transpose_item(a.w_kv, 1024, kb * 64, nb * 32, (bf16_t*)(ws + WS_WKVT), 2048, nb * 32, nullptr, scr, lane); continue; } r -= I_KV;
        if (r < I_PP) { const int kb = r / 64, nb = r % 64; p0_transpose_item(a.proj_pool, 2048, kb * 64, nb * 32, (bf16_t*)(ws + WS_PPST), 1024, nb * 32, a.pool_scale, scr, lane); continue; } r -= I_PP;
        if (r < I_PF) { const int kb = r / 64, nb = r % 64; p0_transpose_item(a.proj_fourier, 2048, kb * 64, nb * 32, (bf16_t*)(ws + WS_PFT), 1024, nb * 32, nullptr, scr, lane); continue; } r -= I_PF;
        if (r < I_PM) { const int kb = r / 64, nb = r % 64; p0_transpose_item(a.proj_mem, 2048, kb * 64, nb * 32, (bf16_t*)(ws + WS_BCAT) + 2048, 2560, nb * 32, nullptr, scr, lane); continue; } r -= I_PM;
        { const int kb = r / 64, nb = r % 64; p0_transpose_item(a.w_out, 2048, kb * 64, nb * 32, (bf16_t*)(ws + WS_WOT), 2048, nb * 32, nullptr, scr, lane); }
    }
    for (int m = gw; m < T; m += NGW) rms_row_to_bf16(a.x + (size_t)m * DM, a.norm_mix_g, (bf16_t*)(ws + WS_XN) + (size_t)m * DM, lane);
    for (int m = gw; m < NBATCH * MEML; m += NGW) rms_row_to_bf16(a.mem + (size_t)m * DM, a.norm_mem_g, (bf16_t*)(ws + WS_MN) + (size_t)m * DM, lane);
    const int gt = gw * 64 + lane, NGT = NGW * 64;
    for (int i = gt; i < 1024 * 128; i += NGT) { const int row = i >> 7, col = (i & 127) * 8, g = row >> 8, c = row & 255;
        u32x4 o = (u32x4){0u, 0u, 0u, 0u};
        if ((col >> 8) == g) { const float* p = a.pool_w + ((size_t)g * 256 + c) * 256 + (col & 255); const f32x4 v0 = *(const f32x4*)p, v1 = *(const f32x4*)(p + 4);
            o.x = pk2(v0.x, v0.y); o.y = pk2(v0.z, v0.w); o.z = pk2(v1.x, v1.y); o.w = pk2(v1.z, v1.w); }
        *(u32x4*)((bf16_t*)(ws + WS_PWBD) + (size_t)row * 1024 + col) = o; }
    for (int i = gt; i < 1024 * 512; i += NGT) { const int row = i >> 9, col = i & 511, cs = row >> 9, g = (row >> 7) & 3, c = row & 127, g2 = col >> 7, d = col & 127;
        float v = 0.f;
        if (g2 == g) { const float* fw = a.fourier_w + (size_t)g * 128 * 128 + d;
            for (int j = 0; j < 128; ++j) { const float ang = (float)((c * j) & 127) * (1.0f / 64.0f); const float tw = cs ? -sinpif(ang) : cospif(ang); v += tw * fw[(size_t)j * 128]; } }
        ((bf16_t*)(ws + WS_M1BD))[(size_t)row * 1024 + col] = (bf16_t)f2bf(v); }
    for (int i = gt; i < 4096 * 256; i += NGT) { const int row = i >> 8, s0 = (i & 255) * 8, cs = row >> 11, k = row & 2047;
        float v[8];
#pragma unroll
        for (int j = 0; j < 8; ++j) { const float ang = (float)((k * (s0 + j)) & 2047) * (1.0f / 1024.0f); v[j] = (cs ? sinpif(ang) : cospif(ang)) * (1.0f / 512.0f); }
        u32x4 o; o.x = pk2(v[0], v[1]); o.y = pk2(v[2], v[3]); o.z = pk2(v[4], v[5]); o.w = pk2(v[6], v[7]);
        *(u32x4*)((bf16_t*)(ws + WS_TW) + (size_t)row * 2048 + s0) = o; }
}

__device__ __forceinline__ void pool_pass(const Args& a, int gw, int NGW, int lane) {
    const bf16_t* ZM = (const bf16_t*)(a.ws + WS_ZM); bf16_t* AC = (bf16_t*)(a.ws + WS_ACAT);
    for (int it = gw; it < 2048; it += NGW) {
        const int run = it >> 1, hf = it & 1, chunk = hf * 64 + lane, ch0 = chunk * 8, g = chunk >> 5, hw = 1 << g;
        const int t0 = run * 16, b = t0 >> 11, s0 = t0 & 2047; const bf16_t* base = ZM + (size_t)b * SEQ * 2048 + ch0;
        float sum[8];
#pragma unroll
        for (int j = 0; j < 8; ++j) sum[j] = 0.f;
        for (int d = -8; d < 8; ++d) { const int s = s0 + d; if (d >= -hw && d < hw && s >= 0 && s < SEQ) { const u32x4 w = *(const u32x4*)(base + (size_t)s * 2048);
            sum[0] += bf_lo(w.x); sum[1] += bf_hi(w.x); sum[2] += bf_lo(w.y); sum[3] += bf_hi(w.y); sum[4] += bf_lo(w.z); sum[5] += bf_hi(w.z); sum[6] += bf_lo(w.w); sum[7] += bf_hi(w.w); } }
        for (int i = 0; i < 16; ++i) { const int s = s0 + i; const int lo = (s - hw) < 0 ? 0 : (s - hw), hi = (s + hw) > SEQ ? SEQ : (s + hw); const float rc = 1.0f / (float)(hi - lo);
            const u32x4 c = *(const u32x4*)(base + (size_t)s * 2048);
            u32x4 o; o.x = pk2(sum[0] * rc - bf_lo(c.x), sum[1] * rc - bf_hi(c.x)); o.y = pk2(sum[2] * rc - bf_lo(c.y), sum[3] * rc - bf_hi(c.y));
            o.z = pk2(sum[4] * rc - bf_lo(c.z), sum[5] * rc - bf_hi(c.z)); o.w = pk2(sum[6] * rc - bf_lo(c.w), sum[7] * rc - bf_hi(c.w));
            *(u32x4*)(AC + (size_t)(t0 + i) * 2560 + ch0) = o;
            if (s + hw < SEQ) { const u32x4 w = *(const u32x4*)(base + (size_t)(s + hw) * 2048);
                sum[0] += bf_lo(w.x); sum[1] += bf_hi(w.x); sum[2] += bf_lo(w.y); sum[3] += bf_hi(w.y); sum[4] += bf_lo(w.z); sum[5] += bf_hi(w.z); sum[6] += bf_lo(w.w); sum[7] += bf_hi(w.w); }
            if (s - hw >= 0) { const u32x4 w = *(const u32x4*)(base + (size_t)(s - hw) * 2048);
                sum[0] -= bf_lo(w.x); sum[1] -= bf_hi(w.x); sum[2] -= bf_lo(w.y); sum[3] -= bf_hi(w.y); sum[4] -= bf_lo(w.z); sum[5] -= bf_hi(w.z); sum[6] -= bf_lo(w.w); sum[7] -= bf_hi(w.w); } }
    }
}

__device__ __forceinline__ void attn_unit(const Args& a, int b, int h, int qb, int wave, int lane) {
    const bf16_t* ZM = (const bf16_t*)(a.ws + WS_ZM); const bf16_t* KM = (const bf16_t*)(a.ws + WS_KMEM); const bf16_t* VT = (const bf16_t*)(a.ws + WS_VT); bf16_t* AC = (bf16_t*)(a.ws + WS_ACAT);
    const int l31 = lane & 31, hh = lane >> 5;
    const int t = b * SEQ + qb * 256 + wave * 32 + l31;
    bf16x8 qf[8];
    const bf16_t* qp = ZM + (size_t)t * 2048 + 1536 + h * 128 + 8 * hh;
#pragma unroll
    for (int ks = 0; ks < 8; ++ks) qf[ks] = *(const bf16x8*)(qp + 16 * ks);
    f32x16 sc[8];
    const bf16_t* kp = KM + (size_t)(b * MEML + l31) * 512 + h * 128 + 8 * hh;
#pragma unroll
    for (int kt = 0; kt < 8; ++kt) { f32x16 acc;
#pragma unroll
        for (int r = 0; r < 16; ++r) acc[r] = 0.f;
#pragma unroll
        for (int ks = 0; ks < 8; ++ks) { const bf16x8 kf = *(const bf16x8*)(kp + (size_t)(32 * kt) * 512 + 16 * ks); acc = __builtin_amdgcn_mfma_f32_32x32x16_bf16(kf, qf[ks], acc, 0, 0, 0); }
        sc[kt] = acc; }
    float mx = -3.0e38f;
#pragma unroll
    for (int kt = 0; kt < 8; ++kt)
#pragma unroll
        for (int r = 0; r < 16; ++r) mx = fmaxf(mx, sc[kt][r]);
    mx = fmaxf(mx, __shfl_xor(mx, 32));
    const float cs = 0.08838834764831845f * 1.44269504089f;
    float sum = 0.f;
#pragma unroll
    for (int kt = 0; kt < 8; ++kt)
#pragma unroll
        for (int r = 0; r < 16; ++r) { const float p = __builtin_amdgcn_exp2f((sc[kt][r] - mx) * cs); sc[kt][r] = p; sum += p; }
    sum += __shfl_xor(sum, 32);
    const float rinv = 1.0f / sum;
    bf16x8 pf[8][2];
#pragma unroll
    for (int kt = 0; kt < 8; ++kt)
#pragma unroll
        for (int s = 0; s < 2; ++s) { u32x4 w; w.x = cvt_pk_bf16(sc[kt][8 * s + 0], sc[kt][8 * s + 1]); w.y = cvt_pk_bf16(sc[kt][8 * s + 2], sc[kt][8 * s + 3]);
            w.z = cvt_pk_bf16(sc[kt][8 * s + 4], sc[kt][8 * s + 5]); w.w = cvt_pk_bf16(sc[kt][8 * s + 6], sc[kt][8 * s + 7]); pf[kt][s] = __builtin_bit_cast(bf16x8, w); }
#pragma unroll
    for (int dt = 0; dt < 4; ++dt) { f32x16 o;
#pragma unroll
        for (int r = 0; r < 16; ++r) o[r] = 0.f;
        const bf16_t* vp = VT + (size_t)(h * 128 + 32 * dt + l31) * 2048 + b * MEML + 4 * hh;
#pragma unroll
        for (int kt = 0; kt < 8; ++kt)
#pragma unroll
            for (int s = 0; s < 2; ++s) { const u32x2 v0 = *(const u32x2*)(vp + 32 * kt + 16 * s), v1 = *(const u32x2*)(vp + 32 * kt + 16 * s + 8);
                const u32x4 vv = (u32x4){v0.x, v0.y, v1.x, v1.y};
                o = __builtin_amdgcn_mfma_f32_32x32x16_bf16(__builtin_bit_cast(bf16x8, vv), pf[kt][s], o, 0, 0, 0); }
        bf16_t* op = AC + (size_t)t * 2560 + 2048 + h * 128 + 32 * dt + 4 * hh;
#pragma unroll
        for (int rg = 0; rg < 4; ++rg) { u32x2 w; w.x = cvt_pk_bf16(o[4 * rg + 0] * rinv, o[4 * rg + 1] * rinv); w.y = cvt_pk_bf16(o[4 * rg + 2] * rinv, o[4 * rg + 3] * rinv);
            *(u32x2*)(op + 8 * rg) = w; } }
}

__device__ __forceinline__ void router_phase(const Args& a, LAS unsigned char* lds, int vcu, int G, int wave, int lane, int tid) {
    LAS float* wrT = (LAS float*)lds;
    for (int i = tid; i < 2048 * 16; i += NTHR) { const int d = i >> 4, e = i & 15; wrT[e * 2048 + d] = a.w_router[i]; }
    __syncthreads();
    const float* X1 = a.out; bf16_t* H2 = (bf16_t*)(a.ws + WS_H2); float* AFF = (float*)(a.ws + WS_AFF);
    for (int gp = vcu * NWAVES + wave; gp < T / 2; gp += G * NWAVES) {
        const f32x4* xr0 = (const f32x4*)(X1 + (size_t)(2 * gp) * DM) + lane; const f32x4* xr1 = xr0 + DM / 4;
        float s0 = 0.f, s1 = 0.f;
#pragma unroll
        for (int j = 0; j < 8; ++j) { const f32x4 p = xr0[64 * j], q = xr1[64 * j]; s0 += (p.x * p.x + p.y * p.y) + (p.z * p.z + p.w * p.w); s1 += (q.x * q.x + q.y * q.y) + (q.z * q.z + q.w * q.w); }
        const float inv0 = 1.0f / sqrtf(wave_sum(s0) * (1.f / DM) + EPS), inv1 = 1.0f / sqrtf(wave_sum(s1) * (1.f / DM) + EPS);
        float lg[2][16];
#pragma unroll
        for (int e = 0; e < 16; ++e) { lg[0][e] = 0.f; lg[1][e] = 0.f; }
        u32x2* h0 = (u32x2*)(H2 + (size_t)(2 * gp) * DM) + lane; u32x2* h1 = h0 + DM / 4;
#pragma unroll 1
        for (int j = 0; j < 8; ++j) { const f32x4 gg = ((const f32x4*)a.norm_ffn_g)[64 * j + lane];
            const f32x4 p = xr0[64 * j] * inv0 * gg, q = xr1[64 * j] * inv1 * gg;
            u32x2 w0; w0.x = pk2(p.x, p.y); w0.y = pk2(p.z, p.w); h0[64 * j] = w0;
            u32x2 w1; w1.x = pk2(q.x, q.y); w1.y = pk2(q.z, q.w); h1[64 * j] = w1;
            const LAS float* wb = wrT + 256 * j + 4 * lane;
#pragma unroll
            for (int e = 0; e < 16; ++e) { const f32x4 w = *(const LAS f32x4*)(wb + e * 2048);
                lg[0][e] += (p.x * w.x + p.y * w.y) + (p.z * w.z + p.w * w.w);
                lg[1][e] += (q.x * w.x + q.y * w.y) + (q.z * w.z + q.w * w.w); } }
#pragma unroll
        for (int r = 0; r < 2; ++r) { float mx = -3.0e38f;
#pragma unroll
            for (int e = 0; e < 16; ++e) { lg[r][e] = wave_sum(lg[r][e]); mx = fmaxf(mx, lg[r][e]); }
            float sum = 0.f;
#pragma unroll
            for (int e = 0; e < 16; ++e) { lg[r][e] = __expf(lg[r][e] - mx); sum += lg[r][e]; }
            const float rs = 1.0f / sum; float mine = 0.f;
#pragma unroll
            for (int e = 0; e < 16; ++e) mine = (lane == e) ? lg[r][e] * rs : mine;
            const int t = 2 * gp + r, b = t >> 11, s = t & 2047;
            if (lane < 16) AFF[((size_t)b * 16 + lane) * SEQ + s] = mine; }
    }
}

__device__ __forceinline__ void topk_phase(const Args& a, LAS unsigned char* lds, int c, int wave, int lane, int tid) {
    if (c >= 256) return;
    const int b = c & 7, e = (c >> 3) & 15, hf = c >> 7;
    LAS float* af = (LAS float*)lds; LAS int* list = (LAS int*)(lds + 8192);
    const float* AFF = (const float*)(a.ws + WS_AFF) + ((size_t)b * 16 + e) * SEQ;
    for (int i = tid; i < SEQ; i += NTHR) af[i] = AFF[i];
    if (tid < CAP) list[tid] = -1;
    __syncthreads();
    const int s0 = hf * 1024 + tid * 2, s1 = s0 + 1; const float a0 = af[s0], a1 = af[s1];
    int c0 = 0, c1 = 0;
    for (int j = 0; j < SEQ; j += 4) { const f32x4 v = *(const LAS f32x4*)(af + j);
#pragma unroll
        for (int q = 0; q < 4; ++q) { const float vv = v[q]; const int jj = j + q;
            c0 += (vv > a0 || (vv == a0 && jj < s0)) ? 1 : 0; c1 += (vv > a1 || (vv == a1 && jj < s1)) ? 1 : 0; } }
    int* INV = (int*)(a.ws + WS_INV); float* SELW = (float*)(a.ws + WS_SELW);
    INV[((size_t)b * SEQ + s0) * 16 + e] = c0 < CAP ? c0 : -1;
    INV[((size_t)b * SEQ + s1) * 16 + e] = c1 < CAP ? c1 : -1;
    if (c0 < CAP) { list[c0] = s0; SELW[((size_t)e * 8 + b) * CAP + c0] = a0; }
    if (c1 < CAP) { list[c1] = s1; SELW[((size_t)e * 8 + b) * CAP + c1] = a1; }
    __syncthreads();
    const bf16_t* H2 = (const bf16_t*)(a.ws + WS_H2); bf16_t* XIN = (bf16_t*)(a.ws + WS_XIN);
    for (int slot = wave; slot < CAP; slot += NWAVES) { const int s = list[slot]; if (s < 0) continue;
        const u32x4* src = (const u32x4*)(H2 + ((size_t)b * SEQ + s) * DM) + lane; u32x4* dst = (u32x4*)(XIN + (((size_t)e * 8 + b) * CAP + slot) * DM) + lane;
        const u32x4 v0 = src[0], v1 = src[64], v2 = src[128], v3 = src[192]; dst[0] = v0; dst[64] = v1; dst[128] = v2; dst[192] = v3; }
    __syncthreads();
}

__device__ __forceinline__ void combine_phase(const Args& a, int gw, int NGW, int lane) {
    const bf16_t* Y = (const bf16_t*)(a.ws + WS_XIN); const int* INV = (const int*)(a.ws + WS_INV);
    for (int t = gw; t < T; t += NGW) { const int b = t >> 11;
        float* xr = a.out + (size_t)t * DM;
        f32x4 v[8];
#pragma unroll
        for (int j = 0; j < 8; ++j) v[j] = ((const f32x4*)xr)[64 * j + lane];
        const int myinv = DBG_SKIP_MOE ? -1 : INV[(size_t)t * 16 + (lane & 15)];
        for (int e = 0; e < 16; ++e) { const int slot = __shfl(myinv, e);
            if (slot >= 0) { const u32x2* yr = (const u32x2*)(Y + (((size_t)e * 8 + b) * CAP + slot) * DM);
#pragma unroll
                for (int j = 0; j < 8; ++j) { const u32x2 w = yr[64 * j + lane]; v[j].x += bf_lo(w.x); v[j].y += bf_hi(w.x); v[j].z += bf_lo(w.y); v[j].w += bf_hi(w.y); } } }
        float s = 0.f;
#pragma unroll
        for (int j = 0; j < 8; ++j) s += (v[j].x * v[j].x + v[j].y * v[j].y) + (v[j].z * v[j].z + v[j].w * v[j].w);
        const float inv = 1.0f / sqrtf(wave_sum(s) * (1.f / DM) + EPS);
#pragma unroll
        for (int j = 0; j < 8; ++j) { const f32x4 gg = ((const f32x4*)a.norm_final_g)[64 * j + lane]; ((f32x4*)xr)[64 * j + lane] = v[j] * inv * gg; }
    }
}

using pg8::Unit;
struct SchedFold {
    unsigned char* ws; int c;
    __device__ __forceinline__ bool next(int i, Unit& u) const {
        if (i > 0 || c >= 64) return false;
        const int L = c & 31, pm = L & 7, pn = L >> 3;
        if (c < 32) { u.A = (const char*)(ws + WS_PPST) + (size_t)pm * 256 * 1024 * 2; u.B0 = (const char*)(ws + WS_PWBD) + (size_t)pn * 256 * 1024 * 2; u.nt = 16; u.c0 = pn * 256; }
        else { u.A = (const char*)(ws + WS_PFT) + (size_t)pm * 256 * 1024 * 2; u.B0 = (const char*)(ws + WS_M1BD) + (size_t)pn * 256 * 1024 * 2; u.nt = 8; u.c0 = 1024 + pn * 256; }
        u.B1 = u.B0 + (size_t)128 * 1024 * 2; u.r0 = pm * 256; u.aux = 0; return true;
    }
};
struct SchedKV {
    unsigned char* ws; int c;
    __device__ __forceinline__ bool next(int i, Unit& u) const {
        if (i > 0 || c < 64 || c >= 96) return false;
        const int L = c - 64; u.nt = 32;
        if (L < 16) { const int pm = L & 7, pn = L >> 3; u.A = (const char*)(ws + WS_MN) + (size_t)pm * 256 * 2048 * 2; u.B0 = (const char*)(ws + WS_WKVT) + (size_t)pn * 256 * 2048 * 2; u.r0 = pm * 256; u.c0 = pn * 256; u.aux = 0; }
        else { const int L2 = L - 16, pm = L2 & 1, pn = L2 >> 1; u.A = (const char*)(ws + WS_WKVT) + (size_t)(512 + pm * 256) * 2048 * 2; u.B0 = (const char*)(ws + WS_MN) + (size_t)pn * 256 * 2048 * 2; u.r0 = pm * 256; u.c0 = pn * 256; u.aux = 1; }
        u.B1 = u.B0 + (size_t)128 * 2048 * 2; return true;
    }
};
struct EpiKV {
    bf16_t* KM; bf16_t* VT;
    __device__ __forceinline__ void operator()(const f32x4 (&acc)[2][2][4][2], const Unit& u, int wr, int wc, int fr, int fq) const {
        pg8::EpiBf16 E{u.aux ? VT : KM, u.aux ? 2048 : 512, nullptr}; E(acc, u, wr, wc, fr, fq);
    }
};
struct SchedTiles {
    const char* A; const char* B; int lda, ldb, nM, nN, nt, G, c;
    __device__ __forceinline__ bool next(int i, Unit& u) const {
        const int L = i * G + c; if (L >= nM * nN) return false;
        int pm, pn; pg8::tile_order(L, nM, nN, pm, pn);
        u.A = A + (size_t)pm * 256 * lda * 2; u.B0 = B + (size_t)pn * 256 * ldb * 2; u.B1 = u.B0 + (size_t)128 * ldb * 2; u.nt = nt; u.r0 = pm * 256; u.c0 = pn * 256; u.aux = 0; return true;
    }
};
struct SchedDFT {
    unsigned char* ws; int c;
    __device__ __forceinline__ bool next(int i, Unit& u) const {
        if (i > 0 || c >= 256) return false;
        const int b = c & 7, j = c >> 3, pm = j & 15, pn = j >> 4;
        u.A = (const char*)(ws + WS_TW) + (size_t)pm * 256 * 2048 * 2; u.B0 = (const char*)(ws + WS_UT) + (size_t)(b * 512 + pn * 256) * 2048 * 2; u.B1 = u.B0 + (size_t)128 * 2048 * 2; u.nt = 32;
        u.r0 = b * SEQ + (pm & 7) * 256; u.c0 = 1024 + (pm >> 3) * 512 + pn * 256; u.aux = 0; return true;
    }
};
struct SchedProj {
    unsigned char* ws; int G, c;
    __device__ __forceinline__ bool next(int i, Unit& u) const {
        const int ti = i / 3, s = i - 3 * ti; const int L = ti * G + c; if (L >= 512) return false;
        int pm, pn; pg8::tile_order(L, 64, 8, pm, pn);
        const size_t co = (size_t)s * 1024 * 2;
        u.A = (const char*)(ws + WS_ACAT) + (size_t)pm * 256 * 2560 * 2 + co; u.B0 = (const char*)(ws + WS_BCAT) + (size_t)pn * 256 * 2560 * 2 + co; u.B1 = u.B0 + (size_t)128 * 2560 * 2;
        u.nt = s == 2 ? 8 : 16; u.r0 = pm * 256; u.c0 = pn * 256; u.aux = s; return true;
    }
};
struct SchedGU {
    unsigned char* ws; int G, c;
    __device__ __forceinline__ bool next(int i, Unit& u) const {
        const int L = i * G + c; if (L >= 2048) return false;
        const int e = L >> 7, j = L & 127, x = j & 7, q = j >> 3, pm = q & 7, pn = 2 * x + (q >> 3);
        u.A = (const char*)(ws + WS_XIN) + (size_t)(e * 8 + pm) * 256 * 2048 * 2; u.B0 = (const char*)(ws + WS_WGUT) + ((size_t)e * 4096 + pn * 256) * 2048 * 2; u.B1 = u.B0 + (size_t)128 * 2048 * 2;
        u.nt = 32; u.r0 = (e * 8 + pm) * 256; u.c0 = pn * 128; u.aux = 0; return true;
    }
};
struct SchedDown {
    unsigned char* ws; int G, c;
    __device__ __forceinline__ bool next(int i, Unit& u) const {
        const int L = i * G + c; if (L >= 1024) return false;
        const int e = L >> 6, j = L & 63, pn = j & 7, pm = j >> 3;
        u.A = (const char*)(ws + WS_HID) + (size_t)(e * 8 + pm) * 256 * 2048 * 2; u.B0 = (const char*)(ws + WS_WDT) + ((size_t)e * 2048 + pn * 256) * 2048 * 2; u.B1 = u.B0 + (size_t)128 * 2048 * 2;
        u.nt = 32; u.r0 = (e * 8 + pm) * 256; u.c0 = pn * 256; u.aux = 0; return true;
    }
};

__global__ void __launch_bounds__(NTHR, 2) fwd_kernel(Args a) {
    extern __shared__ __attribute__((aligned(16))) unsigned char lds_raw[];
    LAS unsigned char* lds = (LAS unsigned char*)lds_raw;
    const int tid = threadIdx.x, lane = tid & 63, wave = __builtin_amdgcn_readfirstlane(tid >> 6);
    const int G = gridDim.x, c = blockIdx.x;
    const int vcu = (G % 8 == 0) ? (c % 8) * (G / 8) + c / 8 : c;
    const int gw = vcu * NWAVES + wave, NGW = G * NWAVES;
    unsigned char* ws = a.ws;
    const int lo = a.ph_lo, hi = a.ph_hi;
#define IN(k) (lo <= (k) && (k) < hi)
#define SEAM(k) do { if (IN(k) && IN((k) + 1)) { cg::this_grid().sync(); } } while (0)

    if (IN(0)) { phase0(a, lds, gw, NGW, wave, lane); __syncthreads(); }
    SEAM(0);
    if (!DBG_P5_FROM_XN && IN(1)) {
        { SchedFold S{ws, c}; pg8::EpiBf16 E{(bf16_t*)(ws + WS_BCAT), 2560, nullptr}; pg8::gemm_phase(lds, 1024, 1024, S, E); }
        { SchedKV S{ws, c}; EpiKV E{(bf16_t*)(ws + WS_KMEM), (bf16_t*)(ws + WS_VT)}; pg8::gemm_phase(lds, 2048, 2048, S, E); }
    }
    SEAM(1);
    if (!DBG_P5_FROM_XN && IN(2)) {
        SchedTiles S{(const char*)(ws + WS_XN), (const char*)(ws + WS_WINT), 2048, 2048, 64, 32, 32, G, c};
        pg8::EpiZ E{(bf16_t*)(ws + WS_ZM), (bf16_t*)(ws + WS_UT), (bf16_t*)(ws + WS_G)};
        pg8::gemm_phase(lds, 2048, 2048, S, E);
    }
    SEAM(2);
    if (!DBG_P5_FROM_XN && IN(3)) {
        { SchedDFT S{ws, c}; pg8::EpiBf16 E{(bf16_t*)(ws + WS_ACAT), 2560, nullptr}; pg8::gemm_phase(lds, 2048, 2048, S, E); }
        if (c < 256) { const int b = c & 7, j = c >> 3; attn_unit(a, b, j & 3, j >> 2, wave, lane); }
        pool_pass(a, gw, NGW, lane);
    }
    SEAM(3);
    if (!DBG_P5_FROM_XN && IN(4)) { SchedProj S{ws, G, c}; pg8::EpiGate E{(bf16_t*)(ws + WS_MG), (const bf16_t*)(ws + WS_G)}; pg8::gemm_phase(lds, 2560, 2560, S, E); }
    SEAM(4);
    if (IN(5)) {
        SchedTiles S{(const char*)(ws + (DBG_P5_FROM_XN ? WS_XN : WS_MG)), (const char*)(ws + WS_WOT), 2048, 2048, 64, 8, 32, G, c};
        pg8::EpiResid E{a.x, a.out}; pg8::gemm_phase(lds, 2048, 2048, S, E);
    }
    SEAM(5);
    if (!DBG_SKIP_MOE && IN(6)) { router_phase(a, lds, vcu, G, wave, lane, tid); __syncthreads(); }
    SEAM(6);
    if (!DBG_SKIP_MOE && IN(7)) topk_phase(a, lds, c, wave, lane, tid);
    SEAM(7);
    if (!DBG_SKIP_MOE && IN(8)) { SchedGU S{ws, G, c}; pg8::EpiSwiGLU E{(bf16_t*)(ws + WS_HID)}; pg8::gemm_phase(lds, 2048, 2048, S, E); }
    SEAM(8);
    if (!DBG_SKIP_MOE && IN(9)) { SchedDown S{ws, G, c}; pg8::EpiBf16 E{(bf16_t*)(ws + WS_XIN), 2048, (const float*)(ws + WS_SELW)}; pg8::gemm_phase(lds, 2048, 2048, S, E); }
    SEAM(9);
    if (IN(10)) combine_phase(a, gw, NGW, lane);
#undef IN
#undef SEAM
}

extern "C" void kernel_launch(void* const* d_in, const int* in_sizes, int n_in, void* d_out, int out_size, void* d_ws, size_t ws_size, hipStream_t stream) {
    static int grid = 0;
    if (grid == 0) {
        if (n_in != 19 || in_sizes[0] != T * DM || out_size != T * DM || ws_size < WS_END) {
            fprintf(stderr, "kernel_launch: unexpected shapes (n_in %d, in0 %d, out %d, ws %zu, need %zu); nothing launched\n", n_in, n_in > 0 ? in_sizes[0] : -1, out_size, ws_size, (size_t)WS_END); grid = -1; return; }
        int dev = 0, cus = 0, per_cu = 0;
        if (hipGetDevice(&dev) != hipSuccess || hipDeviceGetAttribute(&cus, hipDeviceAttributeMultiprocessorCount, dev) != hipSuccess) { fprintf(stderr, "kernel_launch: device query failed\n"); grid = -1; return; }
        if (hipFuncSetAttribute((const void*)fwd_kernel, hipFuncAttributeMaxDynamicSharedMemorySize, LDS_BYTES) != hipSuccess) { fprintf(stderr, "kernel_launch: hipFuncSetAttribute failed\n"); grid = -1; return; }
        if (hipOccupancyMaxActiveBlocksPerMultiprocessor(&per_cu, (const void*)fwd_kernel, NTHR, LDS_BYTES) != hipSuccess || per_cu < 1) { fprintf(stderr, "kernel_launch: occupancy query says %d blocks per CU\n", per_cu); (void)hipGetLastError(); grid = -1; return; }
        grid = cus;
        if (grid < 256) fprintf(stderr, "kernel_launch: note: %d CUs (< 256): some single-round phases assume 256 workgroups\n", grid);
    }
    if (grid < 0) return;
    Args a{};
    a.x = (const float*)d_in[0]; a.mem = (const float*)d_in[1]; a.norm_mix_g = (const float*)d_in[2]; a.norm_mem_g = (const float*)d_in[3]; a.w_in = (const float*)d_in[4];
    a.pool_w = (const float*)d_in[5]; a.pool_scale = (const float*)d_in[6]; a.fourier_w = (const float*)d_in[7]; a.w_kv = (const float*)d_in[8]; a.proj_pool = (const float*)d_in[9];
    a.proj_fourier = (const float*)d_in[10]; a.proj_mem = (const float*)d_in[11]; a.w_out = (const float*)d_in[12]; a.norm_ffn_g = (const float*)d_in[13]; a.w_router = (const float*)d_in[14];
    a.w_gate = (const float*)d_in[15]; a.w_up = (const float*)d_in[16]; a.w_down = (const float*)d_in[17]; a.norm_final_g = (const float*)d_in[18];
    a.out = (float*)d_out; a.ws = (unsigned char*)d_ws;
#if MK_MULTI_LAUNCH
    for (int p = 0; p < NPH; ++p) { a.ph_lo = p; a.ph_hi = p + 1; hipLaunchKernelGGL(fwd_kernel, dim3(grid), dim3(NTHR), LDS_BYTES, stream, a); }
#else
    a.ph_lo = 0; a.ph_hi = NPH;
    void* args[] = {&a};
    hipError_t e = hipLaunchCooperativeKernel((const void*)fwd_kernel, dim3(grid), dim3(NTHR), args, LDS_BYTES, stream);
    if (e != hipSuccess) fprintf(stderr, "kernel_launch: cooperative launch failed: %s (grid %d)\n", hipGetErrorString(e), grid);
#endif
}
```

```cpp
#include <hip/hip_runtime.h>
#include <hip/hip_cooperative_groups.h>
#include <cstdio>
#include <cstdint>
namespace cg = cooperative_groups;

#ifndef MK_MULTI_LAUNCH
#define MK_MULTI_LAUNCH 0
#endif

#ifndef DBG_P5_FROM_XN
#define DBG_P5_FROM_XN 0
#endif
#ifndef DBG_ONLY_BRANCH
#define DBG_ONLY_BRANCH -1
#endif
#ifndef DBG_SKIP_MOE
#define DBG_SKIP_MOE 0
#endif
#define LAS __attribute__((address_space(3)))
#define GAS __attribute__((address_space(1)))
typedef unsigned short bf16_t;
typedef short bf16x8 __attribute__((ext_vector_type(8)));
typedef short s16x4 __attribute__((ext_vector_type(4)));
typedef float f32x2 __attribute__((ext_vector_type(2)));
typedef float f32x4 __attribute__((ext_vector_type(4)));
typedef float f32x16 __attribute__((ext_vector_type(16)));
typedef unsigned u32x2 __attribute__((ext_vector_type(2)));
typedef unsigned u32x4 __attribute__((ext_vector_type(4)));

constexpr int T = 16384, DM = 2048, NBATCH = 8, SEQ = 2048, MEML = 256;
constexpr int NE = 16, CAP = 256;
constexpr float EPS = 1e-6f;
constexpr int NWAVES = 8, NTHR = 512;
constexpr int NPH = 11;

constexpr size_t MiB = 1u << 20;
constexpr size_t WS_CTL  = 0;
constexpr size_t WS_WINT = 1 * MiB;
constexpr size_t WS_WKVT = 33 * MiB;
constexpr size_t WS_PPST = 37 * MiB;
constexpr size_t WS_PFT  = 41 * MiB;
constexpr size_t WS_PWBD = 45 * MiB;
constexpr size_t WS_M1BD = 47 * MiB;
constexpr size_t WS_BCAT = 49 * MiB;
constexpr size_t WS_WOT  = 59 * MiB;
constexpr size_t WS_TW   = 67 * MiB;
constexpr size_t WS_WGUT = 83 * MiB;
constexpr size_t WS_WDT  = 339 * MiB;
constexpr size_t WS_ACT  = 467 * MiB;
constexpr size_t WS_XN   = WS_ACT;
constexpr size_t WS_MN   = WS_ACT + 64 * MiB;
constexpr size_t WS_ZM   = WS_ACT + 72 * MiB;
constexpr size_t WS_G    = WS_ACT + 136 * MiB;
constexpr size_t WS_UT   = WS_ACT + 328 * MiB;
constexpr size_t WS_KMEM = WS_ACT + 344 * MiB;
constexpr size_t WS_VT   = WS_ACT + 346 * MiB;
constexpr size_t WS_ACAT = WS_ACT + 348 * MiB;
constexpr size_t WS_MG   = WS_ACT + 428 * MiB;
constexpr size_t WS_H2   = WS_ACT;
constexpr size_t WS_XIN  = WS_ACT + 64 * MiB;
constexpr size_t WS_HID  = WS_ACT + 192 * MiB;
constexpr size_t WS_AFF  = WS_ACT + 320 * MiB;
constexpr size_t WS_SELW = WS_ACT + 321 * MiB;
constexpr size_t WS_INV  = WS_ACT + 322 * MiB;
constexpr size_t WS_END  = WS_ACT + 492 * MiB;

constexpr int LDS_BYTES = 147456;

#define LDS_WAIT() asm volatile("s_waitcnt lgkmcnt(0)" ::: "memory")
#define VM_WAIT() asm volatile("s_waitcnt vmcnt(0)" ::: "memory")
__device__ __forceinline__ unsigned f2bf(float f) { unsigned u = __builtin_bit_cast(unsigned, f); return (u + 0x7fffu + ((u >> 16) & 1u)) >> 16; }
__device__ __forceinline__ unsigned pk2(float lo, float hi) { return f2bf(lo) | (f2bf(hi) << 16); }
typedef __bf16 bf16x2_t __attribute__((ext_vector_type(2)));
__device__ __forceinline__ unsigned cvt_pk_bf16(float lo, float hi) { const bf16x2_t v = __builtin_convertvector((f32x2){lo, hi}, bf16x2_t); return __builtin_bit_cast(unsigned, v); }
__device__ __forceinline__ float bf_lo(unsigned w) { return __builtin_bit_cast(float, w << 16); }
__device__ __forceinline__ float bf_hi(unsigned w) { return __builtin_bit_cast(float, w & 0xffff0000u); }
__device__ __forceinline__ float wave_sum(float v) {
#pragma unroll
    for (int o = 1; o < 64; o <<= 1) v += __shfl_xor(v, o);
    return v;
}
__device__ __forceinline__ float fast_sigmoid(float v) { return __builtin_amdgcn_rcpf(1.0f + __builtin_amdgcn_exp2f(-1.44269504089f * v)); }


#define XB_TMO      128
#define XB_XCNT(j)  (256  + 64 * (j))
#define XB_XSUB(j)  (1280 + 64 * (j))
#define XB_XGEN(j)  (2304 + 64 * (j))
#define XB_TOP      3328
#define XB_TOPGEN   3392
#define XCD_BAR_WORDS 3456
#define XB_SPIN_CAP (1u << 18)
__device__ __forceinline__ unsigned xb_ld(unsigned* p)              { return __hip_atomic_load(p, __ATOMIC_RELAXED, __HIP_MEMORY_SCOPE_AGENT); }
__device__ __forceinline__ unsigned xb_add(unsigned* p, unsigned v) { return __hip_atomic_fetch_add(p, v, __ATOMIC_RELAXED, __HIP_MEMORY_SCOPE_AGENT); }
__device__ __forceinline__ unsigned xb_xcc_id() { return (unsigned)__builtin_amdgcn_s_getreg((3 << 11) | 20) & 0xFu; }
#define XB_SPIN(cond, bar) do { unsigned _sp = 0; while (cond) { __builtin_amdgcn_s_sleep(1); \
    if ((++_sp & 255u) == 0u) { if (xb_ld(&(bar)[XB_TMO])) break; if (_sp > XB_SPIN_CAP) { atomicAdd(&(bar)[XB_TMO], 1u); break; } } } } while (0)
struct XcdBarrier { unsigned* bar; unsigned x; volatile LAS unsigned* st; };
__device__ __forceinline__ XcdBarrier xcd_barrier_post(unsigned* bar, volatile LAS unsigned* st) {
    XcdBarrier b; b.bar = bar; b.x = xb_xcc_id(); b.st = st;
    if (threadIdx.x == 0) (void)xb_add(&bar[XB_XCNT(b.x)], 1u);
    return b;
}
__device__ __forceinline__ void xcd_barrier_complete(unsigned* bar, unsigned x, unsigned& nloc, unsigned& nx) {
    const unsigned G = gridDim.x * gridDim.y * gridDim.z;
    unsigned sum, cnt, mine, sp = 0u;
    for (;;) {
        sum = 0u; cnt = 0u; mine = 0u;
#pragma unroll
        for (unsigned j = 0; j < 16; ++j) { const unsigned c = xb_ld(&bar[XB_XCNT(j)]); sum += c; cnt += (c > 0u) ? 1u : 0u; mine = (j == x) ? c : mine; }
        if (sum == G) break;
        __builtin_amdgcn_s_sleep(1);
        if ((++sp & 255u) == 0u) { if (xb_ld(&bar[XB_TMO])) break; if (sp > XB_SPIN_CAP) { atomicAdd(&bar[XB_TMO], 1u); break; } }
    }
    nloc = mine > 0u ? mine : 1u; nx = cnt > 0u ? cnt : 1u;
}
__device__ __forceinline__ void xcd_barrier(const XcdBarrier& b) {
    asm volatile("s_waitcnt vmcnt(0)" ::: "memory");
    __syncthreads();
    if (threadIdx.x == 0) {
        unsigned* bar = b.bar;
        __builtin_amdgcn_s_waitcnt(0);
        unsigned nloc = b.st[0], nx = b.st[1];
        if (nloc == 0u) { xcd_barrier_complete(bar, b.x, nloc, nx); b.st[0] = nloc; b.st[1] = nx; }
        const unsigned old = xb_add(&bar[XB_XSUB(b.x)], 1u);
        const unsigned gen = old / nloc;
        if (old + 1u == (gen + 1u) * nloc) {
            __builtin_amdgcn_fence(__ATOMIC_RELEASE, "agent");
            asm volatile("s_waitcnt vmcnt(0)" ::: "memory");
            const unsigned og = xb_add(&bar[XB_TOP], 1u);
            const unsigned tg = og / nx;
            if (og + 1u == (tg + 1u) * nx) xb_add(&bar[XB_TOPGEN], 1u);
            else XB_SPIN(xb_ld(&bar[XB_TOPGEN]) == tg, bar);
            __builtin_amdgcn_fence(__ATOMIC_ACQUIRE, "agent");
            xb_add(&bar[XB_XGEN(b.x)], 1u);
            asm volatile("s_waitcnt vmcnt(0)" ::: "memory");
        } else {
            XB_SPIN(xb_ld(&bar[XB_XGEN(b.x)]) == gen, bar);
            __builtin_amdgcn_fence(__ATOMIC_ACQUIRE, "agent");
            asm volatile("s_waitcnt vmcnt(0)" ::: "memory");
        }
    }
    __syncthreads();
}

namespace pg8 {
constexpr int BM = 256, BK = 64, HALF = 128, HTB = HALF * BK * 2, STAGE_BYTES = 8 * HTB;
__device__ __forceinline__ int lds_byte(int r, int c) { const int st = (r >> 4) * 2 + (c >> 5), rr = r & 15, cc = c & 31, ob = rr * 64 + cc * 2; return st * 1024 + (ob ^ (((ob >> 9) & 1) << 5)); }
__device__ __forceinline__ void stage_rc(int b, int& R, int& C) { const int st = b / 1024, sb = b % 1024, swz = sb ^ (((sb >> 9) & 1) << 5); R = (st >> 1) * 16 + swz / 64; C = (st & 1) * 32 + (swz % 64) / 2; }
__device__ __forceinline__ int perm32(int rho) { const int n = rho >> 4, i = rho & 15; return 8 * (i >> 2) + 4 * n + (i & 3); }

struct Unit { const char* A; const char* B0; const char* B1; int nt; int r0, c0, aux; };

__device__ __forceinline__ void tile_order(int L, int nM, int nN, int& pm, int& pn) {
    const int nwg = nM * nN;
    int wgid = L; { const int q = nwg / 8, r = nwg % 8, xcd = wgid % 8, off = wgid / 8; wgid = (xcd < r ? xcd * (q + 1) : r * (q + 1) + (xcd - r) * q) + off; }
    const int nig = 8 * nN, gid = wgid / nig, fm = gid * 8, gsz = (nM - fm) < 8 ? (nM - fm) : 8;
    pm = fm + ((wgid % nig) % gsz); pn = (wgid % nig) / gsz;
}

template <class Epi, class Sched>
__device__ __forceinline__ void gemm_phase(LAS unsigned char* lds, const int lda, const int ldb, const Sched& S, const Epi& E) {
    const int tid = threadIdx.x, wid = __builtin_amdgcn_readfirstlane(tid >> 6), lane = tid & 63, wr = wid >> 2, wc = wid & 3, fr = lane & 15, fq = lane >> 4;
    unsigned voffA[2], voffB[2];
#pragma unroll
    for (int i = 0; i < 2; ++i) { int R, C; stage_rc(tid * 16 + i * 8192, R, C); const int Rb = (R & ~31) + perm32(R & 31);
        voffA[i] = (unsigned)(R * lda + C) * 2u; voffB[i] = (unsigned)(Rb * ldb + C) * 2u; }
    const size_t kstep = (size_t)(BK * 2);
    const size_t hstepA = (size_t)HALF * lda * 2;
    const unsigned ldsw = (unsigned)wid * 1024u;
    const int aoff = lds_byte(wr * 64 + fr, fq * 8), boff = lds_byte(wc * 32 + fr, fq * 8);
#define PG8_SA(b, h) (((b) * 2 + (h)) * HTB)
#define PG8_SB(b, h) ((4 + (b) * 2 + (h)) * HTB)
#define PG8_STAGE(bufoff, gbase, voff) do { _Pragma("unroll") for (int _i = 0; _i < 2; ++_i) \
        __builtin_amdgcn_global_load_lds((const unsigned*)((const char*)(gbase) + (voff)[_i]), (LAS unsigned*)(lds + (bufoff) + ldsw + _i * 8192), 16, 0, 0); } while (0)
#define PG8_LDA(dst, b, h) do { _Pragma("unroll") for (int m = 0; m < 4; ++m) _Pragma("unroll") for (int k = 0; k < 2; ++k) dst[m][k] = *(const LAS bf16x8*)(lds + PG8_SA(b, h) + aoff + m * 2048 + k * 1024); } while (0)
#define PG8_LDB(dst, b, h) do { _Pragma("unroll") for (int n = 0; n < 2; ++n) _Pragma("unroll") for (int k = 0; k < 2; ++k) dst[n][k] = *(const LAS bf16x8*)(lds + PG8_SB(b, h) + boff + n * 2048 + k * 1024); } while (0)
#define PG8_MMA(ai, bj, At, Bt) do { __builtin_amdgcn_s_setprio(1); _Pragma("unroll") for (int m = 0; m < 4; ++m) _Pragma("unroll") for (int n = 0; n < 2; ++n) _Pragma("unroll") for (int k = 0; k < 2; ++k) \
        acc[ai][bj][m][n] = __builtin_amdgcn_mfma_f32_16x16x32_bf16(Bt[n][k], At[m][k], acc[ai][bj][m][n], 0, 0, 0); __builtin_amdgcn_s_setprio(0); } while (0)
#define PG8_WAIT_V(n) asm volatile("s_waitcnt vmcnt(" #n ")" ::: "memory")
#define PG8_WAIT_L(n) asm volatile("s_waitcnt lgkmcnt(" #n ")" ::: "memory")
#define PG8_BAR __builtin_amdgcn_s_barrier()
#define PG8_SCHED __builtin_amdgcn_sched_barrier(0)
    Unit cur, nxt; int ui = 0;
    if (!S.next(0, cur)) return;
    f32x4 acc[2][2][4][2];
#pragma unroll
    for (int a = 0; a < 2; ++a)
#pragma unroll
        for (int b = 0; b < 2; ++b)
#pragma unroll
            for (int m = 0; m < 4; ++m)
#pragma unroll
                for (int n = 0; n < 2; ++n) acc[a][b][m][n] = (f32x4){0.f, 0.f, 0.f, 0.f};
    bf16x8 At[4][2], B0[2][2], B1[2][2];
    const char* cA = cur.A; const char* cB0 = cur.B0; const char* cB1 = cur.B1;
    PG8_STAGE(PG8_SB(0, 0), cB0, voffB); PG8_STAGE(PG8_SB(0, 1), cB1, voffB); PG8_STAGE(PG8_SA(0, 0), cA, voffA); PG8_STAGE(PG8_SA(0, 1), cA + hstepA, voffA);
    if (wr == 1) PG8_BAR;
    PG8_WAIT_V(2); PG8_BAR;
    PG8_STAGE(PG8_SB(1, 0), cB0 + kstep, voffB); PG8_STAGE(PG8_SA(1, 0), cA + kstep, voffA); PG8_STAGE(PG8_SB(1, 1), cB1 + kstep, voffB);
    PG8_WAIT_V(6); PG8_BAR;
    for (;;) {
        const bool has_next = S.next(ui + 1, nxt);
        const char* nA = has_next ? nxt.A : cA; const char* nB0 = has_next ? nxt.B0 : cB0; const char* nB1 = has_next ? nxt.B1 : cB1;
        const int nt = cur.nt;
        for (int t = 0; t < nt; t += 2) {
            const bool last = (t == nt - 2);
            const char* a1 = cA + (size_t)(t + 1) * kstep;
            const char* a2 = last ? nA : cA + (size_t)(t + 2) * kstep;
            const char* b20 = last ? nB0 : cB0 + (size_t)(t + 2) * kstep; const char* b21 = last ? nB1 : cB1 + (size_t)(t + 2) * kstep;
            const char* a3 = a2 + kstep; const char* b30 = b20 + kstep; const char* b31 = b21 + kstep;
            PG8_LDB(B0, 0, 0); PG8_LDB(B1, 0, 1); PG8_SCHED; PG8_LDA(At, 0, 0); PG8_STAGE(PG8_SA(1, 1), a1 + hstepA, voffA);
            PG8_WAIT_V(8); PG8_WAIT_L(0); PG8_BAR; PG8_MMA(0, 0, At, B0); PG8_MMA(0, 1, At, B1); PG8_BAR; PG8_SCHED;
            PG8_LDA(At, 0, 1); PG8_STAGE(PG8_SB(0, 0), b20, voffB); PG8_STAGE(PG8_SB(0, 1), b21, voffB); PG8_STAGE(PG8_SA(0, 0), a2, voffA);
            PG8_WAIT_V(8); PG8_WAIT_L(0); PG8_BAR; PG8_MMA(1, 0, At, B0); PG8_MMA(1, 1, At, B1); PG8_BAR; PG8_SCHED;
            PG8_LDB(B0, 1, 0); PG8_LDB(B1, 1, 1); PG8_SCHED; PG8_LDA(At, 1, 0); PG8_STAGE(PG8_SA(0, 1), a2 + hstepA, voffA);
            PG8_WAIT_V(8); PG8_WAIT_L(0); PG8_BAR; PG8_MMA(0, 0, At, B0); PG8_MMA(0, 1, At, B1); PG8_BAR; PG8_SCHED;
            PG8_LDA(At, 1, 1); PG8_STAGE(PG8_SB(1, 0), b30, voffB); PG8_STAGE(PG8_SB(1, 1), b31, voffB); PG8_STAGE(PG8_SA(1, 0), a3, voffA);
            PG8_WAIT_V(8); PG8_WAIT_L(0); PG8_BAR; PG8_MMA(1, 0, At, B0); PG8_MMA(1, 1, At, B1); PG8_BAR; PG8_SCHED;
        }
        if (wr == 0) PG8_BAR;
        E(acc, cur, wr, wc, fr, fq);
        if (!has_next) break;
#pragma unroll
        for (int a = 0; a < 2; ++a)
#pragma unroll
            for (int b = 0; b < 2; ++b)
#pragma unroll
                for (int m = 0; m < 4; ++m)
#pragma unroll
                    for (int n = 0; n < 2; ++n) acc[a][b][m][n] = (f32x4){0.f, 0.f, 0.f, 0.f};
        cur = nxt; cA = nA; cB0 = nB0; cB1 = nB1; ++ui;
        if (wr == 1) PG8_BAR;
    }
    PG8_WAIT_V(0);
    PG8_BAR;
#undef PG8_SA
#undef PG8_SB
#undef PG8_STAGE
#undef PG8_LDA
#undef PG8_LDB
#undef PG8_MMA
#undef PG8_WAIT_V
#undef PG8_WAIT_L
#undef PG8_BAR
#undef PG8_SCHED
}

struct EpiBf16 {
    bf16_t* O; int ldc; const float* rowscale;
    __device__ __forceinline__ void operator()(const f32x4 (&acc)[2][2][4][2], const Unit& u, int wr, int wc, int fr, int fq) const {
        const int row0 = u.r0 + wr * 64 + fr, col0 = u.c0 + wc * 32 + 8 * fq;
#pragma unroll
        for (int ai = 0; ai < 2; ++ai)
#pragma unroll
            for (int m = 0; m < 4; ++m) { const int row = row0 + ai * HALF + m * 16; const float sc = rowscale ? rowscale[row] : 1.f;
                bf16_t* rowp = O + (size_t)row * ldc + col0;
#pragma unroll
                for (int bj = 0; bj < 2; ++bj) { const f32x4 v0 = acc[ai][bj][m][0] * sc, v1 = acc[ai][bj][m][1] * sc;
                    u32x4 w; w.x = cvt_pk_bf16(v0[0], v0[1]); w.y = cvt_pk_bf16(v0[2], v0[3]); w.z = cvt_pk_bf16(v1[0], v1[1]); w.w = cvt_pk_bf16(v1[2], v1[3]);
                    *(u32x4*)(rowp + bj * HALF) = w; } }
    }
};
struct EpiZ {
    bf16_t* ZM; bf16_t* UT; bf16_t* G;
    __device__ __forceinline__ void operator()(const f32x4 (&acc)[2][2][4][2], const Unit& u, int wr, int wc, int fr, int fq) const {
        const int row0 = u.r0 + wr * 64 + fr, col0 = u.c0 + wc * 32 + 8 * fq;
        if (u.c0 >= 2048) {
#pragma unroll
            for (int ai = 0; ai < 2; ++ai)
#pragma unroll
                for (int m = 0; m < 4; ++m) { bf16_t* rowp = G + (size_t)(row0 + ai * HALF + m * 16) * 6144 + (col0 - 2048);
#pragma unroll
                    for (int bj = 0; bj < 2; ++bj) { const f32x4 a0 = acc[ai][bj][m][0], a1 = acc[ai][bj][m][1];
                        u32x4 w; w.x = cvt_pk_bf16(fast_sigmoid(a0[0]), fast_sigmoid(a0[1])); w.y = cvt_pk_bf16(fast_sigmoid(a0[2]), fast_sigmoid(a0[3]));
                        w.z = cvt_pk_bf16(fast_sigmoid(a1[0]), fast_sigmoid(a1[1])); w.w = cvt_pk_bf16(fast_sigmoid(a1[2]), fast_sigmoid(a1[3]));
                        *(u32x4*)(rowp + bj * HALF) = w; } }
        } else if (u.c0 >= 1024 && u.c0 < 1536) {
#pragma unroll
            for (int ai = 0; ai < 2; ++ai)
#pragma unroll
                for (int m = 0; m < 4; ++m) { const int row = row0 + ai * HALF + m * 16; const int b = row >> 11, s = row & 2047;
                    bf16_t* base = UT + ((size_t)b * 512 + (col0 - 1024)) * 2048 + s;
#pragma unroll
                    for (int bj = 0; bj < 2; ++bj)
#pragma unroll
                        for (int n = 0; n < 2; ++n)
#pragma unroll
                            for (int j = 0; j < 4; ++j) base[(size_t)(bj * HALF + 4 * n + j) * 2048] = (bf16_t)f2bf(acc[ai][bj][m][n][j]); }
        } else {
#pragma unroll
            for (int ai = 0; ai < 2; ++ai)
#pragma unroll
                for (int m = 0; m < 4; ++m) { bf16_t* rowp = ZM + (size_t)(row0 + ai * HALF + m * 16) * 2048 + col0;
#pragma unroll
                    for (int bj = 0; bj < 2; ++bj) { const f32x4 v0 = acc[ai][bj][m][0], v1 = acc[ai][bj][m][1];
                        u32x4 w; w.x = cvt_pk_bf16(v0[0], v0[1]); w.y = cvt_pk_bf16(v0[2], v0[3]); w.z = cvt_pk_bf16(v1[0], v1[1]); w.w = cvt_pk_bf16(v1[2], v1[3]);
                        *(u32x4*)(rowp + bj * HALF) = w; } }
        }
    }
};
struct EpiGate {
    bf16_t* MG; const bf16_t* G;
    __device__ __forceinline__ void operator()(const f32x4 (&acc)[2][2][4][2], const Unit& u, int wr, int wc, int fr, int fq) const {
        const int row0 = u.r0 + wr * 64 + fr, col0 = u.c0 + wc * 32 + 8 * fq; int s = u.aux;
        const int gs = s; if (DBG_ONLY_BRANCH >= 0) { if (s != DBG_ONLY_BRANCH) return; s = 0; }
#pragma unroll
        for (int ai = 0; ai < 2; ++ai)
#pragma unroll
            for (int m = 0; m < 4; ++m) { const int row = row0 + ai * HALF + m * 16;
                bf16_t* mp = MG + (size_t)row * 2048 + col0; const bf16_t* gp = G + (size_t)row * 6144 + gs * 2048 + col0;
#pragma unroll
                for (int bj = 0; bj < 2; ++bj) { const u32x4 g = *(const u32x4*)(gp + bj * HALF);
                    u32x4 o = (u32x4){0u, 0u, 0u, 0u}; if (s > 0) o = *(const u32x4*)(mp + bj * HALF);
                    const f32x4 a0 = acc[ai][bj][m][0], a1 = acc[ai][bj][m][1];
                    u32x4 w;
                    w.x = cvt_pk_bf16(bf_lo(o.x) + bf_lo(g.x) * a0[0], bf_hi(o.x) + bf_hi(g.x) * a0[1]);
                    w.y = cvt_pk_bf16(bf_lo(o.y) + bf_lo(g.y) * a0[2], bf_hi(o.y) + bf_hi(g.y) * a0[3]);
                    w.z = cvt_pk_bf16(bf_lo(o.z) + bf_lo(g.z) * a1[0], bf_hi(o.z) + bf_hi(g.z) * a1[1]);
                    w.w = cvt_pk_bf16(bf_lo(o.w) + bf_lo(g.w) * a1[2], bf_hi(o.w) + bf_hi(g.w) * a1[3]);
                    *(u32x4*)(mp + bj * HALF) = w; } }
    }
};
struct EpiResid {
    const float* X; float* O;
    __device__ __forceinline__ void operator()(const f32x4 (&acc)[2][2][4][2], const Unit& u, int wr, int wc, int fr, int fq) const {
        const int row0 = u.r0 + wr * 64 + fr, col0 = u.c0 + wc * 32 + 8 * fq;
#pragma unroll
        for (int ai = 0; ai < 2; ++ai)
#pragma unroll
            for (int m = 0; m < 4; ++m) { const size_t off = (size_t)(row0 + ai * HALF + m * 16) * 2048 + col0;
#pragma unroll
                for (int bj = 0; bj < 2; ++bj)
#pragma unroll
                    for (int n = 0; n < 2; ++n) { const f32x4 xv = *(const f32x4*)(X + off + bj * HALF + 4 * n); *(f32x4*)(O + off + bj * HALF + 4 * n) = xv + acc[ai][bj][m][n]; } }
    }
};
struct EpiSwiGLU {
    bf16_t* H;
    __device__ __forceinline__ void operator()(const f32x4 (&acc)[2][2][4][2], const Unit& u, int wr, int wc, int fr, int fq) const {
        const int row0 = u.r0 + wr * 64 + fr, col0 = u.c0 + wc * 32 + 8 * fq;
#pragma unroll
        for (int ai = 0; ai < 2; ++ai)
#pragma unroll
            for (int m = 0; m < 4; ++m) { bf16_t* rowp = H + (size_t)(row0 + ai * HALF + m * 16) * 2048 + col0;
                float h[8];
#pragma unroll
                for (int n = 0; n < 2; ++n)
#pragma unroll
                    for (int j = 0; j < 4; ++j) { const float g = acc[ai][0][m][n][j], up = acc[ai][1][m][n][j]; h[4 * n + j] = g * fast_sigmoid(g) * up; }
                u32x4 w; w.x = cvt_pk_bf16(h[0], h[1]); w.y = cvt_pk_bf16(h[2], h[3]); w.z = cvt_pk_bf16(h[4], h[5]); w.w = cvt_pk_bf16(h[6], h[7]);
                *(u32x4*)rowp = w; }
    }
};
}

struct Args {
    const float* x; const float* mem; const float* norm_mix_g; const float* norm_mem_g; const float* w_in; const float* pool_w; const float* pool_scale; const float* fourier_w;
    const float* w_kv; const float* proj_pool; const float* proj_fourier; const float* proj_mem; const float* w_out; const float* norm_ffn_g; const float* w_router;
    const float* w_gate; const float* w_up; const float* w_down; const float* norm_final_g;
    float* out; unsigned char* ws; int ph_lo, ph_hi;
};

__device__ __forceinline__ void p0_transpose_item(const float* W, int N, int k0, int n0, bf16_t* WT, int ldt, int drow0, const float* kscale, LAS float* scr, int lane) {
#pragma unroll 8
    for (int i = 0; i < 32; ++i) { const int kk = 2 * i + (lane >> 5); float v = W[(size_t)(k0 + kk) * N + n0 + (lane & 31)]; if (kscale) v *= kscale[k0 + kk]; scr[kk * 33 + (lane & 31)] = v; }
    LDS_WAIT(); asm volatile("" ::: "memory");
    const int c = lane & 7;
#pragma unroll
    for (int j = 0; j < 4; ++j) { const int n = (lane >> 3) + 8 * j; const LAS float* s = scr + (8 * c) * 33 + n;
        u32x4 o; o.x = pk2(s[0 * 33], s[1 * 33]); o.y = pk2(s[2 * 33], s[3 * 33]); o.z = pk2(s[4 * 33], s[5 * 33]); o.w = pk2(s[6 * 33], s[7 * 33]);
        *(u32x4*)(WT + (size_t)(drow0 + n) * ldt + k0 + 8 * c) = o; }
    LDS_WAIT(); asm volatile("" ::: "memory");
}
__device__ __forceinline__ void rms_row_to_bf16(const float* xrow, const float* g, bf16_t* orow, int lane) {
    const f32x4* xr = (const f32x4*)xrow + lane; const f32x4* gr = (const f32x4*)g + lane;
    f32x4 v[8]; float s = 0.f;
#pragma unroll
    for (int j = 0; j < 8; ++j) { v[j] = xr[64 * j]; s += (v[j].x * v[j].x + v[j].y * v[j].y) + (v[j].z * v[j].z + v[j].w * v[j].w); }
    const float inv = 1.0f / sqrtf(wave_sum(s) * (1.f / DM) + EPS);
    u32x2* o8 = (u32x2*)orow + lane;
#pragma unroll
    for (int j = 0; j < 8; ++j) { const f32x4 gg = gr[64 * j]; u32x2 w; w.x = pk2(v[j].x * inv * gg.x, v[j].y * inv * gg.y); w.y = pk2(v[j].z * inv * gg.z, v[j].w * inv * gg.w); o8[64 * j] = w; }
}

__device__ __forceinline__ void phase0(const Args& a, LAS unsigned char* lds, int gw, int NGW, int wave, int lane) {
    unsigned char* ws = a.ws;
    LAS float* scr = (LAS float*)(lds + wave * 16384);
    constexpr int I_WIN = 32 * 256, I_KV = 32 * 32, I_PP = 16 * 64, I_PF = 8 * 64, I_PM = 8 * 64, I_WO = 32 * 64, I_EX = 32 * 64;
    constexpr int NSMALL = I_WIN + I_KV + I_PP + I_PF + I_PM + I_WO;
    constexpr int NITEMS = NSMALL + 48 * I_EX;
    for (int it = gw; it < NITEMS; it += NGW) {
        int r = it;
        if (r >= NSMALL) { r -= NSMALL; const int mat = r / I_EX, w = r % I_EX, type = mat / 16, e = mat % 16; const int kb = w / 64, nb = w % 64, n0 = nb * 32;
            const float* src = (type == 0 ? a.w_gate : (type == 1 ? a.w_up : a.w_down)) + (size_t)e * 2048 * 2048;
            if (type < 2) p0_transpose_item(src, 2048, kb * 64, n0, (bf16_t*)(ws + WS_WGUT) + (size_t)e * 4096 * 2048, 2048, ((n0 >> 7) << 8) + (n0 & 127) + (type == 1 ? 128 : 0), nullptr, scr, lane);
            else p0_transpose_item(src, 2048, kb * 64, n0, (bf16_t*)(ws + WS_WDT) + (size_t)e * 2048 * 2048, 2048, n0, nullptr, scr, lane);
            continue; }
        if (r < I_WIN) { const int kb = r / 256, nb = r % 256; p0_transpose_item(a.w_in, 8192, kb * 64, nb * 32, (bf16_t*)(ws + WS_WINT), 2048, nb * 32, nullptr, scr, lane); continue; } r -= I_WIN;
        if (r < I_KV) { const int kb = r / 32, nb = r % 32; p0_transpose_item(a.w_kv, 1024, kb * 64, nb * 32, (bf16_t*)(ws + WS_WKVT), 2048, nb * 32, nullptr, scr, lane); continue; } r -= I_KV;
        if (r < I_PP) { const int kb = r / 64, nb = r % 64; p0_transpose_item(a.proj_pool, 2048, kb * 64, nb * 32, (bf16_t*)(ws + WS_PPST), 1024, nb * 32, a.pool_scale, scr, lane); continue; } r -= I_PP;
        if (r < I_PF) { const int kb = r / 64, nb = r % 64; p0_transpose_item(a.proj_fourier, 2048, kb * 64, nb * 32, (bf16_t*)(ws + WS_PFT), 1024, nb * 32, nullptr, scr, lane); continue; } r -= I_PF;
        if (r < I_PM) { const int kb = r / 64, nb = r % 64; p0_transpose_item(a.proj_mem, 2048, kb * 64, nb * 32, (bf16_t*)(ws + WS_BCAT) + 2048, 2560, nb * 32, nullptr, scr, lane); continue; } r -= I_PM;
        { const int kb = r / 64, nb = r % 64; p0_transpose_item(a.w_out, 2048, kb * 64, nb * 32, (bf16_t*)(ws + WS_WOT), 2048, nb * 32, nullptr, scr, lane); }
    }
    for (int m = gw; m < T; m += NGW) rms_row_to_bf16(a.x + (size_t)m * DM, a.norm_mix_g, (bf16_t*)(ws + WS_XN) + (size_t)m * DM, lane);
    for (int m = gw; m < NBATCH * MEML; m += NGW) rms_row_to_bf16(a.mem + (size_t)m * DM, a.norm_mem_g, (bf16_t*)(ws + WS_MN) + (size_t)m * DM, lane);
    const int gt = gw * 64 + lane, NGT = NGW * 64;
    for (int i = gt; i < 1024 * 128; i += NGT) { const int row = i >> 7, col = (i & 127) * 8, g = row >> 8, c = row & 255;
        u32x4 o = (u32x4){0u, 0u, 0u, 0u};
        if ((col >> 8) == g) { const float* p = a.pool_w + ((size_t)g * 256 + c) * 256 + (col & 255); const f32x4 v0 = *(const f32x4*)p, v1 = *(const f32x4*)(p + 4);
            o.x = pk2(v0.x, v0.y); o.y = pk2(v0.z, v0.w); o.z = pk2(v1.x, v1.y); o.w = pk2(v1.z, v1.w); }
        *(u32x4*)((bf16_t*)(ws + WS_PWBD) + (size_t)row * 1024 + col) = o; }
    for (int i = gt; i < 1024 * 512; i += NGT) { const int row = i >> 9, col = i & 511, cs = row >> 9, g = (row >> 7) & 3, c = row & 127, g2 = col >> 7, d = col & 127;
        float v = 0.f;
        if (g2 == g) { const float* fw = a.fourier_w + (size_t)g * 128 * 128 + d;
            for (int j = 0; j < 128; ++j) { const float ang = (float)((c * j) & 127) * (1.0f / 64.0f); const float tw = cs ? -sinpif(ang) : cospif(ang); v += tw * fw[(size_t)j * 128]; } }
        ((bf16_t*)(ws + WS_M1BD))[(size_t)row * 1024 + col] = (bf16_t)f2bf(v); }
    for (int i = gt; i < 4096 * 256; i += NGT) { const int row = i >> 8, s0 = (i & 255) * 8, cs = row >> 11, k = row & 2047;
        float v[8];
#pragma unroll
        for (int j = 0; j < 8; ++j) { const float ang = (float)((k * (s0 + j)) & 2047) * (1.0f / 1024.0f); v[j] = (cs ? sinpif(ang) : cospif(ang)) * (1.0f / 512.0f); }
        u32x4 o; o.x = pk2(v[0], v[1]); o.y = pk2(v[2], v[3]); o.z = pk2(v[4], v[5]); o.w = pk2(v[6], v[7]);
        *(u32x4*)((bf16_t*)(ws + WS_TW) + (size_t)row * 2048 + s0) = o; }
}

__device__ __forceinline__ void pool_pass(const Args& a, int gw, int NGW, int lane) {
    const bf16_t* ZM = (const bf16_t*)(a.ws + WS_ZM); bf16_t* AC = (bf16_t*)(a.ws + WS_ACAT);
    for (int it = gw; it < 2048; it += NGW) {
        const int run = it >> 1, hf = it & 1, chunk = hf * 64 + lane, ch0 = chunk * 8, g = chunk >> 5, hw = 1 << g;
        const int t0 = run * 16, b = t0 >> 11, s0 = t0 & 2047; const bf16_t* base = ZM + (size_t)b * SEQ * 2048 + ch0;
        float sum[8];
#pragma unroll
        for (int j = 0; j < 8; ++j) sum[j] = 0.f;
        for (int d = -8; d < 8; ++d) { const int s = s0 + d; if (d >= -hw && d < hw && s >= 0 && s < SEQ) { const u32x4 w = *(const u32x4*)(base + (size_t)s * 2048);
            sum[0] += bf_lo(w.x); sum[1] += bf_hi(w.x); sum[2] += bf_lo(w.y); sum[3] += bf_hi(w.y); sum[4] += bf_lo(w.z); sum[5] += bf_hi(w.z); sum[6] += bf_lo(w.w); sum[7] += bf_hi(w.w); } }
        for (int i = 0; i < 16; ++i) { const int s = s0 + i; const int lo = (s - hw) < 0 ? 0 : (s - hw), hi = (s + hw) > SEQ ? SEQ : (s + hw); const float rc = 1.0f / (float)(hi - lo);
            const u32x4 c = *(const u32x4*)(base + (size_t)s * 2048);
            u32x4 o; o.x = pk2(sum[0] * rc - bf_lo(c.x), sum[1] * rc - bf_hi(c.x)); o.y = pk2(sum[2] * rc - bf_lo(c.y), sum[3] * rc - bf_hi(c.y));
            o.z = pk2(sum[4] * rc - bf_lo(c.z), sum[5] * rc - bf_hi(c.z)); o.w = pk2(sum[6] * rc - bf_lo(c.w), sum[7] * rc - bf_hi(c.w));
            *(u32x4*)(AC + (size_t)(t0 + i) * 2560 + ch0) = o;
            if (s + hw < SEQ) { const u32x4 w = *(const u32x4*)(base + (size_t)(s + hw) * 2048);
                sum[0] += bf_lo(w.x); sum[1] += bf_hi(w.x); sum[2] += bf_lo(w.y); sum[3] += bf_hi(w.y); sum[4] += bf_lo(w.z); sum[5] += bf_hi(w.z); sum[6] += bf_lo(w.w); sum[7] += bf_hi(w.w); }
            if (s - hw >= 0) { const u32x4 w = *(const u32x4*)(base + (size_t)(s - hw) * 2048);
                sum[0] -= bf_lo(w.x); sum[1] -= bf_hi(w.x); sum[2] -= bf_lo(w.y); sum[3] -= bf_hi(w.y); sum[4] -= bf_lo(w.z); sum[5] -= bf_hi(w.z); sum[6] -= bf_lo(w.w); sum[7] -= bf_hi(w.w); } }
    }
}

__device__ __forceinline__ void attn_unit(const Args& a, int b, int h, int qb, int wave, int lane) {
    const bf16_t* ZM = (const bf16_t*)(a.ws + WS_ZM); const bf16_t* KM = (const bf16_t*)(a.ws + WS_KMEM); const bf16_t* VT = (const bf16_t*)(a.ws + WS_VT); bf16_t* AC = (bf16_t*)(a.ws + WS_ACAT);
    const int l31 = lane & 31, hh = lane >> 5;
    const int t = b * SEQ + qb * 256 + wave * 32 + l31;
    bf16x8 qf[8];
    const bf16_t* qp = ZM + (size_t)t * 2048 + 1536 + h * 128 + 8 * hh;
#pragma unroll
    for (int ks = 0; ks < 8; ++ks) qf[ks] = *(const bf16x8*)(qp + 16 * ks);
    f32x16 sc[8];
    const bf16_t* kp = KM + (size_t)(b * MEML + l31) * 512 + h * 128 + 8 * hh;
#pragma unroll
    for (int kt = 0; kt < 8; ++kt) { f32x16 acc;
#pragma unroll
        for (int r = 0; r < 16; ++r) acc[r] = 0.f;
#pragma unroll
        for (int ks = 0; ks < 8; ++ks) { const bf16x8 kf = *(const bf16x8*)(kp + (size_t)(32 * kt) * 512 + 16 * ks); acc = __builtin_amdgcn_mfma_f32_32x32x16_bf16(kf, qf[ks], acc, 0, 0, 0); }
        sc[kt] = acc; }
    float mx = -3.0e38f;
#pragma unroll
    for (int kt = 0; kt < 8; ++kt)
#pragma unroll
        for (int r = 0; r < 16; ++r) mx = fmaxf(mx, sc[kt][r]);
    mx = fmaxf(mx, __shfl_xor(mx, 32));
    const float cs = 0.08838834764831845f * 1.44269504089f;
    float sum = 0.f;
#pragma unroll
    for (int kt = 0; kt < 8; ++kt)
#pragma unroll
        for (int r = 0; r < 16; ++r) { const float p = __builtin_amdgcn_exp2f((sc[kt][r] - mx) * cs); sc[kt][r] = p; sum += p; }
    sum += __shfl_xor(sum, 32);
    const float rinv = 1.0f / sum;
    bf16x8 pf[8][2];
#pragma unroll
    for (int kt = 0; kt < 8; ++kt)
#pragma unroll
        for (int s = 0; s < 2; ++s) { u32x4 w; w.x = cvt_pk_bf16(sc[kt][8 * s + 0], sc[kt][8 * s + 1]); w.y = cvt_pk_bf16(sc[kt][8 * s + 2], sc[kt][8 * s + 3]);
            w.z = cvt_pk_bf16(sc[kt][8 * s + 4], sc[kt][8 * s + 5]); w.w = cvt_pk_bf16(sc[kt][8 * s + 6], sc[kt][8 * s + 7]); pf[kt][s] = __builtin_bit_cast(bf16x8, w); }
#pragma unroll
    for (int dt = 0; dt < 4; ++dt) { f32x16 o;
#pragma unroll
        for (int r = 0; r < 16; ++r) o[r] = 0.f;
        const bf16_t* vp = VT + (size_t)(h * 128 + 32 * dt + l31) * 2048 + b * MEML + 4 * hh;
#pragma unroll
        for (int kt = 0; kt < 8; ++kt)
#pragma unroll
            for (int s = 0; s < 2; ++s) { const u32x2 v0 = *(const u32x2*)(vp + 32 * kt + 16 * s), v1 = *(const u32x2*)(vp + 32 * kt + 16 * s + 8);
                const u32x4 vv = (u32x4){v0.x, v0.y, v1.x, v1.y};
                o = __builtin_amdgcn_mfma_f32_32x32x16_bf16(__builtin_bit_cast(bf16x8, vv), pf[kt][s], o, 0, 0, 0); }
        bf16_t* op = AC + (size_t)t * 2560 + 2048 + h * 128 + 32 * dt + 4 * hh;
#pragma unroll
        for (int rg = 0; rg < 4; ++rg) { u32x2 w; w.x = cvt_pk_bf16(o[4 * rg + 0] * rinv, o[4 * rg + 1] * rinv); w.y = cvt_pk_bf16(o[4 * rg + 2] * rinv, o[4 * rg + 3] * rinv);
            *(u32x2*)(op + 8 * rg) = w; } }
}

__device__ __forceinline__ void router_phase(const Args& a, LAS unsigned char* lds, int vcu, int G, int wave, int lane, int tid) {
    LAS float* wrT = (LAS float*)lds;
    for (int i = tid; i < 2048 * 16; i += NTHR) { const int d = i >> 4, e = i & 15; wrT[e * 2048 + d] = a.w_router[i]; }
    __syncthreads();
    const float* X1 = a.out; bf16_t* H2 = (bf16_t*)(a.ws + WS_H2); float* AFF = (float*)(a.ws + WS_AFF);
    for (int gp = vcu * NWAVES + wave; gp < T / 2; gp += G * NWAVES) {
        const f32x4* xr0 = (const f32x4*)(X1 + (size_t)(2 * gp) * DM) + lane; const f32x4* xr1 = xr0 + DM / 4;
        float s0 = 0.f, s1 = 0.f;
#pragma unroll
        for (int j = 0; j < 8; ++j) { const f32x4 p = xr0[64 * j], q = xr1[64 * j]; s0 += (p.x * p.x + p.y * p.y) + (p.z * p.z + p.w * p.w); s1 += (q.x * q.x + q.y * q.y) + (q.z * q.z + q.w * q.w); }
        const float inv0 = 1.0f / sqrtf(wave_sum(s0) * (1.f / DM) + EPS), inv1 = 1.0f / sqrtf(wave_sum(s1) * (1.f / DM) + EPS);
        float lg[2][16];
#pragma unroll
        for (int e = 0; e < 16; ++e) { lg[0][e] = 0.f; lg[1][e] = 0.f; }
        u32x2* h0 = (u32x2*)(H2 + (size_t)(2 * gp) * DM) + lane; u32x2* h1 = h0 + DM / 4;
#pragma unroll 1
        for (int j = 0; j < 8; ++j) { const f32x4 gg = ((const f32x4*)a.norm_ffn_g)[64 * j + lane];
            const f32x4 p = xr0[64 * j] * inv0 * gg, q = xr1[64 * j] * inv1 * gg;
            u32x2 w0; w0.x = pk2(p.x, p.y); w0.y = pk2(p.z, p.w); h0[64 * j] = w0;
            u32x2 w1; w1.x = pk2(q.x, q.y); w1.y = pk2(q.z, q.w); h1[64 * j] = w1;
            const LAS float* wb = wrT + 256 * j + 4 * lane;
#pragma unroll
            for (int e = 0; e < 16; ++e) { const f32x4 w = *(const LAS f32x4*)(wb + e * 2048);
                lg[0][e] += (p.x * w.x + p.y * w.y) + (p.z * w.z + p.w * w.w);
                lg[1][e] += (q.x * w.x + q.y * w.y) + (q.z * w.z + q.w * w.w); } }
#pragma unroll
        for (int r = 0; r < 2; ++r) { float mx = -3.0e38f;
#pragma unroll
            for (int e = 0; e < 16; ++e) { lg[r][e] = wave_sum(lg[r][e]); mx = fmaxf(mx, lg[r][e]); }
            float sum = 0.f;
#pragma unroll
            for (int e = 0; e < 16; ++e) { lg[r][e] = __expf(lg[r][e] - mx); sum += lg[r][e]; }
            const float rs = 1.0f / sum; float mine = 0.f;
#pragma unroll
            for (int e = 0; e < 16; ++e) mine = (lane == e) ? lg[r][e] * rs : mine;
            const int t = 2 * gp + r, b = t >> 11, s = t & 2047;
            if (lane < 16) AFF[((size_t)b * 16 + lane) * SEQ + s] = mine; }
    }
}

__device__ __forceinline__ void topk_phase(const Args& a, LAS unsigned char* lds, int c, int wave, int lane, int tid) {
    if (c >= 256) return;
    const int b = c & 7, e = (c >> 3) & 15, hf = c >> 7;
    LAS float* af = (LAS float*)lds; LAS int* list = (LAS int*)(lds + 8192);
    const float* AFF = (const float*)(a.ws + WS_AFF) + ((size_t)b * 16 + e) * SEQ;
    for (int i = tid; i < SEQ; i += NTHR) af[i] = AFF[i];
    if (tid < CAP) list[tid] = -1;
    __syncthreads();
    const int s0 = hf * 1024 + tid * 2, s1 = s0 + 1; const float a0 = af[s0], a1 = af[s1];
    int c0 = 0, c1 = 0;
    for (int j = 0; j < SEQ; j += 4) { const f32x4 v = *(const LAS f32x4*)(af + j);
#pragma unroll
        for (int q = 0; q < 4; ++q) { const float vv = v[q]; const int jj = j + q;
            c0 += (vv > a0 || (vv == a0 && jj < s0)) ? 1 : 0; c1 += (vv > a1 || (vv == a1 && jj < s1)) ? 1 : 0; } }
    int* INV = (int*)(a.ws + WS_INV); float* SELW = (float*)(a.ws + WS_SELW);
    INV[((size_t)b * SEQ + s0) * 16 + e] = c0 < CAP ? c0 : -1;
    INV[((size_t)b * SEQ + s1) * 16 + e] = c1 < CAP ? c1 : -1;
    if (c0 < CAP) { list[c0] = s0; SELW[((size_t)e * 8 + b) * CAP + c0] = a0; }
    if (c1 < CAP) { list[c1] = s1; SELW[((size_t)e * 8 + b) * CAP + c1] = a1; }
    __syncthreads();
    const bf16_t* H2 = (const bf16_t*)(a.ws + WS_H2); bf16_t* XIN = (bf16_t*)(a.ws + WS_XIN);
    for (int slot = wave; slot < CAP; slot += NWAVES) { const int s = list[slot]; if (s < 0) continue;
        const u32x4* src = (const u32x4*)(H2 + ((size_t)b * SEQ + s) * DM) + lane; u32x4* dst = (u32x4*)(XIN + (((size_t)e * 8 + b) * CAP + slot) * DM) + lane;
        const u32x4 v0 = src[0], v1 = src[64], v2 = src[128], v3 = src[192]; dst[0] = v0; dst[64] = v1; dst[128] = v2; dst[192] = v3; }
    __syncthreads();
}

__device__ __forceinline__ void combine_phase(const Args& a, int gw, int NGW, int lane) {
    const bf16_t* Y = (const bf16_t*)(a.ws + WS_XIN); const int* INV = (const int*)(a.ws + WS_INV);
    for (int t = gw; t < T; t += NGW) { const int b = t >> 11;
        float* xr = a.out + (size_t)t * DM;
        f32x4 v[8];
#pragma unroll
        for (int j = 0; j < 8; ++j) v[j] = ((const f32x4*)xr)[64 * j + lane];
        const int myinv = DBG_SKIP_MOE ? -1 : INV[(size_t)t * 16 + (lane & 15)];
        for (int e = 0; e < 16; ++e) { const int slot = __shfl(myinv, e);
            if (slot >= 0) { const u32x2* yr = (const u32x2*)(Y + (((size_t)e * 8 + b) * CAP + slot) * DM);
#pragma unroll
                for (int j = 0; j < 8; ++j) { const u32x2 w = yr[64 * j + lane]; v[j].x += bf_lo(w.x); v[j].y += bf_hi(w.x); v[j].z += bf_lo(w.y); v[j].w += bf_hi(w.y); } } }
        float s = 0.f;
#pragma unroll
        for (int j = 0; j < 8; ++j) s += (v[j].x * v[j].x + v[j].y * v[j].y) + (v[j].z * v[j].z + v[j].w * v[j].w);
        const float inv = 1.0f / sqrtf(wave_sum(s) * (1.f / DM) + EPS);
#pragma unroll
        for (int j = 0; j < 8; ++j) { const f32x4 gg = ((const f32x4*)a.norm_final_g)[64 * j + lane]; ((f32x4*)xr)[64 * j + lane] = v[j] * inv * gg; }
    }
}

using pg8::Unit;
struct SchedFold {
    unsigned char* ws; int c;
    __device__ __forceinline__ bool next(int i, Unit& u) const {
        if (i > 0 || c >= 64) return false;
        const int L = c & 31, pm = L & 7, pn = L >> 3;
        if (c < 32) { u.A = (const char*)(ws + WS_PPST) + (size_t)pm * 256 * 1024 * 2; u.B0 = (const char*)(ws + WS_PWBD) + (size_t)pn * 256 * 1024 * 2; u.nt = 16; u.c0 = pn * 256; }
        else { u.A = (const char*)(ws + WS_PFT) + (size_t)pm * 256 * 1024 * 2; u.B0 = (const char*)(ws + WS_M1BD) + (size_t)pn * 256 * 1024 * 2; u.nt = 8; u.c0 = 1024 + pn * 256; }
        u.B1 = u.B0 + (size_t)128 * 1024 * 2; u.r0 = pm * 256; u.aux = 0; return true;
    }
};
struct SchedKV {
    unsigned char* ws; int c;
    __device__ __forceinline__ bool next(int i, Unit& u) const {
        if (i > 0 || c < 64 || c >= 96) return false;
        const int L = c - 64; u.nt = 32;
        if (L < 16) { const int pm = L & 7, pn = L >> 3; u.A = (const char*)(ws + WS_MN) + (size_t)pm * 256 * 2048 * 2; u.B0 = (const char*)(ws + WS_WKVT) + (size_t)pn * 256 * 2048 * 2; u.r0 = pm * 256; u.c0 = pn * 256; u.aux = 0; }
        else { const int L2 = L - 16, pm = L2 & 1, pn = L2 >> 1; u.A = (const char*)(ws + WS_WKVT) + (size_t)(512 + pm * 256) * 2048 * 2; u.B0 = (const char*)(ws + WS_MN) + (size_t)pn * 256 * 2048 * 2; u.r0 = pm * 256; u.c0 = pn * 256; u.aux = 1; }
        u.B1 = u.B0 + (size_t)128 * 2048 * 2; return true;
    }
};
struct EpiKV {
    bf16_t* KM; bf16_t* VT;
    __device__ __forceinline__ void operator()(const f32x4 (&acc)[2][2][4][2], const Unit& u, int wr, int wc, int fr, int fq) const {
        pg8::EpiBf16 E{u.aux ? VT : KM, u.aux ? 2048 : 512, nullptr}; E(acc, u, wr, wc, fr, fq);
    }
};
struct SchedTiles {
    const char* A; const char* B; int lda, ldb, nM, nN, nt, G, c;
    __device__ __forceinline__ bool next(int i, Unit& u) const {
        const int L = i * G + c; if (L >= nM * nN) return false;
        int pm, pn; pg8::tile_order(L, nM, nN, pm, pn);
        u.A = A + (size_t)pm * 256 * lda * 2; u.B0 = B + (size_t)pn * 256 * ldb * 2; u.B1 = u.B0 + (size_t)128 * ldb * 2; u.nt = nt; u.r0 = pm * 256; u.c0 = pn * 256; u.aux = 0; return true;
    }
};
struct SchedDFT {
    unsigned char* ws; int c;
    __device__ __forceinline__ bool next(int i, Unit& u) const {
        if (i > 0 || c >= 256) return false;
        const int b = c & 7, j = c >> 3, pm = j & 15, pn = j >> 4;
        u.A = (const char*)(ws + WS_TW) + (size_t)pm * 256 * 2048 * 2; u.B0 = (const char*)(ws + WS_UT) + (size_t)(b * 512 + pn * 256) * 2048 * 2; u.B1 = u.B0 + (size_t)128 * 2048 * 2; u.nt = 32;
        u.r0 = b * SEQ + (pm & 7) * 256; u.c0 = 1024 + (pm >> 3) * 512 + pn * 256; u.aux = 0; return true;
    }
};
struct SchedProj {
    unsigned char* ws; int G, c;
    __device__ __forceinline__ bool next(int i, Unit& u) const {
        const int ti = i / 3, s = i - 3 * ti; const int L = ti * G + c; if (L >= 512) return false;
        int pm, pn; pg8::tile_order(L, 64, 8, pm, pn);
        const size_t co = (size_t)s * 1024 * 2;
        u.A = (const char*)(ws + WS_ACAT) + (size_t)pm * 256 * 2560 * 2 + co; u.B0 = (const char*)(ws + WS_BCAT) + (size_t)pn * 256 * 2560 * 2 + co; u.B1 = u.B0 + (size_t)128 * 2560 * 2;
        u.nt = s == 2 ? 8 : 16; u.r0 = pm * 256; u.c0 = pn * 256; u.aux = s; return true;
    }
};
struct SchedGU {
    unsigned char* ws; int G, c;
    __device__ __forceinline__ bool next(int i, Unit& u) const {
        const int L = i * G + c; if (L >= 2048) return false;
        const int e = L >> 7, j = L & 127, x = j & 7, q = j >> 3, pm = q & 7, pn = 2 * x + (q >> 3);
        u.A = (const char*)(ws + WS_XIN) + (size_t)(e * 8 + pm) * 256 * 2048 * 2; u.B0 = (const char*)(ws + WS_WGUT) + ((size_t)e * 4096 + pn * 256) * 2048 * 2; u.B1 = u.B0 + (size_t)128 * 2048 * 2;
        u.nt = 32; u.r0 = (e * 8 + pm) * 256; u.c0 = pn * 128; u.aux = 0; return true;
    }
};
struct SchedDown {
    unsigned char* ws; int G, c;
    __device__ __forceinline__ bool next(int i, Unit& u) const {
        const int L = i * G + c; if (L >= 1024) return false;
        const int e = L >> 6, j = L & 63, pn = j & 7, pm = j >> 3;
        u.A = (const char*)(ws + WS_HID) + (size_t)(e * 8 + pm) * 256 * 2048 * 2; u.B0 = (const char*)(ws + WS_WDT) + ((size_t)e * 2048 + pn * 256) * 2048 * 2; u.B1 = u.B0 + (size_t)128 * 2048 * 2;
        u.nt = 32; u.r0 = (e * 8 + pm) * 256; u.c0 = pn * 256; u.aux = 0; return true;
    }
};

__global__ void __launch_bounds__(NTHR, 2) fwd_kernel(Args a) {
    extern __shared__ __attribute__((aligned(16))) unsigned char lds_raw[];
    LAS unsigned char* lds = (LAS unsigned char*)lds_raw;
    const int tid = threadIdx.x, lane = tid & 63, wave = __builtin_amdgcn_readfirstlane(tid >> 6);
    const int G = gridDim.x, c = blockIdx.x;
    const int vcu = (G % 8 == 0) ? (c % 8) * (G / 8) + c / 8 : c;
    const int gw = vcu * NWAVES + wave, NGW = G * NWAVES;
    unsigned char* ws = a.ws;
    const int lo = a.ph_lo, hi = a.ph_hi;
#define IN(k) (lo <= (k) && (k) < hi)
    volatile LAS unsigned* bst = (volatile LAS unsigned*)(lds + 131072 + 512);
    if (tid < 64) ((LAS unsigned*)(lds + 131072 + 512))[tid] = 0u;
    __syncthreads();
    XcdBarrier gbar = xcd_barrier_post((unsigned*)(ws + WS_CTL) + 4096, bst);
#define SEAM(k) do { if (IN(k) && IN((k) + 1)) { xcd_barrier(gbar); } } while (0)

    if (IN(0)) { phase0(a, lds, gw, NGW, wave, lane); __syncthreads(); }
    SEAM(0);
    if (!DBG_P5_FROM_XN && IN(1)) {
        { SchedFold S{ws, c}; pg8::EpiBf16 E{(bf16_t*)(ws + WS_BCAT), 2560, nullptr}; pg8::gemm_phase(lds, 1024, 1024, S, E); }
        { SchedKV S{ws, c}; EpiKV E{(bf16_t*)(ws + WS_KMEM), (bf16_t*)(ws + WS_VT)}; pg8::gemm_phase(lds, 2048, 2048, S, E); }
    }
    SEAM(1);
    if (!DBG_P5_FROM_XN && IN(2)) {
        SchedTiles S{(const char*)(ws + WS_XN), (const char*)(ws + WS_WINT), 2048, 2048, 64, 32, 32, G, c};
        pg8::EpiZ E{(bf16_t*)(ws + WS_ZM), (bf16_t*)(ws + WS_UT), (bf16_t*)(ws + WS_G)};
        pg8::gemm_phase(lds, 2048, 2048, S, E);
    }
    SEAM(2);
    if (!DBG_P5_FROM_XN && IN(3)) {
        { SchedDFT S{ws, c}; pg8::EpiBf16 E{(bf16_t*)(ws + WS_ACAT), 2560, nullptr}; pg8::gemm_phase(lds, 2048, 2048, S, E); }
        if (c < 256) { const int b = c & 7, j = c >> 3; attn_unit(a, b, j & 3, j >> 2, wave, lane); }
        pool_pass(a, gw, NGW, lane);
    }
    SEAM(3);
    if (!DBG_P5_FROM_XN && IN(4)) { SchedProj S{ws, G, c}; pg8::EpiGate E{(bf16_t*)(ws + WS_MG), (const bf16_t*)(ws + WS_G)}; pg8::gemm_phase(lds, 2560, 2560, S, E); }
    SEAM(4);
    if (IN(5)) {
        SchedTiles S{(const char*)(ws + (DBG_P5_FROM_XN ? WS_XN : WS_MG)), (const char*)(ws + WS_WOT), 2048, 2048, 64, 8, 32, G, c};
        pg8::EpiResid E{a.x, a.out}; pg8::gemm_phase(lds, 2048, 2048, S, E);
    }
    SEAM(5);
    if (!DBG_SKIP_MOE && IN(6)) { router_phase(a, lds, vcu, G, wave, lane, tid); __syncthreads(); }
    SEAM(6);
    if (!DBG_SKIP_MOE && IN(7)) topk_phase(a, lds, c, wave, lane, tid);
    SEAM(7);
    if (!DBG_SKIP_MOE && IN(8)) { SchedGU S{ws, G, c}; pg8::EpiSwiGLU E{(bf16_t*)(ws + WS_HID)}; pg8::gemm_phase(lds, 2048, 2048, S, E); }
    SEAM(8);
    if (!DBG_SKIP_MOE && IN(9)) { SchedDown S{ws, G, c}; pg8::EpiBf16 E{(bf16_t*)(ws + WS_XIN), 2048, (const float*)(ws + WS_SELW)}; pg8::gemm_phase(lds, 2048, 2048, S, E); }
    SEAM(9);
    if (IN(10)) combine_phase(a, gw, NGW, lane);
#undef IN
#undef SEAM
}

extern "C" void kernel_launch(void* const* d_in, const int* in_sizes, int n_in, void* d_out, int out_size, void* d_ws, size_t ws_size, hipStream_t stream) {
    static int grid = 0;
    if (grid == 0) {
        if (n_in != 19 || in_sizes[0] != T * DM || out_size != T * DM || ws_size < WS_END) {
            fprintf(stderr, "kernel_launch: unexpected shapes (n_in %d, in0 %d, out %d, ws %zu, need %zu); nothing launched\n", n_in, n_in > 0 ? in_sizes[0] : -1, out_size, ws_size, (size_t)WS_END); grid = -1; return; }
        int dev = 0, cus = 0, per_cu = 0;
        if (hipGetDevice(&dev) != hipSuccess || hipDeviceGetAttribute(&cus, hipDeviceAttributeMultiprocessorCount, dev) != hipSuccess) { fprintf(stderr, "kernel_launch: device query failed\n"); grid = -1; return; }
        if (hipFuncSetAttribute((const void*)fwd_kernel, hipFuncAttributeMaxDynamicSharedMemorySize, LDS_BYTES) != hipSuccess) { fprintf(stderr, "kernel_launch: hipFuncSetAttribute failed\n"); grid = -1; return; }
        if (hipOccupancyMaxActiveBlocksPerMultiprocessor(&per_cu, (const void*)fwd_kernel, NTHR, LDS_BYTES) != hipSuccess || per_cu < 1) { fprintf(stderr, "kernel_launch: occupancy query says %d blocks per CU\n", per_cu); (void)hipGetLastError(); grid = -1; return; }
        grid = cus;
        if (grid < 256) fprintf(stderr, "kernel_launch: note: %d CUs (< 256): some single-round phases assume 256 workgroups\n", grid);
    }
    if (grid < 0) return;
    Args a{};
    a.x = (const float*)d_in[0]; a.mem = (const float*)d_in[1]; a.norm_mix_g = (const float*)d_in[2]; a.norm_mem_g = (const float*)d_in[3]; a.w_in = (const float*)d_in[4];
    a.pool_w = (const float*)d_in[5]; a.pool_scale = (const float*)d_in[6]; a.fourier_w = (const float*)d_in[7]; a.w_kv = (const float*)d_in[8]; a.proj_pool = (const float*)d_in[9];
    a.proj_fourier = (const float*)d_in[10]; a.proj_mem = (const float*)d_in[11]; a.w_out = (const float*)d_in[12]; a.norm_ffn_g = (const float*)d_in[13]; a.w_router = (const float*)d_in[14];
    a.w_gate = (const float*)d_in[15]; a.w_up = (const float*)d_in[16]; a.w_down = (const float*)d_in[17]; a.norm_final_g = (const float*)d_in[18];
    a.out = (float*)d_out; a.ws = (unsigned char*)d_ws;
#if MK_MULTI_LAUNCH
    for (int p = 0; p < NPH; ++p) { a.ph_lo = p; a.ph_hi = p + 1; hipLaunchKernelGGL(fwd_kernel, dim3(grid), dim3(NTHR), LDS_BYTES, stream, a); }
#else
    a.ph_lo = 0; a.ph_hi = NPH;
    if (hipMemsetAsync((char*)d_ws + WS_CTL, 0, 65536, stream) != hipSuccess) { fprintf(stderr, "kernel_launch: hipMemsetAsync failed\n"); return; }
    void* args[] = {&a};
    hipError_t e = hipLaunchCooperativeKernel((const void*)fwd_kernel, dim3(grid), dim3(NTHR), args, LDS_BYTES, stream);
    if (e != hipSuccess) fprintf(stderr, "kernel_launch: cooperative launch failed: %s (grid %d)\n", hipGetErrorString(e), grid);
#endif
}
```

```cpp
#include <hip/hip_runtime.h>
#include <hip/hip_cooperative_groups.h>
#include <cstdio>
#include <cstdint>
namespace cg = cooperative_groups;

#ifndef MK_MULTI_LAUNCH
#define MK_MULTI_LAUNCH 0
#endif

#ifndef PROBE_REP
#define PROBE_REP -1
#endif
#ifndef DBG_P5_FROM_XN
#define DBG_P5_FROM_XN 0
#endif
#ifndef DBG_ONLY_BRANCH
#define DBG_ONLY_BRANCH -1
#endif
#ifndef DBG_SKIP_MOE
#define DBG_SKIP_MOE 0
#endif
#define LAS __attribute__((address_space(3)))
#define GAS __attribute__((address_space(1)))
typedef unsigned short bf16_t;
typedef short bf16x8 __attribute__((ext_vector_type(8)));
typedef short s16x4 __attribute__((ext_vector_type(4)));
typedef float f32x2 __attribute__((ext_vector_type(2)));
typedef float f32x4 __attribute__((ext_vector_type(4)));
typedef float f32x16 __attribute__((ext_vector_type(16)));
typedef unsigned u32x2 __attribute__((ext_vector_type(2)));
typedef unsigned u32x4 __attribute__((ext_vector_type(4)));

constexpr int T = 16384, DM = 2048, NBATCH = 8, SEQ = 2048, MEML = 256;
constexpr int NE = 16, CAP = 256;
constexpr int CAT_LD = 2560;
constexpr float EPS = 1e-6f;
constexpr int NWAVES = 8, NTHR = 512;
constexpr int NPH = 11;

constexpr size_t MiB = 1u << 20;
constexpr size_t WS_CTL  = 0;
constexpr size_t WS_WINT = 1 * MiB;
constexpr size_t WS_WIN8 = 9 * MiB;
constexpr size_t WS_WKVT = 33 * MiB;
constexpr size_t WS_PPST = 37 * MiB;
constexpr size_t WS_PFT  = 41 * MiB;
constexpr size_t WS_PWBD = 45 * MiB;
constexpr size_t WS_M1BD = 47 * MiB;
constexpr size_t WS_BCAT = 49 * MiB;
constexpr size_t WS_WOT  = 60 * MiB;
constexpr size_t WS_TW   = 68 * MiB;
constexpr size_t WS_WGUT = 84 * MiB;
constexpr size_t WS_WDT  = 339 * MiB;
constexpr size_t WS_ACT  = 467 * MiB;
constexpr size_t WS_XN   = WS_ACT;
constexpr size_t WS_MN   = WS_ACT + 64 * MiB;
constexpr size_t WS_ZM   = WS_ACT + 72 * MiB;
constexpr size_t WS_G    = WS_ACT + 136 * MiB;
constexpr size_t WS_UT   = WS_ACT + 328 * MiB;
constexpr size_t WS_KMEM = WS_ACT + 344 * MiB;
constexpr size_t WS_VT   = WS_ACT + 346 * MiB;
constexpr size_t WS_ACAT = WS_ACT + 348 * MiB;
constexpr size_t WS_MG   = WS_ACT + 432 * MiB;
constexpr size_t WS_H2   = WS_ACT;
constexpr size_t WS_XIN  = WS_ACT + 32 * MiB;
constexpr size_t WS_Y    = WS_ACT + 96 * MiB;
constexpr size_t WS_HID  = WS_ACT + 224 * MiB;
constexpr size_t WS_AFF  = WS_ACT + 320 * MiB;
constexpr size_t WS_SELW = WS_ACT + 321 * MiB;
constexpr size_t WS_INV  = WS_ACT + 322 * MiB;
constexpr size_t WS_X1B  = WS_ACT + 352 * MiB;
constexpr size_t WS_XN8  = WS_ACT + 497 * MiB;
constexpr size_t WS_END  = WS_ACT + 529 * MiB;

constexpr int LDS_BYTES = 147456;

#define LDS_WAIT() asm volatile("s_waitcnt lgkmcnt(0)" ::: "memory")
#define VM_WAIT() asm volatile("s_waitcnt vmcnt(0)" ::: "memory")
__device__ __forceinline__ unsigned f2bf(float f) { unsigned u = __builtin_bit_cast(unsigned, f); return (u + 0x7fffu + ((u >> 16) & 1u)) >> 16; }
__device__ __forceinline__ unsigned pk2(float lo, float hi) { return f2bf(lo) | (f2bf(hi) << 16); }
typedef __bf16 bf16x2_t __attribute__((ext_vector_type(2)));
__device__ __forceinline__ unsigned cvt_pk_bf16(float lo, float hi) { const bf16x2_t v = __builtin_convertvector((f32x2){lo, hi}, bf16x2_t); return __builtin_bit_cast(unsigned, v); }
typedef int i32x8 __attribute__((ext_vector_type(8)));
__device__ __forceinline__ unsigned cvt4_fp8(float a, float b, float c, float d) {
    a = __builtin_fminf(__builtin_fmaxf(a, -448.f), 448.f); b = __builtin_fminf(__builtin_fmaxf(b, -448.f), 448.f);
    c = __builtin_fminf(__builtin_fmaxf(c, -448.f), 448.f); d = __builtin_fminf(__builtin_fmaxf(d, -448.f), 448.f);
    unsigned w = 0u; w = (unsigned)__builtin_amdgcn_cvt_pk_fp8_f32(a, b, (int)w, false); w = (unsigned)__builtin_amdgcn_cvt_pk_fp8_f32(c, d, (int)w, true); return w; }
constexpr float SC_W8 = 256.f, SC_H8 = 16.f, SC_HID8 = 8.f;
__device__ __forceinline__ float bf_lo(unsigned w) { return __builtin_bit_cast(float, w << 16); }
__device__ __forceinline__ float bf_hi(unsigned w) { return __builtin_bit_cast(float, w & 0xffff0000u); }
__device__ __forceinline__ int opaque_lane() { int t = threadIdx.x; asm volatile("" : "+v"(t)); return t & 63; }
__device__ __forceinline__ float wave_sum(float v) {
#pragma unroll
    for (int o = 1; o < 64; o <<= 1) v += __shfl_xor(v, o);
    return v;
}
__device__ __forceinline__ float fast_sigmoid(float v) { return __builtin_amdgcn_rcpf(1.0f + __builtin_amdgcn_exp2f(-1.44269504089f * v)); }


#ifndef PROBE_A
#define PROBE_A -1
#endif
#ifndef PROBE_B
#define PROBE_B 0
#endif
#ifndef PROBE_PHASE
#define PROBE_PHASE -1
#endif
#ifndef PROBE_BLK
#define PROBE_BLK 0
#endif
#define PROBE_SCALE 10
#define STAMP_BASE (143360 + 1024)
#define STAMP_EN() (((volatile LAS unsigned*)(unsigned)(STAMP_BASE + 512))[0])
#ifndef PROBE_NG
#define PROBE_NG 0
#endif
#define STAMPN(ph, i) do { if (PROBE_A >= 0 && PROBE_NG && PROBE_PHASE == (ph) && blockIdx.x == PROBE_BLK && threadIdx.x == 0) { ((volatile LAS unsigned long long*)(unsigned)STAMP_BASE)[i] = __builtin_amdgcn_s_memrealtime(); } } while (0)
#define STAMP0(i) STAMPN(0, i)
#define STAMPG(i) do { if constexpr (PRB) { STAMP(i); } } while (0)
#define STAMP(i) do { if (PROBE_A >= 0 && !PROBE_NG && blockIdx.x == PROBE_BLK && threadIdx.x == 0 && STAMP_EN()) { ((volatile LAS unsigned long long*)(unsigned)STAMP_BASE)[i] = __builtin_amdgcn_s_memrealtime(); } } while (0)

#define XB_TMO      128
#define XB_XCNT(j)  (256  + 64 * (j))
#define XB_XSUB(j)  (1280 + 64 * (j))
#define XB_XGEN(j)  (2304 + 64 * (j))
#define XB_TOP      3328
#define XB_TOPGEN   3392
#define XCD_BAR_WORDS 3456
#define XB_SPIN_CAP (1u << 18)
__device__ __forceinline__ unsigned xb_ld(unsigned* p)              { return __hip_atomic_load(p, __ATOMIC_RELAXED, __HIP_MEMORY_SCOPE_AGENT); }
__device__ __forceinline__ unsigned xb_add(unsigned* p, unsigned v) { return __hip_atomic_fetch_add(p, v, __ATOMIC_RELAXED, __HIP_MEMORY_SCOPE_AGENT); }
__device__ __forceinline__ unsigned xb_xcc_id() { return (unsigned)__builtin_amdgcn_s_getreg((3 << 11) | 20) & 0xFu; }
#define XB_SPIN(cond, bar) do { unsigned _sp = 0; while (cond) { __builtin_amdgcn_s_sleep(1); \
    if ((++_sp & 255u) == 0u) { if (xb_ld(&(bar)[XB_TMO])) break; if (_sp > XB_SPIN_CAP) { atomicAdd(&(bar)[XB_TMO], 1u); break; } } } } while (0)
struct XcdBarrier { unsigned* bar; unsigned x; volatile LAS unsigned* st; };
__device__ __forceinline__ XcdBarrier xcd_barrier_post(unsigned* bar, volatile LAS unsigned* st) {
    XcdBarrier b; b.bar = bar; b.x = xb_xcc_id(); b.st = st;
    if (threadIdx.x == 0) (void)xb_add(&bar[XB_XCNT(b.x)], 1u);
    return b;
}
__device__ __forceinline__ void xcd_barrier_complete(unsigned* bar, unsigned x, unsigned& nloc, unsigned& nx) {
    const unsigned G = gridDim.x * gridDim.y * gridDim.z;
    unsigned sum, cnt, mine, sp = 0u;
    for (;;) {
        sum = 0u; cnt = 0u; mine = 0u;
#pragma unroll
        for (unsigned j = 0; j < 16; ++j) { const unsigned c = xb_ld(&bar[XB_XCNT(j)]); sum += c; cnt += (c > 0u) ? 1u : 0u; mine = (j == x) ? c : mine; }
        if (sum == G) break;
        __builtin_amdgcn_s_sleep(1);
        if ((++sp & 255u) == 0u) { if (xb_ld(&bar[XB_TMO])) break; if (sp > XB_SPIN_CAP) { atomicAdd(&bar[XB_TMO], 1u); break; } }
    }
    nloc = mine > 0u ? mine : 1u; nx = cnt > 0u ? cnt : 1u;
}
__device__ __forceinline__ void xcd_barrier(const XcdBarrier& b) {
    asm volatile("s_waitcnt vmcnt(0)" ::: "memory");
    __syncthreads();
    if (threadIdx.x == 0) {
        unsigned* bar = b.bar;
        __builtin_amdgcn_s_waitcnt(0);
        unsigned nloc = b.st[0], nx = b.st[1];
        if (nloc == 0u) { xcd_barrier_complete(bar, b.x, nloc, nx); b.st[0] = nloc; b.st[1] = nx; }
        const unsigned old = xb_add(&bar[XB_XSUB(b.x)], 1u);
        const unsigned gen = old / nloc;
        if (old + 1u == (gen + 1u) * nloc) {
            __builtin_amdgcn_fence(__ATOMIC_RELEASE, "agent");
            asm volatile("s_waitcnt vmcnt(0)" ::: "memory");
            const unsigned og = xb_add(&bar[XB_TOP], 1u);
            const unsigned tg = og / nx;
            if (og + 1u == (tg + 1u) * nx) xb_add(&bar[XB_TOPGEN], 1u);
            else XB_SPIN(xb_ld(&bar[XB_TOPGEN]) == tg, bar);
            __builtin_amdgcn_fence(__ATOMIC_ACQUIRE, "agent");
            xb_add(&bar[XB_XGEN(b.x)], 1u);
            asm volatile("s_waitcnt vmcnt(0)" ::: "memory");
        } else {
            XB_SPIN(xb_ld(&bar[XB_XGEN(b.x)]) == gen, bar);
            __builtin_amdgcn_fence(__ATOMIC_ACQUIRE, "agent");
            asm volatile("s_waitcnt vmcnt(0)" ::: "memory");
        }
    }
    __syncthreads();
}

namespace pg8 {
typedef int i32x4v __attribute__((ext_vector_type(4)));
template <bool F8> struct FragT { bf16x8 bf[2]; };
template <> struct FragT<true> { i32x8 f8; };
constexpr int BM = 256, BK = 64, HALF = 128, HTB = HALF * BK * 2, STAGE_BYTES = 8 * HTB;
__device__ __forceinline__ int lds_byte(int r, int c) { const int st = (r >> 4) * 2 + (c >> 5), rr = r & 15, cc = c & 31, ob = rr * 64 + cc * 2; return st * 1024 + (ob ^ (((ob >> 9) & 1) << 5)); }
__device__ __forceinline__ void stage_rc(int b, int& R, int& C) { const int st = b / 1024, sb = b % 1024, swz = sb ^ (((sb >> 9) & 1) << 5); R = (st >> 1) * 16 + swz / 64; C = (st & 1) * 32 + (swz % 64) / 2; }
__device__ __forceinline__ int perm32(int rho) { const int n = rho >> 4, i = rho & 15; return 8 * (i >> 2) + 4 * n + (i & 3); }

struct Unit { const char* A; const char* B0; int nt; int r0, c0, aux; };

__device__ __forceinline__ void tile_order(int L, int nM, int nN, int& pm, int& pn) {
    const int nwg = nM * nN;
    int wgid = L; { const int q = nwg / 8, r = nwg % 8, xcd = wgid % 8, off = wgid / 8; wgid = (xcd < r ? xcd * (q + 1) : r * (q + 1) + (xcd - r) * q) + off; }
    const int nig = 8 * nN, gid = wgid / nig, fm = gid * 8, gsz = (nM - fm) < 8 ? (nM - fm) : 8;
    pm = fm + ((wgid % nig) % gsz); pn = (wgid % nig) / gsz;
}

template <bool FP8, bool PRB = false, class Epi, class Sched>
__device__ __forceinline__ void gemm_phase(LAS unsigned char* lds, const int lda, const int ldb, const Sched& S, const Epi& E) {
    int tid = threadIdx.x; asm volatile("" : "+v"(tid));
    const int wid = __builtin_amdgcn_readfirstlane(tid >> 6), lane = tid & 63, wr = wid >> 2, wc = wid & 3, fr = lane & 15, fq = lane >> 4;
    unsigned voffA[2], voffB[2];
#pragma unroll
    for (int i = 0; i < 2; ++i) { int R, C; stage_rc(tid * 16 + i * 8192, R, C); const int Rb = (R & ~31) + perm32(R & 31);
        voffA[i] = (unsigned)(R * lda + C * 2); voffB[i] = (unsigned)(Rb * ldb + C * 2); }
    const size_t kstep = (size_t)(BK * 2);
    const size_t hstepA = (size_t)HALF * lda, hstepB = (size_t)HALF * ldb;
    const unsigned ldsw = (unsigned)wid * 1024u;
    const int aoff = lds_byte(wr * 64 + fr, FP8 ? fq * 16 : fq * 8), boff = lds_byte(wc * 32 + fr, FP8 ? fq * 16 : fq * 8);
#define PG8_SA(b, h) (((b) * 2 + (h)) * HTB)
#define PG8_SB(b, h) ((4 + (b) * 2 + (h)) * HTB)
#define PG8_STAGE(bufoff, gbase, voff) do { const char* _gb = (const char*)(gbase); asm volatile("" : "+s"(_gb)); _Pragma("unroll") for (int _i = 0; _i < 2; ++_i) { \
        unsigned _vo = (voff)[_i]; asm volatile("" : "+v"(_vo)); \
        __builtin_amdgcn_global_load_lds((const unsigned*)(_gb + _vo), (LAS unsigned*)(lds + (bufoff) + ldsw + _i * 8192), 16, 0, 0); } } while (0)
#define PG8_LDA(dst, b, h) do { _Pragma("unroll") for (int m = 0; m < 4; ++m) { if constexpr (FP8) { \
            const i32x4v lo_ = *(const LAS i32x4v*)(lds + PG8_SA(b, h) + aoff + m * 2048), hi_ = *(const LAS i32x4v*)(lds + PG8_SA(b, h) + aoff + m * 2048 + 16); \
            dst[m].f8 = __builtin_shufflevector(lo_, hi_, 0, 1, 2, 3, 4, 5, 6, 7); } \
        else { _Pragma("unroll") for (int k = 0; k < 2; ++k) dst[m].bf[k] = *(const LAS bf16x8*)(lds + PG8_SA(b, h) + aoff + m * 2048 + k * 1024); } } } while (0)
#define PG8_LDB(dst, b, h) do { _Pragma("unroll") for (int n = 0; n < 2; ++n) { if constexpr (FP8) { \
            const i32x4v lo_ = *(const LAS i32x4v*)(lds + PG8_SB(b, h) + boff + n * 2048), hi_ = *(const LAS i32x4v*)(lds + PG8_SB(b, h) + boff + n * 2048 + 16); \
            dst[n].f8 = __builtin_shufflevector(lo_, hi_, 0, 1, 2, 3, 4, 5, 6, 7); } \
        else { _Pragma("unroll") for (int k = 0; k < 2; ++k) dst[n].bf[k] = *(const LAS bf16x8*)(lds + PG8_SB(b, h) + boff + n * 2048 + k * 1024); } } } while (0)
#define PG8_MMA(ai, bj, At, Bt) do { __builtin_amdgcn_s_setprio(1); _Pragma("unroll") for (int m = 0; m < 4; ++m) _Pragma("unroll") for (int n = 0; n < 2; ++n) { \
        if constexpr (FP8) acc[ai][bj][m][n] = __builtin_amdgcn_mfma_scale_f32_16x16x128_f8f6f4(Bt[n].f8, At[m].f8, acc[ai][bj][m][n], 0, 0, 0, 0x7F7F7F7F, 0, 0x7F7F7F7F); \
        else { _Pragma("unroll") for (int k = 0; k < 2; ++k) acc[ai][bj][m][n] = __builtin_amdgcn_mfma_f32_16x16x32_bf16(Bt[n].bf[k], At[m].bf[k], acc[ai][bj][m][n], 0, 0, 0); } } \
        __builtin_amdgcn_s_setprio(0); } while (0)
#define PG8_WAIT_V(n) asm volatile("s_waitcnt vmcnt(" #n ")" ::: "memory")
#define PG8_WAIT_L(n) asm volatile("s_waitcnt lgkmcnt(" #n ")" ::: "memory")
#define PG8_BAR __builtin_amdgcn_s_barrier()
#define PG8_SCHED __builtin_amdgcn_sched_barrier(0)
    Unit cur, nxt; int ui = 0;
    STAMPG(0);
    if (!S.next(0, cur)) return;
    f32x4 acc[2][2][4][2];
#pragma unroll
    for (int a = 0; a < 2; ++a)
#pragma unroll
        for (int b = 0; b < 2; ++b)
#pragma unroll
            for (int m = 0; m < 4; ++m)
#pragma unroll
                for (int n = 0; n < 2; ++n) acc[a][b][m][n] = (f32x4){0.f, 0.f, 0.f, 0.f};
    FragT<FP8> At[4], B0[2], B1[2];
    const char* cA = cur.A; const char* cB0 = cur.B0;
    PG8_STAGE(PG8_SB(0, 0), cB0, voffB); PG8_STAGE(PG8_SB(0, 1), cB0 + hstepB, voffB); PG8_STAGE(PG8_SA(0, 0), cA, voffA); PG8_STAGE(PG8_SA(0, 1), cA + hstepA, voffA);
    if (wr == 1) PG8_BAR;
    PG8_WAIT_V(2); PG8_BAR;
    PG8_STAGE(PG8_SB(1, 0), cB0 + kstep, voffB); PG8_STAGE(PG8_SA(1, 0), cA + kstep, voffA); PG8_STAGE(PG8_SB(1, 1), cB0 + hstepB + kstep, voffB);
    PG8_WAIT_V(6); PG8_BAR;
    STAMPG(1);
    for (;;) {
        const bool has_next = S.next(ui + 1, nxt);
        const char* nA = has_next ? nxt.A : cA; const char* nB0 = has_next ? nxt.B0 : cB0;
        const int nt = cur.nt;
        for (int t = 0; t < nt; t += 2) {
            const bool last = (t == nt - 2);
            const char* a1 = cA + (size_t)(t + 1) * kstep;
            const char* a2 = last ? nA : cA + (size_t)(t + 2) * kstep;
            const char* b20 = last ? nB0 : cB0 + (size_t)(t + 2) * kstep; const char* b21 = b20 + hstepB;
            const char* a3 = a2 + kstep; const char* b30 = b20 + kstep; const char* b31 = b21 + kstep;
            PG8_LDB(B0, 0, 0); PG8_LDB(B1, 0, 1); PG8_SCHED; PG8_LDA(At, 0, 0); PG8_STAGE(PG8_SA(1, 1), a1 + hstepA, voffA);
            PG8_WAIT_V(8); PG8_WAIT_L(0); PG8_BAR; PG8_MMA(0, 0, At, B0); PG8_MMA(0, 1, At, B1); PG8_BAR; PG8_SCHED;
            PG8_LDA(At, 0, 1); PG8_STAGE(PG8_SB(0, 0), b20, voffB); PG8_STAGE(PG8_SB(0, 1), b21, voffB); PG8_STAGE(PG8_SA(0, 0), a2, voffA);
            PG8_WAIT_V(8); PG8_WAIT_L(0); PG8_BAR; PG8_MMA(1, 0, At, B0); PG8_MMA(1, 1, At, B1); PG8_BAR; PG8_SCHED;
            PG8_LDB(B0, 1, 0); PG8_LDB(B1, 1, 1); PG8_SCHED; PG8_LDA(At, 1, 0); PG8_STAGE(PG8_SA(0, 1), a2 + hstepA, voffA);
            PG8_WAIT_V(8); PG8_WAIT_L(0); PG8_BAR; PG8_MMA(0, 0, At, B0); PG8_MMA(0, 1, At, B1); PG8_BAR; PG8_SCHED;
            PG8_LDA(At, 1, 1); PG8_STAGE(PG8_SB(1, 0), b30, voffB); PG8_STAGE(PG8_SB(1, 1), b31, voffB); PG8_STAGE(PG8_SA(1, 0), a3, voffA);
            PG8_WAIT_V(8); PG8_WAIT_L(0); PG8_BAR; PG8_MMA(1, 0, At, B0); PG8_MMA(1, 1, At, B1); PG8_BAR; PG8_SCHED;
        }
        if (wr == 0) PG8_BAR;
        if (ui == 0) STAMPG(2); STAMPG(4);
        E(acc, cur, wr, wc, fr, fq);
        if (PROBE_A >= 0 && PRB) { asm volatile("s_waitcnt vmcnt(0)" ::: "memory"); } if (ui == 0) STAMPG(3); STAMPG(5);
        if (!has_next) break;
        if (!Epi::keep_acc(cur)) {
#pragma unroll
        for (int a = 0; a < 2; ++a)
#pragma unroll
            for (int b = 0; b < 2; ++b)
#pragma unroll
                for (int m = 0; m < 4; ++m)
#pragma unroll
                    for (int n = 0; n < 2; ++n) acc[a][b][m][n] = (f32x4){0.f, 0.f, 0.f, 0.f}; }
        cur = nxt; cA = nA; cB0 = nB0; ++ui;
        if (wr == 1) PG8_BAR;
    }
    PG8_WAIT_V(0);
    PG8_BAR;
    STAMPG(6);
#undef PG8_SA
#undef PG8_SB
#undef PG8_STAGE
#undef PG8_LDA
#undef PG8_LDB
#undef PG8_MMA
#undef PG8_WAIT_V
#undef PG8_WAIT_L
#undef PG8_BAR
#undef PG8_SCHED
}

struct EpiBf16 {
    static __device__ __forceinline__ bool keep_acc(const Unit&) { return false; }
    bf16_t* O; int ldc; const float* rowscale; float mul;
    __device__ __forceinline__ void operator()(const f32x4 (&acc)[2][2][4][2], const Unit& u, int wr, int wc, int fr, int fq) const {
        const int row0 = u.r0 + wr * 64 + fr, col0 = u.c0 + wc * 32 + 8 * fq;
#pragma unroll
        for (int ai = 0; ai < 2; ++ai)
#pragma unroll
            for (int m = 0; m < 4; ++m) { const int row = row0 + ai * HALF + m * 16; const float sc = rowscale ? rowscale[row] * mul : mul;
                bf16_t* rowp = O + (size_t)row * ldc + col0;
#pragma unroll
                for (int bj = 0; bj < 2; ++bj) { const f32x4 v0 = acc[ai][bj][m][0] * sc, v1 = acc[ai][bj][m][1] * sc;
                    u32x4 w; w.x = cvt_pk_bf16(v0[0], v0[1]); w.y = cvt_pk_bf16(v0[2], v0[3]); w.z = cvt_pk_bf16(v1[0], v1[1]); w.w = cvt_pk_bf16(v1[2], v1[3]);
                    *(u32x4*)(rowp + bj * HALF) = w; } }
    }
};
struct EpiZ {
    static __device__ __forceinline__ bool keep_acc(const Unit&) { return false; }
    bf16_t* ZM; bf16_t* UT;
    __device__ __forceinline__ void operator()(const f32x4 (&acc)[2][2][4][2], const Unit& u, int wr, int wc, int fr, int fq) const {
        const int row0 = u.r0 + wr * 64 + fr, col0 = u.c0 + wc * 32 + 8 * fq;
        if (u.c0 >= 1024 && u.c0 < 1536) {
#pragma unroll
            for (int ai = 0; ai < 2; ++ai)
#pragma unroll
                for (int m = 0; m < 4; ++m) { const int row = row0 + ai * HALF + m * 16; const int b = row >> 11, s = row & 2047;
                    bf16_t* base = UT + ((size_t)b * 512 + (col0 - 1024)) * 2048 + s;
#pragma unroll
                    for (int bj = 0; bj < 2; ++bj)
#pragma unroll
                        for (int n = 0; n < 2; ++n)
#pragma unroll
                            for (int j = 0; j < 4; ++j) base[(size_t)(bj * HALF + 4 * n + j) * 2048] = (bf16_t)f2bf(acc[ai][bj][m][n][j]); }
        } else {
#pragma unroll
            for (int ai = 0; ai < 2; ++ai)
#pragma unroll
                for (int m = 0; m < 4; ++m) { bf16_t* rowp = ZM + (size_t)(row0 + ai * HALF + m * 16) * 2048 + col0;
#pragma unroll
                    for (int bj = 0; bj < 2; ++bj) { const f32x4 v0 = acc[ai][bj][m][0], v1 = acc[ai][bj][m][1];
                        u32x4 w; w.x = cvt_pk_bf16(v0[0], v0[1]); w.y = cvt_pk_bf16(v0[2], v0[3]); w.z = cvt_pk_bf16(v1[0], v1[1]); w.w = cvt_pk_bf16(v1[2], v1[3]);
                        *(u32x4*)(rowp + bj * HALF) = w; } }
        }
    }
};
struct EpiGates8 {
    static __device__ __forceinline__ bool keep_acc(const Unit&) { return false; }
    bf16_t* G; float inmul;
    __device__ __forceinline__ void operator()(const f32x4 (&acc)[2][2][4][2], const Unit& u, int wr, int wc, int fr, int fq) const {
        const int row0 = u.r0 + wr * 64 + fr, col0 = u.c0 + wc * 32 + 8 * fq;
#pragma unroll
        for (int ai = 0; ai < 2; ++ai)
#pragma unroll
            for (int m = 0; m < 4; ++m) { bf16_t* rowp = G + (size_t)(row0 + ai * HALF + m * 16) * 6144 + col0;
#pragma unroll
                for (int bj = 0; bj < 2; ++bj) { const f32x4 a0 = acc[ai][bj][m][0] * inmul, a1 = acc[ai][bj][m][1] * inmul;
                    u32x4 w; w.x = cvt_pk_bf16(fast_sigmoid(a0[0]), fast_sigmoid(a0[1])); w.y = cvt_pk_bf16(fast_sigmoid(a0[2]), fast_sigmoid(a0[3]));
                    w.z = cvt_pk_bf16(fast_sigmoid(a1[0]), fast_sigmoid(a1[1])); w.w = cvt_pk_bf16(fast_sigmoid(a1[2]), fast_sigmoid(a1[3]));
                    *(u32x4*)(rowp + bj * HALF) = w; } }
    }
};
struct EpiGate {
    static __device__ __forceinline__ bool keep_acc(const Unit& u) { return (u.aux & 32) == 0; }
    bf16_t* MG; const bf16_t* G;
    __device__ __forceinline__ void operator()(f32x4 (&acc)[2][2][4][2], const Unit& u, int wr, int wc, int fr, int fq) const {
        const int row0 = u.r0 + wr * 64 + fr, col0 = u.c0 + wc * 32 + 8 * fq; const int gs = u.aux & 3, gn = (u.aux >> 2) & 3; const bool last = (u.aux & 32) != 0;
#pragma unroll
        for (int ai = 0; ai < 2; ++ai)
#pragma unroll
            for (int m = 0; m < 4; ++m) { const int row = row0 + ai * HALF + m * 16;
                const bf16_t* gp = G + (size_t)row * 6144 + gs * 2048 + col0; const bf16_t* gq = G + (size_t)row * 6144 + gn * 2048 + col0;
#pragma unroll
                for (int bj = 0; bj < 2; ++bj) { const u32x4 g = *(const u32x4*)(gp + bj * HALF);
                    float f[8] = {bf_lo(g.x), bf_hi(g.x), bf_lo(g.y), bf_hi(g.y), bf_lo(g.z), bf_hi(g.z), bf_lo(g.w), bf_hi(g.w)};
                    if (!last) { const u32x4 h = *(const u32x4*)(gq + bj * HALF);
                        const float d[8] = {bf_lo(h.x), bf_hi(h.x), bf_lo(h.y), bf_hi(h.y), bf_lo(h.z), bf_hi(h.z), bf_lo(h.w), bf_hi(h.w)};
#pragma unroll
                        for (int j = 0; j < 8; ++j) f[j] = f[j] * __builtin_amdgcn_rcpf(__builtin_fmaxf(d[j], 1e-30f)); }
                    f32x4 a0 = acc[ai][bj][m][0], a1 = acc[ai][bj][m][1];
                    a0[0] *= f[0]; a0[1] *= f[1]; a0[2] *= f[2]; a0[3] *= f[3]; a1[0] *= f[4]; a1[1] *= f[5]; a1[2] *= f[6]; a1[3] *= f[7];
                    if (last) { u32x4 w; w.x = cvt_pk_bf16(a0[0], a0[1]); w.y = cvt_pk_bf16(a0[2], a0[3]); w.z = cvt_pk_bf16(a1[0], a1[1]); w.w = cvt_pk_bf16(a1[2], a1[3]);
                        *(u32x4*)(MG + (size_t)row * 2048 + col0 + bj * HALF) = w; }
                    else { acc[ai][bj][m][0] = a0; acc[ai][bj][m][1] = a1; } } }
    }
};
struct EpiResid {
    static __device__ __forceinline__ bool keep_acc(const Unit&) { return false; }
    const float* X; bf16_t* O;
    __device__ __forceinline__ void operator()(const f32x4 (&acc)[2][2][4][2], const Unit& u, int wr, int wc, int fr, int fq) const {
        const int row0 = u.r0 + wr * 64 + fr, col0 = u.c0 + wc * 32 + 8 * fq;
#pragma unroll
        for (int ai = 0; ai < 2; ++ai)
#pragma unroll
            for (int m = 0; m < 4; ++m) { const size_t off = (size_t)(row0 + ai * HALF + m * 16) * 2048 + col0;
#pragma unroll
                for (int bj = 0; bj < 2; ++bj) { const f32x4 x0 = *(const f32x4*)(X + off + bj * HALF), x1 = *(const f32x4*)(X + off + bj * HALF + 4);
                    const f32x4 v0 = x0 + acc[ai][bj][m][0], v1 = x1 + acc[ai][bj][m][1];
                    u32x4 w; w.x = cvt_pk_bf16(v0[0], v0[1]); w.y = cvt_pk_bf16(v0[2], v0[3]); w.z = cvt_pk_bf16(v1[0], v1[1]); w.w = cvt_pk_bf16(v1[2], v1[3]);
                    *(u32x4*)(O + off + bj * HALF) = w; } }
    }
};
struct EpiSwiGLU8 {
    static __device__ __forceinline__ bool keep_acc(const Unit&) { return false; }
    unsigned char* H; float inmul;
    __device__ __forceinline__ void operator()(const f32x4 (&acc)[2][2][4][2], const Unit& u, int wr, int wc, int fr, int fq) const {
        const int row0 = u.r0 + wr * 64 + fr, col0 = u.c0 + wc * 32 + 8 * fq;
#pragma unroll
        for (int ai = 0; ai < 2; ++ai)
#pragma unroll
            for (int m = 0; m < 4; ++m) { unsigned char* rowp = H + (size_t)(row0 + ai * HALF + m * 16) * 2048 + col0;
                float h[8];
#pragma unroll
                for (int n = 0; n < 2; ++n)
#pragma unroll
                    for (int j = 0; j < 4; ++j) { const float g = acc[ai][0][m][n][j] * inmul, up = acc[ai][1][m][n][j] * inmul; h[4 * n + j] = g * fast_sigmoid(g) * up * SC_HID8; }
                u32x2 w; w.x = cvt4_fp8(h[0], h[1], h[2], h[3]); w.y = cvt4_fp8(h[4], h[5], h[6], h[7]);
                *(u32x2*)rowp = w; }
    }
};
}

struct Args {
    const float* x; const float* mem; const float* norm_mix_g; const float* norm_mem_g; const float* w_in; const float* pool_w; const float* pool_scale; const float* fourier_w;
    const float* w_kv; const float* proj_pool; const float* proj_fourier; const float* proj_mem; const float* w_out; const float* norm_ffn_g; const float* w_router;
    const float* w_gate; const float* w_up; const float* w_down; const float* norm_final_g;
    float* out; unsigned char* ws; int ph_lo, ph_hi;
};

template <bool FP8>
__device__ __forceinline__ void p0_tile64(const float* W, int N, int k0, int n0, void* WT, int ldt, int drow0, const float* kscale, float mul, int lane) {
    if constexpr (FP8) {
        const int lr = lane >> 4, lc = 4 * (lane & 15);
        f32x4 v[16];
#pragma unroll
        for (int i = 0; i < 16; ++i) v[i] = *(const f32x4*)(W + (size_t)(k0 + 16 * lr + i) * N + n0 + lc);
#pragma unroll
        for (int i = 0; i < 16; ++i) { float sc = mul; if (kscale) sc *= kscale[k0 + 16 * lr + i]; v[i] = v[i] * sc; }
#pragma unroll
        for (int n = 0; n < 4; ++n) { u32x4 o;
            o.x = cvt4_fp8(v[0][n], v[1][n], v[2][n], v[3][n]); o.y = cvt4_fp8(v[4][n], v[5][n], v[6][n], v[7][n]);
            o.z = cvt4_fp8(v[8][n], v[9][n], v[10][n], v[11][n]); o.w = cvt4_fp8(v[12][n], v[13][n], v[14][n], v[15][n]);
            *(u32x4*)((unsigned char*)WT + (size_t)(drow0 + lc + n) * ldt + k0 + 16 * lr) = o; }
    } else {
        const int kq = lane & 7, cg = lane >> 3;
        f32x4 v[2][8];
#pragma unroll
        for (int h = 0; h < 2; ++h)
#pragma unroll
            for (int i = 0; i < 8; ++i) v[h][i] = *(const f32x4*)(W + (size_t)(k0 + 8 * kq + i) * N + n0 + 32 * h + 4 * cg);
        if (kscale) {
#pragma unroll
            for (int i = 0; i < 8; ++i) { const float sc = kscale[k0 + 8 * kq + i]; v[0][i] = v[0][i] * sc; v[1][i] = v[1][i] * sc; } }
#pragma unroll
        for (int h = 0; h < 2; ++h)
#pragma unroll
            for (int n = 0; n < 4; ++n) { u32x4 o;
                o.x = cvt_pk_bf16(v[h][0][n], v[h][1][n]); o.y = cvt_pk_bf16(v[h][2][n], v[h][3][n]); o.z = cvt_pk_bf16(v[h][4][n], v[h][5][n]); o.w = cvt_pk_bf16(v[h][6][n], v[h][7][n]);
                *(u32x4*)((bf16_t*)WT + (size_t)(drow0 + 32 * h + 4 * cg + n) * ldt + k0 + 8 * kq) = o; }
    }
}
__device__ __forceinline__ void rms_row_to_bf16(const float* xrow, const float* g, bf16_t* orow, unsigned char* orow8, int lane) {
    const f32x4* xr = (const f32x4*)xrow + lane; const f32x4* gr = (const f32x4*)g + lane;
    f32x4 v[8]; float s = 0.f;
#pragma unroll
    for (int j = 0; j < 8; ++j) { v[j] = xr[64 * j]; s += (v[j].x * v[j].x + v[j].y * v[j].y) + (v[j].z * v[j].z + v[j].w * v[j].w); }
    const float inv = 1.0f / sqrtf(wave_sum(s) * (1.f / DM) + EPS);
    u32x2* o8 = (u32x2*)orow + lane;
#pragma unroll
    for (int j = 0; j < 8; ++j) { const f32x4 gg = gr[64 * j]; const f32x4 h = v[j] * inv * gg; u32x2 w; w.x = cvt_pk_bf16(h.x, h.y); w.y = cvt_pk_bf16(h.z, h.w); o8[64 * j] = w;
        if (orow8) ((unsigned*)orow8)[64 * j + lane] = cvt4_fp8(h.x * SC_H8, h.y * SC_H8, h.z * SC_H8, h.w * SC_H8); }
}

struct ExItem { const float* src; unsigned char* dst; int k0, n0, drow0; };
__device__ __forceinline__ ExItem ex_item(const Args& a, int r) {
    constexpr int I_EX = 32 * 32; const int mat = r / I_EX, w = r % I_EX, type = mat / 16, e = mat % 16, kb = w / 32, nb = w % 32, n0 = nb * 64;
    ExItem it; it.src = (type == 0 ? a.w_gate : (type == 1 ? a.w_up : a.w_down)) + (size_t)e * 2048 * 2048; it.k0 = kb * 64; it.n0 = n0;
    if (type < 2) { it.dst = a.ws + WS_WGUT + (size_t)e * 4096 * 2048; it.drow0 = ((n0 >> 7) << 8) + (n0 & 127) + (type == 1 ? 128 : 0); }
    else { it.dst = a.ws + WS_WDT + (size_t)e * 2048 * 2048; it.drow0 = n0; }
    return it;
}
__device__ __forceinline__ void ex_load(const ExItem& it, f32x4 (&v)[16], int lane) {
    const int lr = lane >> 4, lc = 4 * (lane & 15);
#pragma unroll
    for (int i = 0; i < 16; ++i) v[i] = __builtin_nontemporal_load((const f32x4*)(it.src + (size_t)(it.k0 + 16 * lr + i) * 2048 + it.n0 + lc));
}
__device__ __forceinline__ void ex_store(const ExItem& it, const f32x4 (&v)[16], int lane) {
    const int lr = lane >> 4, lc = 4 * (lane & 15);
#pragma unroll
    for (int n = 0; n < 4; ++n) { u32x4 o;
        o.x = cvt4_fp8(v[0][n] * SC_W8, v[1][n] * SC_W8, v[2][n] * SC_W8, v[3][n] * SC_W8); o.y = cvt4_fp8(v[4][n] * SC_W8, v[5][n] * SC_W8, v[6][n] * SC_W8, v[7][n] * SC_W8);
        o.z = cvt4_fp8(v[8][n] * SC_W8, v[9][n] * SC_W8, v[10][n] * SC_W8, v[11][n] * SC_W8); o.w = cvt4_fp8(v[12][n] * SC_W8, v[13][n] * SC_W8, v[14][n] * SC_W8, v[15][n] * SC_W8);
        __builtin_nontemporal_store(o, (u32x4*)(it.dst + (size_t)(it.drow0 + lc + n) * 2048 + it.k0 + 16 * lr)); }
}
__device__ __forceinline__ void convert_experts(const Args& a, int c, int G, int wave, int lane) {
    constexpr int NEXP = 48 * 32 * 32;
    int start, cnt;
    if (G == 256) { if (c >= 64 && c < 96) { cnt = 192; start = (c - 64) * 192; } else if (c < 64) { cnt = 212; start = 6144 + c * 212; } else { cnt = 184; start = 19712 + (c - 96) * 184; } }
    else { const int per = (NEXP + G - 1) / G; start = c * per; cnt = (start + per <= NEXP) ? per : (NEXP > start ? NEXP - start : 0); }
    const int end = start + cnt;
    int r = start + wave; if (r >= end) return;
    f32x4 va[16], vb[16];
    ExItem ia = ex_item(a, r), ib; ex_load(ia, va, lane);
    for (;;) {
        const bool hb = (r + NWAVES) < end; if (hb) { ib = ex_item(a, r + NWAVES); ex_load(ib, vb, lane); }
        ex_store(ia, va, lane);
        if (!hb) break;
        r += NWAVES;
        const bool ha = (r + NWAVES) < end; if (ha) { ia = ex_item(a, r + NWAVES); ex_load(ia, va, lane); }
        ex_store(ib, vb, lane);
        if (!ha) break;
        r += NWAVES;
    }
}
__device__ __forceinline__ void rms_row2_to_bf16(const float* xrow, const float* g, bf16_t* orow, unsigned char* orow8, int lane) {
    const f32x4* xr = (const f32x4*)xrow + lane; const f32x4* gr = (const f32x4*)g + lane;
    f32x4 v[2][8]; float s0 = 0.f, s1 = 0.f;
#pragma unroll
    for (int j = 0; j < 8; ++j) { v[0][j] = xr[64 * j]; v[1][j] = xr[512 + 64 * j]; }
#pragma unroll
    for (int j = 0; j < 8; ++j) { s0 += (v[0][j].x * v[0][j].x + v[0][j].y * v[0][j].y) + (v[0][j].z * v[0][j].z + v[0][j].w * v[0][j].w); s1 += (v[1][j].x * v[1][j].x + v[1][j].y * v[1][j].y) + (v[1][j].z * v[1][j].z + v[1][j].w * v[1][j].w); }
    const float inv0 = 1.0f / sqrtf(wave_sum(s0) * (1.f / DM) + EPS), inv1 = 1.0f / sqrtf(wave_sum(s1) * (1.f / DM) + EPS);
    u32x2* o8 = (u32x2*)orow + lane; unsigned* of8 = (unsigned*)orow8 + lane;
#pragma unroll
    for (int j = 0; j < 8; ++j) { const f32x4 gg = gr[64 * j]; const f32x4 h0 = v[0][j] * inv0 * gg, h1 = v[1][j] * inv1 * gg;
        u32x2 w0; w0.x = cvt_pk_bf16(h0.x, h0.y); w0.y = cvt_pk_bf16(h0.z, h0.w); o8[64 * j] = w0;
        u32x2 w1; w1.x = cvt_pk_bf16(h1.x, h1.y); w1.y = cvt_pk_bf16(h1.z, h1.w); o8[512 + 64 * j] = w1;
        of8[64 * j] = cvt4_fp8(h0.x * SC_H8, h0.y * SC_H8, h0.z * SC_H8, h0.w * SC_H8); of8[512 + 64 * j] = cvt4_fp8(h1.x * SC_H8, h1.y * SC_H8, h1.z * SC_H8, h1.w * SC_H8); }
}
__device__ __forceinline__ void phase0(const Args& a, LAS unsigned char* lds, int gw, int NGW, int wave, int lane) {
    unsigned char* ws = a.ws;
    STAMP0(0);
    LAS float* tab = (LAS float*)lds;
    { const int t_ = threadIdx.x; if (t_ < 128) { tab[t_] = cospif((float)t_ * (1.0f / 64.0f)); tab[128 + t_] = -sinpif((float)t_ * (1.0f / 64.0f)); } }
    __syncthreads();
    constexpr int I_WIN = 32 * 128, I_KV = 32 * 16, I_PP = 16 * 32, I_PF = 8 * 32, I_PM = 8 * 32, I_WO = 32 * 32;
    constexpr int NITEMS = I_WIN + I_KV + I_PP + I_PF + I_PM + I_WO;
    for (int it = gw; it < NITEMS; it += NGW) {
        int r = it;
        if (r < I_WIN) { const int kb = r / 128, nb = r % 128;
            if (nb < 32) p0_tile64<false>(a.w_in, 8192, kb * 64, nb * 64, ws + WS_WINT, 2048, nb * 64, nullptr, 1.f, lane);
            else p0_tile64<true>(a.w_in, 8192, kb * 64, nb * 64, ws + WS_WIN8, 2048, (nb - 32) * 64, nullptr, SC_W8, lane);
            continue; } r -= I_WIN;
        if (r < I_KV) { const int kb = r / 16, nb = r % 16; p0_tile64<false>(a.w_kv, 1024, kb * 64, nb * 64, ws + WS_WKVT, 2048, nb * 64, nullptr, 1.f, lane); continue; } r -= I_KV;
        if (r < I_PP) { const int kb = r / 32, nb = r % 32; p0_tile64<false>(a.proj_pool, 2048, kb * 64, nb * 64, ws + WS_PPST, 1024, nb * 64, a.pool_scale, 1.f, lane); continue; } r -= I_PP;
        if (r < I_PF) { const int kb = r / 32, nb = r % 32; p0_tile64<false>(a.proj_fourier, 2048, kb * 64, nb * 64, ws + WS_PFT, 1024, nb * 64, nullptr, 1.f, lane); continue; } r -= I_PF;
        if (r < I_PM) { const int kb = r / 32, nb = r % 32; p0_tile64<false>(a.proj_mem, 2048, kb * 64, nb * 64, (bf16_t*)(ws + WS_BCAT) + 2048, CAT_LD, nb * 64, nullptr, 1.f, lane); continue; } r -= I_PM;
        { const int kb = r / 32, nb = r % 32; p0_tile64<false>(a.w_out, 2048, kb * 64, nb * 64, ws + WS_WOT, 2048, nb * 64, nullptr, 1.f, lane); }
    }
    STAMP0(1);
    for (int m = 2 * gw; m < T; m += 2 * NGW) rms_row2_to_bf16(a.x + (size_t)m * DM, a.norm_mix_g, (bf16_t*)(ws + WS_XN) + (size_t)m * DM, ws + WS_XN8 + (size_t)m * DM, lane);
    for (int m = gw; m < NBATCH * MEML; m += NGW) rms_row_to_bf16(a.mem + (size_t)m * DM, a.norm_mem_g, (bf16_t*)(ws + WS_MN) + (size_t)m * DM, nullptr, lane);
    STAMP0(2);
    const int gt = gw * 64 + lane, NGT = NGW * 64;
    for (int i = gt; i < 1024 * 128; i += NGT) { const int row = i >> 7, col = (i & 127) * 8, g = row >> 8, c = row & 255;
        u32x4 o = (u32x4){0u, 0u, 0u, 0u};
        if ((col >> 8) == g) { const float* p = a.pool_w + ((size_t)g * 256 + c) * 256 + (col & 255); const f32x4 v0 = *(const f32x4*)p, v1 = *(const f32x4*)(p + 4);
            o.x = pk2(v0.x, v0.y); o.y = pk2(v0.z, v0.w); o.z = pk2(v1.x, v1.y); o.w = pk2(v1.z, v1.w); }
        *(u32x4*)((bf16_t*)(ws + WS_PWBD) + (size_t)row * 1024 + col) = o; }
    STAMP0(3);
    for (int i = gt; i < 1024 * 512; i += NGT) { const int row = i >> 9, col = i & 511, cs = row >> 9, g = (row >> 7) & 3, c = row & 127, g2 = col >> 7, d = col & 127;
        float v = 0.f;
        if (g2 == g) { const float* fw = a.fourier_w + (size_t)g * 128 * 128 + d; const LAS float* tb = tab + (cs ? 128 : 0);
#pragma unroll 8
            for (int j = 0; j < 128; ++j) v += tb[(c * j) & 127] * fw[(size_t)j * 128]; }
        ((bf16_t*)(ws + WS_M1BD))[(size_t)row * 1024 + col] = (bf16_t)f2bf(v); }
    STAMP0(4);
    for (int i = gt; i < 4096 * 256; i += NGT) { const int row = i >> 8, s0 = (i & 255) * 8, cs = row >> 11, k = row & 2047;
        float v[8];
#pragma unroll
        for (int j = 0; j < 8; ++j) { const float ang = (float)((k * (s0 + j)) & 2047) * (1.0f / 1024.0f); v[j] = (cs ? sinpif(ang) : cospif(ang)) * (1.0f / 512.0f); }
        u32x4 o; o.x = pk2(v[0], v[1]); o.y = pk2(v[2], v[3]); o.z = pk2(v[4], v[5]); o.w = pk2(v[6], v[7]);
        *(u32x4*)((bf16_t*)(ws + WS_TW) + (size_t)row * 2048 + s0) = o; }
    STAMP0(5);
}

__device__ __forceinline__ void pool_pass(const Args& a, int gw, int NGW, int lane) {
    const bf16_t* ZM = (const bf16_t*)(a.ws + WS_ZM); bf16_t* AC = (bf16_t*)(a.ws + WS_ACAT);
    for (int it = gw; it < 4096; it += NGW) {
        const int run = it >> 1, hf = it & 1, chunk = hf * 64 + lane, ch0 = chunk * 8, g = chunk >> 5, hw = 1 << g;
        const int t0 = run * 8, b = t0 >> 11, s0 = t0 & 2047; const bf16_t* base = ZM + (size_t)b * SEQ * 2048 + ch0;
        u32x4 rw[23];
#pragma unroll
        for (int r = 0; r < 23; ++r) { const int d = r - 8, s = s0 + d; rw[r] = (u32x4){0u, 0u, 0u, 0u};
            if (d >= -hw && d < 8 + hw - 1 && s >= 0 && s < SEQ) rw[r] = *(const u32x4*)(base + (size_t)s * 2048); }
        float sum[8];
#pragma unroll
        for (int j = 0; j < 8; ++j) sum[j] = 0.f;
#pragma unroll
        for (int r = 0; r < 16; ++r) { const int d = r - 8; if (d >= -hw && d < hw) { const u32x4 w = rw[r];
            sum[0] += bf_lo(w.x); sum[1] += bf_hi(w.x); sum[2] += bf_lo(w.y); sum[3] += bf_hi(w.y); sum[4] += bf_lo(w.z); sum[5] += bf_hi(w.z); sum[6] += bf_lo(w.w); sum[7] += bf_hi(w.w); } }
#pragma unroll
        for (int i = 0; i < 8; ++i) { const int s = s0 + i; const int lo = (s - hw) < 0 ? 0 : (s - hw), hi = (s + hw) > SEQ ? SEQ : (s + hw); const float rc = 1.0f / (float)(hi - lo);
            const u32x4 c = rw[8 + i];
            u32x4 o; o.x = cvt_pk_bf16(sum[0] * rc - bf_lo(c.x), sum[1] * rc - bf_hi(c.x)); o.y = cvt_pk_bf16(sum[2] * rc - bf_lo(c.y), sum[3] * rc - bf_hi(c.y));
            o.z = cvt_pk_bf16(sum[4] * rc - bf_lo(c.z), sum[5] * rc - bf_hi(c.z)); o.w = cvt_pk_bf16(sum[6] * rc - bf_lo(c.w), sum[7] * rc - bf_hi(c.w));
            *(u32x4*)(AC + (size_t)(t0 + i) * CAT_LD + ch0) = o;
            if (i < 7) { u32x4 wa = (u32x4){0u, 0u, 0u, 0u}, wd = wa;
#pragma unroll
                for (int k = 0; k < 4; ++k) { const int h2 = 1 << k; if (hw == h2) { wa = rw[8 + i + h2]; wd = rw[8 + i - h2]; } }
                sum[0] += bf_lo(wa.x) - bf_lo(wd.x); sum[1] += bf_hi(wa.x) - bf_hi(wd.x); sum[2] += bf_lo(wa.y) - bf_lo(wd.y); sum[3] += bf_hi(wa.y) - bf_hi(wd.y);
                sum[4] += bf_lo(wa.z) - bf_lo(wd.z); sum[5] += bf_hi(wa.z) - bf_hi(wd.z); sum[6] += bf_lo(wa.w) - bf_lo(wd.w); sum[7] += bf_hi(wa.w) - bf_hi(wd.w); } }
    }
}

constexpr int ATT_KSTR = 272, ATT_VSTR = 520, ATT_VOFF = 256 * ATT_KSTR;
__device__ __forceinline__ void attn_unit(const Args& a, LAS unsigned char* lds, int b, int h, int qb, int wave, int lane, int tid) {
    const bf16_t* ZM = (const bf16_t*)(a.ws + WS_ZM); const bf16_t* KM = (const bf16_t*)(a.ws + WS_KMEM); const bf16_t* VT = (const bf16_t*)(a.ws + WS_VT); bf16_t* AC = (bf16_t*)(a.ws + WS_ACAT);
    const int l31 = lane & 31, hh = lane >> 5;
#pragma unroll
    for (int i = 0; i < 8; ++i) { const int ch = tid + 512 * i, row = ch >> 4, cc = ch & 15;
        const u32x4 v = *(const u32x4*)(KM + (size_t)(b * MEML + row) * 512 + h * 128 + 8 * cc);
        *(LAS u32x4*)(lds + row * ATT_KSTR + 16 * cc) = v; }
#pragma unroll
    for (int i = 0; i < 8; ++i) { const int ch = tid + 512 * i, row = ch >> 5, cc = ch & 31;
        const u32x4 v = *(const u32x4*)(VT + (size_t)(h * 128 + row) * 2048 + b * MEML + 8 * cc);
        LAS unsigned* d = (LAS unsigned*)(lds + ATT_VOFF + row * ATT_VSTR + 16 * cc); d[0] = v.x; d[1] = v.y; d[2] = v.z; d[3] = v.w; }
    const int t = b * SEQ + qb * 256 + wave * 32 + l31;
    bf16x8 qf[8];
    const bf16_t* qp = ZM + (size_t)t * 2048 + 1536 + h * 128 + 8 * hh;
#pragma unroll
    for (int ks = 0; ks < 8; ++ks) qf[ks] = *(const bf16x8*)(qp + 16 * ks);
    __syncthreads();
    f32x16 sc[8];
    const LAS unsigned char* kp = lds + l31 * ATT_KSTR + 16 * hh;
#pragma unroll
    for (int kt = 0; kt < 8; ++kt) { f32x16 acc;
#pragma unroll
        for (int r = 0; r < 16; ++r) acc[r] = 0.f;
#pragma unroll
        for (int ks = 0; ks < 8; ++ks) { const bf16x8 kf = *(const LAS bf16x8*)(kp + (32 * kt) * ATT_KSTR + 32 * ks); acc = __builtin_amdgcn_mfma_f32_32x32x16_bf16(kf, qf[ks], acc, 0, 0, 0); }
        sc[kt] = acc; }
    float mx = -3.0e38f;
#pragma unroll
    for (int kt = 0; kt < 8; ++kt)
#pragma unroll
        for (int r = 0; r < 16; ++r) mx = fmaxf(mx, sc[kt][r]);
    mx = fmaxf(mx, __shfl_xor(mx, 32));
    const float cs = 0.08838834764831845f * 1.44269504089f;
    float sum = 0.f;
#pragma unroll
    for (int kt = 0; kt < 8; ++kt)
#pragma unroll
        for (int r = 0; r < 16; ++r) { const float p = __builtin_amdgcn_exp2f((sc[kt][r] - mx) * cs); sc[kt][r] = p; sum += p; }
    sum += __shfl_xor(sum, 32);
    const float rinv = 1.0f / sum;
    bf16x8 pf[8][2];
#pragma unroll
    for (int kt = 0; kt < 8; ++kt)
#pragma unroll
        for (int s = 0; s < 2; ++s) { u32x4 w; w.x = cvt_pk_bf16(sc[kt][8 * s + 0], sc[kt][8 * s + 1]); w.y = cvt_pk_bf16(sc[kt][8 * s + 2], sc[kt][8 * s + 3]);
            w.z = cvt_pk_bf16(sc[kt][8 * s + 4], sc[kt][8 * s + 5]); w.w = cvt_pk_bf16(sc[kt][8 * s + 6], sc[kt][8 * s + 7]); pf[kt][s] = __builtin_bit_cast(bf16x8, w); }
#pragma unroll
    for (int dt = 0; dt < 4; ++dt) { f32x16 o;
#pragma unroll
        for (int r = 0; r < 16; ++r) o[r] = 0.f;
        const LAS unsigned char* vp = lds + ATT_VOFF + (32 * dt + l31) * ATT_VSTR + 8 * hh;
#pragma unroll
        for (int kt = 0; kt < 8; ++kt)
#pragma unroll
            for (int s = 0; s < 2; ++s) { const u32x2 v0 = *(const LAS u32x2*)(vp + 64 * kt + 32 * s), v1 = *(const LAS u32x2*)(vp + 64 * kt + 32 * s + 16);
                const u32x4 vv = (u32x4){v0.x, v0.y, v1.x, v1.y};
                o = __builtin_amdgcn_mfma_f32_32x32x16_bf16(__builtin_bit_cast(bf16x8, vv), pf[kt][s], o, 0, 0, 0); }
        bf16_t* op = AC + (size_t)t * CAT_LD + 2048 + h * 128 + 32 * dt + 4 * hh;
#pragma unroll
        for (int rg = 0; rg < 4; ++rg) { u32x2 w; w.x = cvt_pk_bf16(o[4 * rg + 0] * rinv, o[4 * rg + 1] * rinv); w.y = cvt_pk_bf16(o[4 * rg + 2] * rinv, o[4 * rg + 3] * rinv);
            *(u32x2*)(op + 8 * rg) = w; } }
    __syncthreads();
}

__device__ __forceinline__ void router_phase(const Args& a, LAS unsigned char* lds, int vcu, int G, int wave, int lane, int tid) {
    LAS float* wrT = (LAS float*)lds;
    for (int d = tid; d < 2048; d += NTHR) { const f32x4* wp = (const f32x4*)(a.w_router + (size_t)d * 16);
#pragma unroll
        for (int q4 = 0; q4 < 4; ++q4) { const f32x4 w = wp[q4]; wrT[(4 * q4 + 0) * 2048 + d] = w.x; wrT[(4 * q4 + 1) * 2048 + d] = w.y; wrT[(4 * q4 + 2) * 2048 + d] = w.z; wrT[(4 * q4 + 3) * 2048 + d] = w.w; } }
    __syncthreads();
    const bf16_t* X1 = (const bf16_t*)(a.ws + WS_X1B); unsigned char* H2 = (unsigned char*)(a.ws + WS_H2); float* AFF = (float*)(a.ws + WS_AFF);
    for (int gp = vcu * NWAVES + wave; gp < T / 2; gp += G * NWAVES) {
        const u32x2* xr0 = (const u32x2*)(X1 + (size_t)(2 * gp) * DM) + lane; const u32x2* xr1 = xr0 + DM / 4;
        f32x4 p[8], q[8]; float s0 = 0.f, s1 = 0.f;
#pragma unroll
        for (int j = 0; j < 8; ++j) { const u32x2 pw = xr0[64 * j], qw = xr1[64 * j];
            p[j] = (f32x4){bf_lo(pw.x), bf_hi(pw.x), bf_lo(pw.y), bf_hi(pw.y)}; q[j] = (f32x4){bf_lo(qw.x), bf_hi(qw.x), bf_lo(qw.y), bf_hi(qw.y)}; }
#pragma unroll
        for (int j = 0; j < 8; ++j) { s0 += (p[j].x * p[j].x + p[j].y * p[j].y) + (p[j].z * p[j].z + p[j].w * p[j].w); s1 += (q[j].x * q[j].x + q[j].y * q[j].y) + (q[j].z * q[j].z + q[j].w * q[j].w); }
        const float inv0 = 1.0f / sqrtf(wave_sum(s0) * (1.f / DM) + EPS), inv1 = 1.0f / sqrtf(wave_sum(s1) * (1.f / DM) + EPS);
        unsigned* h0 = (unsigned*)(H2 + (size_t)(2 * gp) * DM) + lane; unsigned* h1 = h0 + DM / 4;
#pragma unroll
        for (int j = 0; j < 8; ++j) { const f32x4 gg = ((const f32x4*)a.norm_ffn_g)[64 * j + lane];
            p[j] = p[j] * inv0 * gg; q[j] = q[j] * inv1 * gg;
            h0[64 * j] = cvt4_fp8(p[j].x * SC_H8, p[j].y * SC_H8, p[j].z * SC_H8, p[j].w * SC_H8);
            h1[64 * j] = cvt4_fp8(q[j].x * SC_H8, q[j].y * SC_H8, q[j].z * SC_H8, q[j].w * SC_H8); }
        float my0 = -3.0e38f, my1 = -3.0e38f;
#pragma unroll 1
        for (int e = 0; e < 16; ++e) { const LAS float* wb = wrT + e * 2048 + 4 * lane; float d0 = 0.f, d1 = 0.f;
#pragma unroll
            for (int j = 0; j < 8; ++j) { const f32x4 w = *(const LAS f32x4*)(wb + 256 * j);
                d0 += (p[j].x * w.x + p[j].y * w.y) + (p[j].z * w.z + p[j].w * w.w);
                d1 += (q[j].x * w.x + q[j].y * w.y) + (q[j].z * w.z + q[j].w * w.w); }
            d0 = wave_sum(d0); d1 = wave_sum(d1);
            if (lane == e) { my0 = d0; my1 = d1; } }
        float mx0 = my0, mx1 = my1;
#pragma unroll
        for (int o = 1; o < 16; o <<= 1) { mx0 = fmaxf(mx0, __shfl_xor(mx0, o)); mx1 = fmaxf(mx1, __shfl_xor(mx1, o)); }
        const float e0 = __expf(my0 - mx0), e1 = __expf(my1 - mx1); float su0 = e0, su1 = e1;
#pragma unroll
        for (int o = 1; o < 16; o <<= 1) { su0 += __shfl_xor(su0, o); su1 += __shfl_xor(su1, o); }
        if (lane < 16) { const int t = 2 * gp, b = t >> 11, s = t & 2047;
            AFF[((size_t)b * 16 + lane) * SEQ + s] = e0 / su0; AFF[((size_t)b * 16 + lane) * SEQ + s + 1] = e1 / su1; }
    }
}

__device__ __forceinline__ int wave_isum(int v) {
#pragma unroll
    for (int o = 1; o < 64; o <<= 1) v += __shfl_xor(v, o);
    return v;
}
__device__ __forceinline__ int wave_excl_scan(int v, int ln) {
    int x = v;
#pragma unroll
    for (int o = 1; o < 64; o <<= 1) { const int y = __shfl(x, (ln - o) & 63); x += (ln >= o) ? y : 0; }
    return x - v;
}
__device__ __forceinline__ void topk_phase(const Args& a, LAS unsigned char* lds, int c, int wave, int ln, int tid) {
    if (c >= 128) return;
    const int b = c & 7, e = c >> 3;
    LAS int* list = (LAS int*)(lds + 1024);
    const float* AFF = (const float*)(a.ws + WS_AFF) + ((size_t)b * 16 + e) * SEQ;
    unsigned u[32];
#pragma unroll
    for (int i = 0; i < 8; ++i) { const u32x4 w = *(const u32x4*)(AFF + 32 * ln + 4 * i); u[4 * i] = w.x; u[4 * i + 1] = w.y; u[4 * i + 2] = w.z; u[4 * i + 3] = w.w; }
    unsigned Tv = 0u;
#pragma unroll 1
    for (int bit = 30; bit >= 0; --bit) { const unsigned cand = Tv | (1u << bit);
        int lc = 0;
#pragma unroll
        for (int i = 0; i < 32; ++i) lc += (u[i] >= cand) ? 1 : 0;
        if (wave_isum(lc) >= CAP) Tv = cand; }
    int ngt_l = 0, ntie_l = 0;
#pragma unroll
    for (int i = 0; i < 32; ++i) { ngt_l += (u[i] > Tv) ? 1 : 0; ntie_l += (u[i] == Tv) ? 1 : 0; }
    const int need = CAP - wave_isum(ngt_l);
    int tr = wave_excl_scan(ntie_l, ln);
    unsigned selmask = 0u; int nsel_l = 0;
#pragma unroll
    for (int i = 0; i < 32; ++i) { const bool t = (u[i] == Tv); const bool s = (u[i] > Tv) || (t && tr < need); tr += t ? 1 : 0; selmask |= s ? (1u << i) : 0u; nsel_l += s ? 1 : 0; }
    int slot = wave_excl_scan(nsel_l, ln);
    int* INV = (int*)(a.ws + WS_INV); float* SELW = (float*)(a.ws + WS_SELW);
    if ((ln >> 3) == wave) {
#pragma unroll
        for (int i = 0; i < 32; ++i) { const int s = 32 * ln + i; const bool sl = (selmask >> i) & 1u;
            INV[((size_t)b * SEQ + s) * 16 + e] = sl ? slot : -1;
            if (sl) { list[slot] = s; SELW[((size_t)e * 8 + b) * CAP + slot] = __builtin_bit_cast(float, u[i]); ++slot; } }
    }
    __syncthreads();
    const unsigned char* H2 = (const unsigned char*)(a.ws + WS_H2); unsigned char* XIN = (unsigned char*)(a.ws + WS_XIN);
    for (int q = 0; q < CAP / NWAVES; q += 8) {
        u32x4 v[8][2];
#pragma unroll
        for (int i = 0; i < 8; ++i) { const int s = list[wave + NWAVES * (q + i)];
            const u32x4* src = (const u32x4*)(H2 + ((size_t)b * SEQ + s) * DM) + ln; v[i][0] = src[0]; v[i][1] = src[64]; }
#pragma unroll
        for (int i = 0; i < 8; ++i) { const int slot2 = wave + NWAVES * (q + i);
            u32x4* dst = (u32x4*)(XIN + (((size_t)e * 8 + b) * CAP + slot2) * DM) + ln; dst[0] = v[i][0]; dst[64] = v[i][1]; }
    }
    __syncthreads();
}

__device__ __forceinline__ void combine_phase(const Args& a, int gw, int NGW, int lane) {
    const bf16_t* Y = (const bf16_t*)(a.ws + WS_Y); const int* INV = (const int*)(a.ws + WS_INV);
    for (int t = gw; t < T; t += NGW) { const int b = t >> 11;
        float* xr = a.out + (size_t)t * DM; const u32x2* x1r = (const u32x2*)((const bf16_t*)(a.ws + WS_X1B) + (size_t)t * DM);
        f32x4 v[8];
#pragma unroll
        for (int j = 0; j < 8; ++j) { const u32x2 w = x1r[64 * j + lane]; v[j] = (f32x4){bf_lo(w.x), bf_hi(w.x), bf_lo(w.y), bf_hi(w.y)}; }
        const int myinv = DBG_SKIP_MOE ? -1 : INV[(size_t)t * 16 + (lane & 15)];
        for (int e = 0; e < 16; ++e) { const int slot = __shfl(myinv, e);
            if (slot >= 0) { const u32x2* yr = (const u32x2*)(Y + (((size_t)e * 8 + b) * CAP + slot) * DM);
#pragma unroll
                for (int j = 0; j < 8; ++j) { const u32x2 w = yr[64 * j + lane]; v[j].x += bf_lo(w.x); v[j].y += bf_hi(w.x); v[j].z += bf_lo(w.y); v[j].w += bf_hi(w.y); } } }
        float s = 0.f;
#pragma unroll
        for (int j = 0; j < 8; ++j) s += (v[j].x * v[j].x + v[j].y * v[j].y) + (v[j].z * v[j].z + v[j].w * v[j].w);
        const float inv = 1.0f / sqrtf(wave_sum(s) * (1.f / DM) + EPS);
#pragma unroll
        for (int j = 0; j < 8; ++j) { const f32x4 gg = ((const f32x4*)a.norm_final_g)[64 * j + lane]; ((f32x4*)xr)[64 * j + lane] = v[j] * inv * gg; }
    }
}

using pg8::Unit;
struct SchedFold {
    unsigned char* ws; int G, c;
    __device__ __forceinline__ bool next(int i, Unit& u) const {
        const int U = i * G + c; if (U >= 64) return false;
        const int L = U & 31, pm = L & 7, pn = L >> 3;
        if (U < 32) { u.A = (const char*)(ws + WS_PPST) + (size_t)pm * 256 * 1024 * 2; u.B0 = (const char*)(ws + WS_PWBD) + (size_t)pn * 256 * 1024 * 2; u.nt = 16; u.c0 = pn * 256; }
        else { u.A = (const char*)(ws + WS_PFT) + (size_t)pm * 256 * 1024 * 2; u.B0 = (const char*)(ws + WS_M1BD) + (size_t)pn * 256 * 1024 * 2; u.nt = 8; u.c0 = 1024 + pn * 256; }
        u.r0 = pm * 256; u.aux = 0; return true;
    }
};
struct SchedKV {
    unsigned char* ws; int G, c;
    __device__ __forceinline__ bool next(int i, Unit& u) const {
        const int cc = (c + G - (64 % G)) % G, L = i * G + cc; if (L >= 32) return false;
        u.nt = 32;
        if (L < 16) { const int pm = L & 7, pn = L >> 3; u.A = (const char*)(ws + WS_MN) + (size_t)pm * 256 * 2048 * 2; u.B0 = (const char*)(ws + WS_WKVT) + (size_t)pn * 256 * 2048 * 2; u.r0 = pm * 256; u.c0 = pn * 256; u.aux = 0; }
        else { const int L2 = L - 16, pm = L2 & 1, pn = L2 >> 1; u.A = (const char*)(ws + WS_WKVT) + (size_t)(512 + pm * 256) * 2048 * 2; u.B0 = (const char*)(ws + WS_MN) + (size_t)pn * 256 * 2048 * 2; u.r0 = pm * 256; u.c0 = pn * 256; u.aux = 1; }
        return true;
    }
};
struct EpiKV {
    static __device__ __forceinline__ bool keep_acc(const Unit&) { return false; }
    bf16_t* KM; bf16_t* VT;
    __device__ __forceinline__ void operator()(const f32x4 (&acc)[2][2][4][2], const Unit& u, int wr, int wc, int fr, int fq) const {
        pg8::EpiBf16 E{u.aux ? VT : KM, u.aux ? 2048 : 512, nullptr, 1.f}; E(acc, u, wr, wc, fr, fq);
    }
};
struct SchedTiles {
    const char* A; const char* B; int lda, ldb, nM, nN, nt, G, c, ibeg, iend, esz;
    __device__ __forceinline__ bool next(int i0, Unit& u) const {
        const int i = i0 + ibeg; if (i >= iend) return false;
        const int L = i * G + c; if (L >= nM * nN) return false;
        int pm, pn; pg8::tile_order(L, nM, nN, pm, pn);
        u.A = A + (size_t)pm * 256 * lda * esz; u.B0 = B + (size_t)pn * 256 * ldb * esz; u.nt = nt; u.r0 = pm * 256; u.c0 = pn * 256; u.aux = 0; return true;
    }
};
struct SchedDFT {
    unsigned char* ws; int G, c;
    __device__ __forceinline__ bool next(int i, Unit& u) const {
        const int U = i * G + c; if (U >= 256) return false;
        const int b = U & 7, j = U >> 3, pm = j & 15, pn = j >> 4;
        u.A = (const char*)(ws + WS_TW) + (size_t)pm * 256 * 2048 * 2; u.B0 = (const char*)(ws + WS_UT) + (size_t)(b * 512 + pn * 256) * 2048 * 2; u.nt = 32;
        u.r0 = b * SEQ + (pm & 7) * 256; u.c0 = 1024 + (pm >> 3) * 512 + pn * 256; u.aux = 0; return true;
    }
};
struct SchedProj {
    unsigned char* ws; int G, c;
    __device__ __forceinline__ bool next(int i, Unit& u) const {
        const int ti = i / 3, si = i - 3 * ti, rot = 0, s = (si + rot) % 3; const int L = ti * G + c; if (L >= 512) return false;
        int pm, pn; pg8::tile_order(L, 64, 8, pm, pn);
        const size_t co = (size_t)s * 1024 * 2;
        u.A = (const char*)(ws + WS_ACAT) + (size_t)pm * 256 * CAT_LD * 2 + co; u.B0 = (const char*)(ws + WS_BCAT) + (size_t)pn * 256 * CAT_LD * 2 + co;
        u.nt = s == 2 ? 8 : 16; u.r0 = pm * 256; u.c0 = pn * 256; u.aux = s | (((si + 1 + rot) % 3) << 2) | (si == 2 ? 32 : 0); return true;
    }
};
struct SchedGU {
    unsigned char* ws; int G, c;
    __device__ __forceinline__ bool next(int i, Unit& u) const {
        const int L = i * G + c; if (L >= 2048) return false;
        int e, pm, pn;
        if (G == 256) { const int x = c & 7, q = (c >> 3) & 31, bi = i * 8 + x; e = bi >> 2; pm = q & 7; pn = 4 * (bi & 3) + (q >> 3); }
        else { e = L >> 7; pm = L & 7; pn = (L >> 3) & 15; }
        u.A = (const char*)(ws + WS_XIN) + (size_t)(e * 8 + pm) * 256 * 2048; u.B0 = (const char*)(ws + WS_WGUT) + ((size_t)e * 4096 + pn * 256) * 2048;
        u.nt = 16; u.r0 = (e * 8 + pm) * 256; u.c0 = pn * 128; u.aux = 0; return true;
    }
};
struct SchedDown {
    unsigned char* ws; int G, c;
    __device__ __forceinline__ bool next(int i, Unit& u) const {
        const int L = i * G + c; if (L >= 1024) return false;
        int e, pm, pn;
        if (G == 256) { const int x = c & 7, q = (c >> 3) & 31, bi = i * 8 + x; e = bi >> 1; pm = q & 7; pn = 4 * (bi & 1) + (q >> 3); }
        else { e = L >> 6; pm = L & 7; pn = (L >> 3) & 7; }
        u.A = (const char*)(ws + WS_HID) + (size_t)(e * 8 + pm) * 256 * 2048; u.B0 = (const char*)(ws + WS_WDT) + ((size_t)e * 2048 + pn * 256) * 2048;
        u.nt = 16; u.r0 = (e * 8 + pm) * 256; u.c0 = pn * 256; u.aux = 0; return true;
    }
};

__global__ void __launch_bounds__(NTHR, 2) fwd_kernel(Args a) {
    extern __shared__ __attribute__((aligned(16))) unsigned char lds_raw[];
    LAS unsigned char* lds = (LAS unsigned char*)lds_raw;
    const int tid = threadIdx.x, wave = __builtin_amdgcn_readfirstlane(tid >> 6);
#define lane opaque_lane()
    const int G = gridDim.x, c = blockIdx.x;
    const int vcu = (G % 8 == 0) ? (c % 8) * (G / 8) + c / 8 : c;
    const int gw = vcu * NWAVES + wave, NGW = G * NWAVES;
    unsigned char* ws = a.ws;
    const int lo = a.ph_lo, hi = a.ph_hi;
#define IN(k) (lo <= (k) && (k) < hi)
    volatile LAS unsigned* bst = (volatile LAS unsigned*)(lds + 143360);
    if (tid < 64) ((LAS unsigned*)(lds + 143360))[tid] = 0u;
    if (tid < 256) ((LAS unsigned*)(lds + STAMP_BASE))[tid] = 0u;
    __syncthreads();
    XcdBarrier gbar = xcd_barrier_post((unsigned*)(ws + WS_CTL) + 4096, bst);
#define SEAM(k) do { if (IN(k) && IN((k) + 1)) { xcd_barrier(gbar); } STAMPN(k, 6); if (PROBE_PHASE == (k)) { STAMP(7); if (tid == 0) STAMP_EN() = 0u; } if (PROBE_PHASE == (k) + 1 && tid == 0) STAMP_EN() = 1u; } while (0)

#define PH0 if (IN(0)) { phase0(a, lds, gw, NGW, wave, lane); __syncthreads(); }
    PH0
    if (PROBE_REP == 0) { xcd_barrier(gbar); PH0 }
    SEAM(0);
    if (PROBE_PHASE == 2 && tid == 0) STAMP_EN() = 1u;
#define PH2 \
    if (!DBG_P5_FROM_XN && IN(2)) { \
          \
          \
        { SchedFold S{ws, G, c}; pg8::EpiBf16 E{(bf16_t*)(ws + WS_BCAT), CAT_LD, nullptr, 1.f}; pg8::gemm_phase<false, (PROBE_PHASE == 2)>(lds, 2048, 2048, S, E); } \
        { SchedKV S{ws, G, c}; EpiKV E{(bf16_t*)(ws + WS_KMEM), (bf16_t*)(ws + WS_VT)}; pg8::gemm_phase<false, (PROBE_PHASE == 2)>(lds, 4096, 4096, S, E); } \
        { SchedTiles S{(const char*)(ws + WS_XN), (const char*)(ws + WS_WINT), 2048, 2048, 64, 8, 32, G, c, 0, 1 << 20, 2}; pg8::EpiZ E{(bf16_t*)(ws + WS_ZM), (bf16_t*)(ws + WS_UT)}; pg8::gemm_phase<false, (PROBE_PHASE == 2)>(lds, 4096, 4096, S, E); } \
        const int csplit = 2 * ((c >> 3) & 3); \
        pg8::EpiGates8 E8{(bf16_t*)(ws + WS_G), 1.0f / (SC_H8 * SC_W8)}; \
        { SchedTiles S{(const char*)(ws + WS_XN8), (const char*)(ws + WS_WIN8), 2048, 2048, 64, 24, 16, G, c, 0, csplit, 1}; pg8::gemm_phase<true, (PROBE_PHASE == 2)>(lds, 2048, 2048, S, E8); } \
        STAMP(8); convert_experts(a, c, G, wave, lane); STAMP(9); \
        { SchedTiles S{(const char*)(ws + WS_XN8), (const char*)(ws + WS_WIN8), 2048, 2048, 64, 24, 16, G, c, csplit, 1 << 20, 1}; pg8::gemm_phase<true, (PROBE_PHASE == 2)>(lds, 2048, 2048, S, E8); } \
    }
    PH2
    if (PROBE_REP == 2) { xcd_barrier(gbar); PH2 }
    SEAM(2);
#define PH3 \
    if (!DBG_P5_FROM_XN && IN(3)) { \
        STAMPN(3, 0); { SchedDFT S{ws, G, c}; pg8::EpiBf16 E{(bf16_t*)(ws + WS_ACAT), CAT_LD, nullptr, 1.f}; pg8::gemm_phase<false, (PROBE_PHASE == 3)>(lds, 4096, 4096, S, E); } STAMPN(3, 1); \
        if (c < 256) { const int b = c & 7, j = c >> 3; attn_unit(a, lds, b, j & 3, j >> 2, wave, lane, tid); }     STAMPN(3, 2); \
        pool_pass(a, gw, NGW, lane); STAMPN(3, 3); \
    }
    PH3
    if (PROBE_REP == 3) { xcd_barrier(gbar); PH3 }
    SEAM(3);
#define PH4 \
    if (!DBG_P5_FROM_XN && IN(4)) { SchedProj S{ws, G, c}; pg8::EpiGate E{(bf16_t*)(ws + WS_MG), (const bf16_t*)(ws + WS_G)}; pg8::gemm_phase<false, (PROBE_PHASE == 4)>(lds, 2 * CAT_LD, 2 * CAT_LD, S, E); }
    PH4
    if (PROBE_REP == 4) { xcd_barrier(gbar); PH4 }
    SEAM(4);
#define PH5 \
    if (IN(5)) { \
        SchedTiles S{(const char*)(ws + (DBG_P5_FROM_XN ? WS_XN : WS_MG)), (const char*)(ws + WS_WOT), 2048, 2048, 64, 8, 32, G, c, 0, 1 << 20, 2}; \
        pg8::EpiResid E{a.x, (bf16_t*)(ws + WS_X1B)}; pg8::gemm_phase<false, (PROBE_PHASE == 5)>(lds, 4096, 4096, S, E); \
    }
    PH5
    if (PROBE_REP == 5) { xcd_barrier(gbar); PH5 }
    SEAM(5);
#define PH6 \
    if (!DBG_SKIP_MOE && IN(6)) { STAMPN(6, 0); router_phase(a, lds, vcu, G, wave, lane, tid); __syncthreads(); STAMPN(6, 1); }
    PH6
    if (PROBE_REP == 6) { xcd_barrier(gbar); PH6 }
    SEAM(6);
#define PH7 \
    if (!DBG_SKIP_MOE && IN(7)) { STAMPN(7, 0); topk_phase(a, lds, c, wave, lane, tid);     STAMPN(7, 1); }
    PH7
    if (PROBE_REP == 7) { xcd_barrier(gbar); PH7 }
    SEAM(7);
#define PH8 \
    if (!DBG_SKIP_MOE && IN(8)) { SchedGU S{ws, G, c}; pg8::EpiSwiGLU8 E{(unsigned char*)(ws + WS_HID), 1.0f / (SC_H8 * SC_W8)}; pg8::gemm_phase<true, (PROBE_PHASE == 8)>(lds, 2048, 2048, S, E); }
    PH8
    if (PROBE_REP == 8) { xcd_barrier(gbar); PH8 }
    SEAM(8);
#define PH9 \
    if (!DBG_SKIP_MOE && IN(9)) { SchedDown S{ws, G, c}; pg8::EpiBf16 E{(bf16_t*)(ws + WS_Y), 2048, (const float*)(ws + WS_SELW), 1.0f / (SC_HID8 * SC_W8)}; pg8::gemm_phase<true, (PROBE_PHASE == 9)>(lds, 2048, 2048, S, E); }
    PH9
    if (PROBE_REP == 9) { xcd_barrier(gbar); PH9 }
    SEAM(9);
    STAMPN(10, 0); if (IN(10)) combine_phase(a, gw, NGW, lane); STAMPN(10, 1);
    if (PROBE_A >= 0 && blockIdx.x == PROBE_BLK && tid == 0) { const volatile LAS unsigned long long* st = (const volatile LAS unsigned long long*)(unsigned)STAMP_BASE;
        const unsigned long long d = (st[PROBE_A] - st[PROBE_B]) * PROBE_SCALE, t0 = __builtin_amdgcn_s_memrealtime();
        if (d < 100000000ull) while (__builtin_amdgcn_s_memrealtime() - t0 < d) __builtin_amdgcn_s_sleep(8); }
#undef IN
#undef SEAM
#undef lane
}

extern "C" void kernel_launch(void* const* d_in, const int* in_sizes, int n_in, void* d_out, int out_size, void* d_ws, size_t ws_size, hipStream_t stream) {
    static int grid = 0;
    if (grid == 0) {
        if (n_in != 19 || in_sizes[0] != T * DM || out_size != T * DM || ws_size < WS_END) {
            fprintf(stderr, "kernel_launch: unexpected shapes (n_in %d, in0 %d, out %d, ws %zu, need %zu); nothing launched\n", n_in, n_in > 0 ? in_sizes[0] : -1, out_size, ws_size, (size_t)WS_END); grid = -1; return; }
        int dev = 0, cus = 0, per_cu = 0;
        if (hipGetDevice(&dev) != hipSuccess || hipDeviceGetAttribute(&cus, hipDeviceAttributeMultiprocessorCount, dev) != hipSuccess) { fprintf(stderr, "kernel_launch: device query failed\n"); grid = -1; return; }
        if (hipFuncSetAttribute((const void*)fwd_kernel, hipFuncAttributeMaxDynamicSharedMemorySize, LDS_BYTES) != hipSuccess) { fprintf(stderr, "kernel_launch: hipFuncSetAttribute failed\n"); grid = -1; return; }
        if (hipOccupancyMaxActiveBlocksPerMultiprocessor(&per_cu, (const void*)fwd_kernel, NTHR, LDS_BYTES) != hipSuccess || per_cu < 1) { fprintf(stderr, "kernel_launch: occupancy query says %d blocks per CU\n", per_cu); (void)hipGetLastError(); grid = -1; return; }
        grid = cus;
        if (grid < 256) fprintf(stderr, "kernel_launch: note: %d CUs (< 256): the attention and top-k phases run one unit per workgroup and need a grid of 256\n", grid);
    }
    if (grid < 0) return;
    Args a{};
    a.x = (const float*)d_in[0]; a.mem = (const float*)d_in[1]; a.norm_mix_g = (const float*)d_in[2]; a.norm_mem_g = (const float*)d_in[3]; a.w_in = (const float*)d_in[4];
    a.pool_w = (const float*)d_in[5]; a.pool_scale = (const float*)d_in[6]; a.fourier_w = (const float*)d_in[7]; a.w_kv = (const float*)d_in[8]; a.proj_pool = (const float*)d_in[9];
    a.proj_fourier = (const float*)d_in[10]; a.proj_mem = (const float*)d_in[11]; a.w_out = (const float*)d_in[12]; a.norm_ffn_g = (const float*)d_in[13]; a.w_router = (const float*)d_in[14];
    a.w_gate = (const float*)d_in[15]; a.w_up = (const float*)d_in[16]; a.w_down = (const float*)d_in[17]; a.norm_final_g = (const float*)d_in[18];
    a.out = (float*)d_out; a.ws = (unsigned char*)d_ws;
#if MK_MULTI_LAUNCH
    for (int p = 0; p < NPH; ++p) { a.ph_lo = p; a.ph_hi = p + 1; hipLaunchKernelGGL(fwd_kernel, dim3(grid), dim3(NTHR), LDS_BYTES, stream, a); }
#else
    a.ph_lo = 0; a.ph_hi = NPH;
    if (hipMemsetAsync((char*)d_ws + WS_CTL, 0, 65536, stream) != hipSuccess) { fprintf(stderr, "kernel_launch: hipMemsetAsync failed\n"); return; }
    void* args[] = {&a};
    hipError_t e = hipLaunchCooperativeKernel((const void*)fwd_kernel, dim3(grid), dim3(NTHR), args, LDS_BYTES, stream);
    if (e != hipSuccess) fprintf(stderr, "kernel_launch: cooperative launch failed: %s (grid %d)\n", hipGetErrorString(e), grid);
#endif
}
```

```cpp
#include <hip/hip_runtime.h>
#include <hip/hip_cooperative_groups.h>
#include <cstdio>
#include <cstdint>
namespace cg = cooperative_groups;

#ifndef MK_MULTI_LAUNCH
#define MK_MULTI_LAUNCH 0
#endif

#ifndef PROBE_REP
#define PROBE_REP -1
#endif
#ifndef DBG_P5_FROM_XN
#define DBG_P5_FROM_XN 0
#endif
#ifndef DBG_ONLY_BRANCH
#define DBG_ONLY_BRANCH -1
#endif
#ifndef DBG_SKIP_MOE
#define DBG_SKIP_MOE 0
#endif
#define LAS __attribute__((address_space(3)))
#define GAS __attribute__((address_space(1)))
typedef unsigned short bf16_t;
typedef short bf16x8 __attribute__((ext_vector_type(8)));
typedef short s16x4 __attribute__((ext_vector_type(4)));
typedef float f32x2 __attribute__((ext_vector_type(2)));
typedef float f32x4 __attribute__((ext_vector_type(4)));
typedef float f32x16 __attribute__((ext_vector_type(16)));
typedef unsigned u32x2 __attribute__((ext_vector_type(2)));
typedef unsigned u32x4 __attribute__((ext_vector_type(4)));

constexpr int T = 16384, DM = 2048, NBATCH = 8, SEQ = 2048, MEML = 256;
constexpr int NE = 16, CAP = 256;
constexpr int CAT_LD = 2560;
constexpr float EPS = 1e-6f;
constexpr int NWAVES = 8, NTHR = 512;
constexpr int NPH = 11;

constexpr size_t MiB = 1u << 20;
constexpr size_t WS_CTL  = 0;
constexpr size_t WS_WINT = 1 * MiB;
constexpr size_t WS_WIN8 = 9 * MiB;
constexpr size_t WS_WKVT = 33 * MiB;
constexpr size_t WS_PPST = 37 * MiB;
constexpr size_t WS_PFT  = 41 * MiB;
constexpr size_t WS_PWBD = 45 * MiB;
constexpr size_t WS_M1BD = 47 * MiB;
constexpr size_t WS_BCAT = 49 * MiB;
constexpr size_t WS_WOT  = 60 * MiB;
constexpr size_t WS_TW   = 68 * MiB;
constexpr size_t WS_WGUT = 84 * MiB;
constexpr size_t WS_WDT  = 339 * MiB;
constexpr size_t WS_ACT  = 467 * MiB;
constexpr size_t WS_XN   = WS_ACT;
constexpr size_t WS_MN   = WS_ACT + 64 * MiB;
constexpr size_t WS_ZM   = WS_ACT + 72 * MiB;
constexpr size_t WS_G    = WS_ACT + 136 * MiB;
constexpr size_t WS_UT   = WS_ACT + 328 * MiB;
constexpr size_t WS_KMEM = WS_ACT + 344 * MiB;
constexpr size_t WS_VT   = WS_ACT + 346 * MiB;
constexpr size_t WS_ACAT = WS_ACT + 348 * MiB;
constexpr size_t WS_MG   = WS_ACT + 432 * MiB;
constexpr size_t WS_H2   = WS_ACT;
constexpr size_t WS_XIN  = WS_ACT + 32 * MiB;
constexpr size_t WS_Y    = WS_ACT + 96 * MiB;
constexpr size_t WS_HID  = WS_ACT + 224 * MiB;
constexpr size_t WS_AFF  = WS_ACT + 320 * MiB;
constexpr size_t WS_SELW = WS_ACT + 321 * MiB;
constexpr size_t WS_INV  = WS_ACT + 322 * MiB;
constexpr size_t WS_X1B  = WS_ACT + 352 * MiB;
constexpr size_t WS_XN8  = WS_ACT + 497 * MiB;
constexpr size_t WS_END  = WS_ACT + 529 * MiB;

constexpr int LDS_BYTES = 147456;

#define LDS_WAIT() asm volatile("s_waitcnt lgkmcnt(0)" ::: "memory")
#define VM_WAIT() asm volatile("s_waitcnt vmcnt(0)" ::: "memory")
__device__ __forceinline__ unsigned f2bf(float f) { unsigned u = __builtin_bit_cast(unsigned, f); return (u + 0x7fffu + ((u >> 16) & 1u)) >> 16; }
__device__ __forceinline__ unsigned pk2(float lo, float hi) { return f2bf(lo) | (f2bf(hi) << 16); }
typedef __bf16 bf16x2_t __attribute__((ext_vector_type(2)));
__device__ __forceinline__ unsigned cvt_pk_bf16(float lo, float hi) { const bf16x2_t v = __builtin_convertvector((f32x2){lo, hi}, bf16x2_t); return __builtin_bit_cast(unsigned, v); }
typedef int i32x8 __attribute__((ext_vector_type(8)));
__device__ __forceinline__ unsigned cvt4_fp8(float a, float b, float c, float d) {
    a = __builtin_fminf(__builtin_fmaxf(a, -448.f), 448.f); b = __builtin_fminf(__builtin_fmaxf(b, -448.f), 448.f);
    c = __builtin_fminf(__builtin_fmaxf(c, -448.f), 448.f); d = __builtin_fminf(__builtin_fmaxf(d, -448.f), 448.f);
    unsigned w = 0u; w = (unsigned)__builtin_amdgcn_cvt_pk_fp8_f32(a, b, (int)w, false); w = (unsigned)__builtin_amdgcn_cvt_pk_fp8_f32(c, d, (int)w, true); return w; }
constexpr float SC_W8 = 256.f, SC_H8 = 16.f, SC_HID8 = 8.f;
__device__ __forceinline__ float bf_lo(unsigned w) { return __builtin_bit_cast(float, w << 16); }
__device__ __forceinline__ float bf_hi(unsigned w) { return __builtin_bit_cast(float, w & 0xffff0000u); }
__device__ __forceinline__ int opaque_lane() { int t = threadIdx.x; asm volatile("" : "+v"(t)); return t & 63; }
__device__ __forceinline__ float wave_sum(float v) {
#pragma unroll
    for (int o = 1; o < 64; o <<= 1) v += __shfl_xor(v, o);
    return v;
}
__device__ __forceinline__ float fast_sigmoid(float v) { return __builtin_amdgcn_rcpf(1.0f + __builtin_amdgcn_exp2f(-1.44269504089f * v)); }


#ifndef PROBE_A
#define PROBE_A -1
#endif
#ifndef PROBE_B
#define PROBE_B 0
#endif
#ifndef PROBE_PHASE
#define PROBE_PHASE -1
#endif
#ifndef PROBE_BLK
#define PROBE_BLK 0
#endif
#define PROBE_SCALE 10
#define STAMP_BASE (143360 + 1024)
#define STAMP_EN() (((volatile LAS unsigned*)(unsigned)(STAMP_BASE + 512))[0])
#ifndef PROBE_NG
#define PROBE_NG 0
#endif
#define STAMPN(ph, i) do { if (PROBE_A >= 0 && PROBE_NG && PROBE_PHASE == (ph) && blockIdx.x == PROBE_BLK && threadIdx.x == 0) { ((volatile LAS unsigned long long*)(unsigned)STAMP_BASE)[i] = __builtin_amdgcn_s_memrealtime(); } } while (0)
#define STAMP0(i) STAMPN(0, i)
#define STAMPG(i) do { if constexpr (PRB) { STAMP(i); } } while (0)
#define STAMP(i) do { if (PROBE_A >= 0 && !PROBE_NG && blockIdx.x == PROBE_BLK && threadIdx.x == 0 && STAMP_EN()) { ((volatile LAS unsigned long long*)(unsigned)STAMP_BASE)[i] = __builtin_amdgcn_s_memrealtime(); } } while (0)

#define XB_TMO      128
#define XB_XCNT(j)  (256  + 64 * (j))
#define XB_XSUB(j)  (1280 + 64 * (j))
#define XB_XGEN(j)  (2304 + 64 * (j))
#define XB_TOP      3328
#define XB_TOPGEN   3392
#define XCD_BAR_WORDS 3456
#define XB_SPIN_CAP (1u << 18)
__device__ __forceinline__ unsigned xb_ld(unsigned* p)              { return __hip_atomic_load(p, __ATOMIC_RELAXED, __HIP_MEMORY_SCOPE_AGENT); }
__device__ __forceinline__ unsigned xb_add(unsigned* p, unsigned v) { return __hip_atomic_fetch_add(p, v, __ATOMIC_RELAXED, __HIP_MEMORY_SCOPE_AGENT); }
__device__ __forceinline__ unsigned xb_xcc_id() { return (unsigned)__builtin_amdgcn_s_getreg((3 << 11) | 20) & 0xFu; }
#define XB_SPIN(cond, bar) do { unsigned _sp = 0; while (cond) { __builtin_amdgcn_s_sleep(1); \
    if ((++_sp & 255u) == 0u) { if (xb_ld(&(bar)[XB_TMO])) break; if (_sp > XB_SPIN_CAP) { atomicAdd(&(bar)[XB_TMO], 1u); break; } } } } while (0)
struct XcdBarrier { unsigned* bar; unsigned x; volatile LAS unsigned* st; };
__device__ __forceinline__ XcdBarrier xcd_barrier_post(unsigned* bar, volatile LAS unsigned* st) {
    XcdBarrier b; b.bar = bar; b.x = xb_xcc_id(); b.st = st;
    if (threadIdx.x == 0) (void)xb_add(&bar[XB_XCNT(b.x)], 1u);
    return b;
}
__device__ __forceinline__ void xcd_barrier_complete(unsigned* bar, unsigned x, unsigned& nloc, unsigned& nx) {
    const unsigned G = gridDim.x * gridDim.y * gridDim.z;
    unsigned sum, cnt, mine, sp = 0u;
    for (;;) {
        sum = 0u; cnt = 0u; mine = 0u;
#pragma unroll
        for (unsigned j = 0; j < 16; ++j) { const unsigned c = xb_ld(&bar[XB_XCNT(j)]); sum += c; cnt += (c > 0u) ? 1u : 0u; mine = (j == x) ? c : mine; }
        if (sum == G) break;
        __builtin_amdgcn_s_sleep(1);
        if ((++sp & 255u) == 0u) { if (xb_ld(&bar[XB_TMO])) break; if (sp > XB_SPIN_CAP) { atomicAdd(&bar[XB_TMO], 1u); break; } }
    }
    nloc = mine > 0u ? mine : 1u; nx = cnt > 0u ? cnt : 1u;
}
__device__ __forceinline__ void xcd_barrier(const XcdBarrier& b) {
    asm volatile("s_waitcnt vmcnt(0)" ::: "memory");
    __syncthreads();
    if (threadIdx.x == 0) {
        unsigned* bar = b.bar;
        __builtin_amdgcn_s_waitcnt(0);
        unsigned nloc = b.st[0], nx = b.st[1];
        if (nloc == 0u) { xcd_barrier_complete(bar, b.x, nloc, nx); b.st[0] = nloc; b.st[1] = nx; }
        const unsigned old = xb_add(&bar[XB_XSUB(b.x)], 1u);
        const unsigned gen = old / nloc;
        if (old + 1u == (gen + 1u) * nloc) {
            __builtin_amdgcn_fence(__ATOMIC_RELEASE, "agent");
            asm volatile("s_waitcnt vmcnt(0)" ::: "memory");
            const unsigned og = xb_add(&bar[XB_TOP], 1u);
            const unsigned tg = og / nx;
            if (og + 1u == (tg + 1u) * nx) xb_add(&bar[XB_TOPGEN], 1u);
            else XB_SPIN(xb_ld(&bar[XB_TOPGEN]) == tg, bar);
            __builtin_amdgcn_fence(__ATOMIC_ACQUIRE, "agent");
            xb_add(&bar[XB_XGEN(b.x)], 1u);
            asm volatile("s_waitcnt vmcnt(0)" ::: "memory");
        } else {
            XB_SPIN(xb_ld(&bar[XB_XGEN(b.x)]) == gen, bar);
            __builtin_amdgcn_fence(__ATOMIC_ACQUIRE, "agent");
            asm volatile("s_waitcnt vmcnt(0)" ::: "memory");
        }
    }
    __syncthreads();
}

namespace pg8 {
typedef int i32x4v __attribute__((ext_vector_type(4)));
template <bool F8> struct FragT { bf16x8 bf[2]; };
template <> struct FragT<true> { i32x8 f8; };
constexpr int BM = 256, BK = 64, HALF = 128, HTB = HALF * BK * 2, STAGE_BYTES = 8 * HTB;
__device__ __forceinline__ int lds_byte(int r, int c) { const int st = (r >> 4) * 2 + (c >> 5), rr = r & 15, cc = c & 31, ob = rr * 64 + cc * 2; return st * 1024 + (ob ^ (((ob >> 9) & 1) << 5)); }
__device__ __forceinline__ void stage_rc(int b, int& R, int& C) { const int st = b / 1024, sb = b % 1024, swz = sb ^ (((sb >> 9) & 1) << 5); R = (st >> 1) * 16 + swz / 64; C = (st & 1) * 32 + (swz % 64) / 2; }
__device__ __forceinline__ int perm32(int rho) { const int n = rho >> 4, i = rho & 15; return 8 * (i >> 2) + 4 * n + (i & 3); }

struct Unit { const char* A; const char* B0; int nt; int r0, c0, aux; };

__device__ __forceinline__ void tile_order(int L, int nM, int nN, int& pm, int& pn) {
    const int nwg = nM * nN;
    int wgid = L; { const int q = nwg / 8, r = nwg % 8, xcd = wgid % 8, off = wgid / 8; wgid = (xcd < r ? xcd * (q + 1) : r * (q + 1) + (xcd - r) * q) + off; }
    const int nig = 8 * nN, gid = wgid / nig, fm = gid * 8, gsz = (nM - fm) < 8 ? (nM - fm) : 8;
    pm = fm + ((wgid % nig) % gsz); pn = (wgid % nig) / gsz;
}

template <bool FP8, bool PRB = false, class Epi, class Sched>
__device__ __forceinline__ void gemm_phase(LAS unsigned char* lds, const int lda, const int ldb, const Sched& S, const Epi& E) {
    int tid = threadIdx.x; asm volatile("" : "+v"(tid));
    const int wid = __builtin_amdgcn_readfirstlane(tid >> 6), lane = tid & 63, wr = wid >> 2, wc = wid & 3, fr = lane & 15, fq = lane >> 4;
    unsigned voffA[2], voffB[2];
#pragma unroll
    for (int i = 0; i < 2; ++i) { int R, C; stage_rc(tid * 16 + i * 8192, R, C); const int Rb = (R & ~31) + perm32(R & 31);
        voffA[i] = (unsigned)(R * lda + C * 2); voffB[i] = (unsigned)(Rb * ldb + C * 2); }
    const size_t kstep = (size_t)(BK * 2);
    const size_t hstepA = (size_t)HALF * lda, hstepB = (size_t)HALF * ldb;
    const unsigned ldsw = (unsigned)wid * 1024u;
    const int aoff = lds_byte(wr * 64 + fr, FP8 ? fq * 16 : fq * 8), boff = lds_byte(wc * 32 + fr, FP8 ? fq * 16 : fq * 8);
#define PG8_SA(b, h) (((b) * 2 + (h)) * HTB)
#define PG8_SB(b, h) ((4 + (b) * 2 + (h)) * HTB)
#define PG8_STAGE(bufoff, gbase, voff) do { const char* _gb = (const char*)(gbase); asm volatile("" : "+s"(_gb)); _Pragma("unroll") for (int _i = 0; _i < 2; ++_i) { \
        unsigned _vo = (voff)[_i]; asm volatile("" : "+v"(_vo)); \
        __builtin_amdgcn_global_load_lds((const unsigned*)(_gb + _vo), (LAS unsigned*)(lds + (bufoff) + ldsw + _i * 8192), 16, 0, 0); } } while (0)
#define PG8_LDA(dst, b, h) do { _Pragma("unroll") for (int m = 0; m < 4; ++m) { if constexpr (FP8) { \
            const i32x4v lo_ = *(const LAS i32x4v*)(lds + PG8_SA(b, h) + aoff + m * 2048), hi_ = *(const LAS i32x4v*)(lds + PG8_SA(b, h) + aoff + m * 2048 + 16); \
            dst[m].f8 = __builtin_shufflevector(lo_, hi_, 0, 1, 2, 3, 4, 5, 6, 7); } \
        else { _Pragma("unroll") for (int k = 0; k < 2; ++k) dst[m].bf[k] = *(const LAS bf16x8*)(lds + PG8_SA(b, h) + aoff + m * 2048 + k * 1024); } } } while (0)
#define PG8_LDB(dst, b, h) do { _Pragma("unroll") for (int n = 0; n < 2; ++n) { if constexpr (FP8) { \
            const i32x4v lo_ = *(const LAS i32x4v*)(lds + PG8_SB(b, h) + boff + n * 2048), hi_ = *(const LAS i32x4v*)(lds + PG8_SB(b, h) + boff + n * 2048 + 16); \
            dst[n].f8 = __builtin_shufflevector(lo_, hi_, 0, 1, 2, 3, 4, 5, 6, 7); } \
        else { _Pragma("unroll") for (int k = 0; k < 2; ++k) dst[n].bf[k] = *(const LAS bf16x8*)(lds + PG8_SB(b, h) + boff + n * 2048 + k * 1024); } } } while (0)
#define PG8_MMA(ai, bj, At, Bt) do { __builtin_amdgcn_s_setprio(1); _Pragma("unroll") for (int m = 0; m < 4; ++m) _Pragma("unroll") for (int n = 0; n < 2; ++n) { \
        if constexpr (FP8) acc[ai][bj][m][n] = __builtin_amdgcn_mfma_scale_f32_16x16x128_f8f6f4(Bt[n].f8, At[m].f8, acc[ai][bj][m][n], 0, 0, 0, 0x7F7F7F7F, 0, 0x7F7F7F7F); \
        else { _Pragma("unroll") for (int k = 0; k < 2; ++k) acc[ai][bj][m][n] = __builtin_amdgcn_mfma_f32_16x16x32_bf16(Bt[n].bf[k], At[m].bf[k], acc[ai][bj][m][n], 0, 0, 0); } } \
        __builtin_amdgcn_s_setprio(0); } while (0)
#define PG8_WAIT_V(n) asm volatile("s_waitcnt vmcnt(" #n ")" ::: "memory")
#define PG8_WAIT_L(n) asm volatile("s_waitcnt lgkmcnt(" #n ")" ::: "memory")
#define PG8_BAR __builtin_amdgcn_s_barrier()
#define PG8_SCHED __builtin_amdgcn_sched_barrier(0)
    Unit cur, nxt; int ui = 0;
    STAMPG(0);
    if (!S.next(0, cur)) return;
    f32x4 acc[2][2][4][2];
#pragma unroll
    for (int a = 0; a < 2; ++a)
#pragma unroll
        for (int b = 0; b < 2; ++b)
#pragma unroll
            for (int m = 0; m < 4; ++m)
#pragma unroll
                for (int n = 0; n < 2; ++n) acc[a][b][m][n] = (f32x4){0.f, 0.f, 0.f, 0.f};
    FragT<FP8> At[4], B0[2], B1[2];
    const char* cA = cur.A; const char* cB0 = cur.B0;
    PG8_STAGE(PG8_SB(0, 0), cB0, voffB); PG8_STAGE(PG8_SB(0, 1), cB0 + hstepB, voffB); PG8_STAGE(PG8_SA(0, 0), cA, voffA); PG8_STAGE(PG8_SA(0, 1), cA + hstepA, voffA);
    if (wr == 1) PG8_BAR;
    PG8_WAIT_V(2); PG8_BAR;
    PG8_STAGE(PG8_SB(1, 0), cB0 + kstep, voffB); PG8_STAGE(PG8_SA(1, 0), cA + kstep, voffA); PG8_STAGE(PG8_SB(1, 1), cB0 + hstepB + kstep, voffB);
    PG8_WAIT_V(6); PG8_BAR;
    STAMPG(1);
    for (;;) {
        const bool has_next = S.next(ui + 1, nxt);
        const char* nA = has_next ? nxt.A : cA; const char* nB0 = has_next ? nxt.B0 : cB0;
        const int nt = cur.nt;
        for (int t = 0; t < nt; t += 2) {
            const bool last = (t == nt - 2);
            const char* a1 = cA + (size_t)(t + 1) * kstep;
            const char* a2 = last ? nA : cA + (size_t)(t + 2) * kstep;
            const char* b20 = last ? nB0 : cB0 + (size_t)(t + 2) * kstep; const char* b21 = b20 + hstepB;
            const char* a3 = a2 + kstep; const char* b30 = b20 + kstep; const char* b31 = b21 + kstep;
            PG8_LDB(B0, 0, 0); PG8_LDB(B1, 0, 1); PG8_SCHED; PG8_LDA(At, 0, 0); PG8_STAGE(PG8_SA(1, 1), a1 + hstepA, voffA);
            PG8_WAIT_V(8); PG8_WAIT_L(0); PG8_BAR; PG8_MMA(0, 0, At, B0); PG8_MMA(0, 1, At, B1); PG8_BAR; PG8_SCHED;
            PG8_LDA(At, 0, 1); PG8_STAGE(PG8_SB(0, 0), b20, voffB); PG8_STAGE(PG8_SB(0, 1), b21, voffB); PG8_STAGE(PG8_SA(0, 0), a2, voffA);
            PG8_WAIT_V(8); PG8_WAIT_L(0); PG8_BAR; PG8_MMA(1, 0, At, B0); PG8_MMA(1, 1, At, B1); PG8_BAR; PG8_SCHED;
            PG8_LDB(B0, 1, 0); PG8_LDB(B1, 1, 1); PG8_SCHED; PG8_LDA(At, 1, 0); PG8_STAGE(PG8_SA(0, 1), a2 + hstepA, voffA);
            PG8_WAIT_V(8); PG8_WAIT_L(0); PG8_BAR; PG8_MMA(0, 0, At, B0); PG8_MMA(0, 1, At, B1); PG8_BAR; PG8_SCHED;
            PG8_LDA(At, 1, 1); PG8_STAGE(PG8_SB(1, 0), b30, voffB); PG8_STAGE(PG8_SB(1, 1), b31, voffB); PG8_STAGE(PG8_SA(1, 0), a3, voffA);
            PG8_WAIT_V(8); PG8_WAIT_L(0); PG8_BAR; PG8_MMA(1, 0, At, B0); PG8_MMA(1, 1, At, B1); PG8_BAR; PG8_SCHED;
        }
        if (wr == 0) PG8_BAR;
        if (ui == 0) STAMPG(2); STAMPG(4);
        E(acc, cur, wr, wc, fr, fq);
        if (PROBE_A >= 0 && PRB) { asm volatile("s_waitcnt vmcnt(0)" ::: "memory"); } if (ui == 0) STAMPG(3); STAMPG(5);
        if (!has_next) break;
        if (!Epi::keep_acc(cur)) {
#pragma unroll
        for (int a = 0; a < 2; ++a)
#pragma unroll
            for (int b = 0; b < 2; ++b)
#pragma unroll
                for (int m = 0; m < 4; ++m)
#pragma unroll
                    for (int n = 0; n < 2; ++n) acc[a][b][m][n] = (f32x4){0.f, 0.f, 0.f, 0.f}; }
        cur = nxt; cA = nA; cB0 = nB0; ++ui;
        if (wr == 1) PG8_BAR;
    }
    PG8_WAIT_V(0);
    PG8_BAR;
    STAMPG(6);
#undef PG8_SA
#undef PG8_SB
#undef PG8_STAGE
#undef PG8_LDA
#undef PG8_LDB
#undef PG8_MMA
#undef PG8_WAIT_V
#undef PG8_WAIT_L
#undef PG8_BAR
#undef PG8_SCHED
}

struct EpiBf16 {
    static __device__ __forceinline__ bool keep_acc(const Unit&) { return false; }
    bf16_t* O; int ldc; const float* rowscale; float mul;
    __device__ __forceinline__ void operator()(const f32x4 (&acc)[2][2][4][2], const Unit& u, int wr, int wc, int fr, int fq) const {
        const int row0 = u.r0 + wr * 64 + fr, col0 = u.c0 + wc * 32 + 8 * fq;
#pragma unroll
        for (int ai = 0; ai < 2; ++ai)
#pragma unroll
            for (int m = 0; m < 4; ++m) { const int row = row0 + ai * HALF + m * 16; const float sc = rowscale ? rowscale[row] * mul : mul;
                bf16_t* rowp = O + (size_t)row * ldc + col0;
#pragma unroll
                for (int bj = 0; bj < 2; ++bj) { const f32x4 v0 = acc[ai][bj][m][0] * sc, v1 = acc[ai][bj][m][1] * sc;
                    u32x4 w; w.x = cvt_pk_bf16(v0[0], v0[1]); w.y = cvt_pk_bf16(v0[2], v0[3]); w.z = cvt_pk_bf16(v1[0], v1[1]); w.w = cvt_pk_bf16(v1[2], v1[3]);
                    *(u32x4*)(rowp + bj * HALF) = w; } }
    }
};
struct EpiZ {
    static __device__ __forceinline__ bool keep_acc(const Unit&) { return false; }
    bf16_t* ZM; bf16_t* UT;
    __device__ __forceinline__ void operator()(const f32x4 (&acc)[2][2][4][2], const Unit& u, int wr, int wc, int fr, int fq) const {
        const int row0 = u.r0 + wr * 64 + fr, col0 = u.c0 + wc * 32 + 8 * fq;
        if (u.c0 >= 1024 && u.c0 < 1536) {
#pragma unroll
            for (int ai = 0; ai < 2; ++ai)
#pragma unroll
                for (int m = 0; m < 4; ++m) { const int row = row0 + ai * HALF + m * 16; const int b = row >> 11, s = row & 2047;
                    bf16_t* base = UT + ((size_t)b * 512 + (col0 - 1024)) * 2048 + s;
#pragma unroll
                    for (int bj = 0; bj < 2; ++bj)
#pragma unroll
                        for (int n = 0; n < 2; ++n)
#pragma unroll
                            for (int j = 0; j < 4; ++j) base[(size_t)(bj * HALF + 4 * n + j) * 2048] = (bf16_t)f2bf(acc[ai][bj][m][n][j]); }
        } else {
#pragma unroll
            for (int ai = 0; ai < 2; ++ai)
#pragma unroll
                for (int m = 0; m < 4; ++m) { bf16_t* rowp = ZM + (size_t)(row0 + ai * HALF + m * 16) * 2048 + col0;
#pragma unroll
                    for (int bj = 0; bj < 2; ++bj) { const f32x4 v0 = acc[ai][bj][m][0], v1 = acc[ai][bj][m][1];
                        u32x4 w; w.x = cvt_pk_bf16(v0[0], v0[1]); w.y = cvt_pk_bf16(v0[2], v0[3]); w.z = cvt_pk_bf16(v1[0], v1[1]); w.w = cvt_pk_bf16(v1[2], v1[3]);
                        *(u32x4*)(rowp + bj * HALF) = w; } }
        }
    }
};
struct EpiGates8 {
    static __device__ __forceinline__ bool keep_acc(const Unit&) { return false; }
    bf16_t* G; float inmul;
    __device__ __forceinline__ void operator()(const f32x4 (&acc)[2][2][4][2], const Unit& u, int wr, int wc, int fr, int fq) const {
        const int row0 = u.r0 + wr * 64 + fr, col0 = u.c0 + wc * 32 + 8 * fq;
#pragma unroll
        for (int ai = 0; ai < 2; ++ai)
#pragma unroll
            for (int m = 0; m < 4; ++m) { bf16_t* rowp = G + (size_t)(row0 + ai * HALF + m * 16) * 6144 + col0;
#pragma unroll
                for (int bj = 0; bj < 2; ++bj) { const f32x4 a0 = acc[ai][bj][m][0] * inmul, a1 = acc[ai][bj][m][1] * inmul;
                    u32x4 w; w.x = cvt_pk_bf16(fast_sigmoid(a0[0]), fast_sigmoid(a0[1])); w.y = cvt_pk_bf16(fast_sigmoid(a0[2]), fast_sigmoid(a0[3]));
                    w.z = cvt_pk_bf16(fast_sigmoid(a1[0]), fast_sigmoid(a1[1])); w.w = cvt_pk_bf16(fast_sigmoid(a1[2]), fast_sigmoid(a1[3]));
                    *(u32x4*)(rowp + bj * HALF) = w; } }
    }
};
struct EpiGate {
    static __device__ __forceinline__ bool keep_acc(const Unit& u) { return (u.aux & 32) == 0; }
    bf16_t* MG; const bf16_t* G;
    __device__ __forceinline__ void operator()(f32x4 (&acc)[2][2][4][2], const Unit& u, int wr, int wc, int fr, int fq) const {
        const int row0 = u.r0 + wr * 64 + fr, col0 = u.c0 + wc * 32 + 8 * fq; const int gs = u.aux & 3, gn = (u.aux >> 2) & 3; const bool last = (u.aux & 32) != 0;
#pragma unroll
        for (int ai = 0; ai < 2; ++ai)
#pragma unroll
            for (int m = 0; m < 4; ++m) { const int row = row0 + ai * HALF + m * 16;
                const bf16_t* gp = G + (size_t)row * 6144 + gs * 2048 + col0; const bf16_t* gq = G + (size_t)row * 6144 + gn * 2048 + col0;
#pragma unroll
                for (int bj = 0; bj < 2; ++bj) { const u32x4 g = *(const u32x4*)(gp + bj * HALF);
                    float f[8] = {bf_lo(g.x), bf_hi(g.x), bf_lo(g.y), bf_hi(g.y), bf_lo(g.z), bf_hi(g.z), bf_lo(g.w), bf_hi(g.w)};
                    if (!last) { const u32x4 h = *(const u32x4*)(gq + bj * HALF);
                        const float d[8] = {bf_lo(h.x), bf_hi(h.x), bf_lo(h.y), bf_hi(h.y), bf_lo(h.z), bf_hi(h.z), bf_lo(h.w), bf_hi(h.w)};
#pragma unroll
                        for (int j = 0; j < 8; ++j) f[j] = f[j] * __builtin_amdgcn_rcpf(__builtin_fmaxf(d[j], 1e-30f)); }
                    f32x4 a0 = acc[ai][bj][m][0], a1 = acc[ai][bj][m][1];
                    a0[0] *= f[0]; a0[1] *= f[1]; a0[2] *= f[2]; a0[3] *= f[3]; a1[0] *= f[4]; a1[1] *= f[5]; a1[2] *= f[6]; a1[3] *= f[7];
                    if (last) { u32x4 w; w.x = cvt_pk_bf16(a0[0], a0[1]); w.y = cvt_pk_bf16(a0[2], a0[3]); w.z = cvt_pk_bf16(a1[0], a1[1]); w.w = cvt_pk_bf16(a1[2], a1[3]);
                        *(u32x4*)(MG + (size_t)row * 2048 + col0 + bj * HALF) = w; }
                    else { acc[ai][bj][m][0] = a0; acc[ai][bj][m][1] = a1; } } }
    }
};
struct EpiResid {
    static __device__ __forceinline__ bool keep_acc(const Unit&) { return false; }
    const float* X; bf16_t* O;
    __device__ __forceinline__ void operator()(const f32x4 (&acc)[2][2][4][2], const Unit& u, int wr, int wc, int fr, int fq) const {
        const int row0 = u.r0 + wr * 64 + fr, col0 = u.c0 + wc * 32 + 8 * fq;
#pragma unroll
        for (int ai = 0; ai < 2; ++ai)
#pragma unroll
            for (int m = 0; m < 4; ++m) { const size_t off = (size_t)(row0 + ai * HALF + m * 16) * 2048 + col0;
#pragma unroll
                for (int bj = 0; bj < 2; ++bj) { const f32x4 x0 = *(const f32x4*)(X + off + bj * HALF), x1 = *(const f32x4*)(X + off + bj * HALF + 4);
                    const f32x4 v0 = x0 + acc[ai][bj][m][0], v1 = x1 + acc[ai][bj][m][1];
                    u32x4 w; w.x = cvt_pk_bf16(v0[0], v0[1]); w.y = cvt_pk_bf16(v0[2], v0[3]); w.z = cvt_pk_bf16(v1[0], v1[1]); w.w = cvt_pk_bf16(v1[2], v1[3]);
                    *(u32x4*)(O + off + bj * HALF) = w; } }
    }
};
struct EpiSwiGLU8 {
    static __device__ __forceinline__ bool keep_acc(const Unit&) { return false; }
    unsigned char* H; float inmul;
    __device__ __forceinline__ void operator()(const f32x4 (&acc)[2][2][4][2], const Unit& u, int wr, int wc, int fr, int fq) const {
        const int row0 = u.r0 + wr * 64 + fr, col0 = u.c0 + wc * 32 + 8 * fq;
#pragma unroll
        for (int ai = 0; ai < 2; ++ai)
#pragma unroll
            for (int m = 0; m < 4; ++m) { unsigned char* rowp = H + (size_t)(row0 + ai * HALF + m * 16) * 2048 + col0;
                float h[8];
#pragma unroll
                for (int n = 0; n < 2; ++n)
#pragma unroll
                    for (int j = 0; j < 4; ++j) { const float g = acc[ai][0][m][n][j] * inmul, up = acc[ai][1][m][n][j] * inmul; h[4 * n + j] = g * fast_sigmoid(g) * up * SC_HID8; }
                u32x2 w; w.x = cvt4_fp8(h[0], h[1], h[2], h[3]); w.y = cvt4_fp8(h[4], h[5], h[6], h[7]);
                *(u32x2*)rowp = w; }
    }
};
}

struct Args {
    const float* x; const float* mem; const float* norm_mix_g; const float* norm_mem_g; const float* w_in; const float* pool_w; const float* pool_scale; const float* fourier_w;
    const float* w_kv; const float* proj_pool; const float* proj_fourier; const float* proj_mem; const float* w_out; const float* norm_ffn_g; const float* w_router;
    const float* w_gate; const float* w_up; const float* w_down; const float* norm_final_g;
    float* out; unsigned char* ws; int ph_lo, ph_hi;
};

template <bool FP8>
__device__ __forceinline__ void p0_tile64(const float* W, int N, int k0, int n0, void* WT, int ldt, int drow0, const float* kscale, float mul, int lane) {
    if constexpr (FP8) {
        const int lr = lane >> 4, lc = 4 * (lane & 15);
        f32x4 v[16];
#pragma unroll
        for (int i = 0; i < 16; ++i) v[i] = *(const f32x4*)(W + (size_t)(k0 + 16 * lr + i) * N + n0 + lc);
#pragma unroll
        for (int i = 0; i < 16; ++i) { float sc = mul; if (kscale) sc *= kscale[k0 + 16 * lr + i]; v[i] = v[i] * sc; }
#pragma unroll
        for (int n = 0; n < 4; ++n) { u32x4 o;
            o.x = cvt4_fp8(v[0][n], v[1][n], v[2][n], v[3][n]); o.y = cvt4_fp8(v[4][n], v[5][n], v[6][n], v[7][n]);
            o.z = cvt4_fp8(v[8][n], v[9][n], v[10][n], v[11][n]); o.w = cvt4_fp8(v[12][n], v[13][n], v[14][n], v[15][n]);
            *(u32x4*)((unsigned char*)WT + (size_t)(drow0 + lc + n) * ldt + k0 + 16 * lr) = o; }
    } else {
        const int kq = lane & 7, cg = lane >> 3;
        f32x4 v[2][8];
#pragma unroll
        for (int h = 0; h < 2; ++h)
#pragma unroll
            for (int i = 0; i < 8; ++i) v[h][i] = *(const f32x4*)(W + (size_t)(k0 + 8 * kq + i) * N + n0 + 32 * h + 4 * cg);
        if (kscale) {
#pragma unroll
            for (int i = 0; i < 8; ++i) { const float sc = kscale[k0 + 8 * kq + i]; v[0][i] = v[0][i] * sc; v[1][i] = v[1][i] * sc; } }
#pragma unroll
        for (int h = 0; h < 2; ++h)
#pragma unroll
            for (int n = 0; n < 4; ++n) { u32x4 o;
                o.x = cvt_pk_bf16(v[h][0][n], v[h][1][n]); o.y = cvt_pk_bf16(v[h][2][n], v[h][3][n]); o.z = cvt_pk_bf16(v[h][4][n], v[h][5][n]); o.w = cvt_pk_bf16(v[h][6][n], v[h][7][n]);
                *(u32x4*)((bf16_t*)WT + (size_t)(drow0 + 32 * h + 4 * cg + n) * ldt + k0 + 8 * kq) = o; }
    }
}
__device__ __forceinline__ void rms_row_to_bf16(const float* xrow, const float* g, bf16_t* orow, unsigned char* orow8, int lane) {
    const f32x4* xr = (const f32x4*)xrow + lane; const f32x4* gr = (const f32x4*)g + lane;
    f32x4 v[8]; float s = 0.f;
#pragma unroll
    for (int j = 0; j < 8; ++j) { v[j] = xr[64 * j]; s += (v[j].x * v[j].x + v[j].y * v[j].y) + (v[j].z * v[j].z + v[j].w * v[j].w); }
    const float inv = 1.0f / sqrtf(wave_sum(s) * (1.f / DM) + EPS);
    u32x2* o8 = (u32x2*)orow + lane;
#pragma unroll
    for (int j = 0; j < 8; ++j) { const f32x4 gg = gr[64 * j]; const f32x4 h = v[j] * inv * gg; u32x2 w; w.x = cvt_pk_bf16(h.x, h.y); w.y = cvt_pk_bf16(h.z, h.w); o8[64 * j] = w;
        if (orow8) ((unsigned*)orow8)[64 * j + lane] = cvt4_fp8(h.x * SC_H8, h.y * SC_H8, h.z * SC_H8, h.w * SC_H8); }
}

struct ExItem { const float* src; unsigned char* dst; int k0, n0, drow0; };
__device__ __forceinline__ ExItem ex_item(const Args& a, int r) {
    constexpr int I_EX = 32 * 32; const int mat = r / I_EX, w = r % I_EX, type = mat / 16, e = mat % 16, kb = w / 32, nb = w % 32, n0 = nb * 64;
    ExItem it; it.src = (type == 0 ? a.w_gate : (type == 1 ? a.w_up : a.w_down)) + (size_t)e * 2048 * 2048; it.k0 = kb * 64; it.n0 = n0;
    if (type < 2) { it.dst = a.ws + WS_WGUT + (size_t)e * 4096 * 2048; it.drow0 = ((n0 >> 7) << 8) + (n0 & 127) + (type == 1 ? 128 : 0); }
    else { it.dst = a.ws + WS_WDT + (size_t)e * 2048 * 2048; it.drow0 = n0; }
    return it;
}
__device__ __forceinline__ void ex_load(const ExItem& it, f32x4 (&v)[16], int lane) {
    const int lr = lane >> 4, lc = 4 * (lane & 15);
#pragma unroll
    for (int i = 0; i < 16; ++i) v[i] = __builtin_nontemporal_load((const f32x4*)(it.src + (size_t)(it.k0 + 16 * lr + i) * 2048 + it.n0 + lc));
}
__device__ __forceinline__ void ex_store(const ExItem& it, const f32x4 (&v)[16], int lane) {
    const int lr = lane >> 4, lc = 4 * (lane & 15);
#pragma unroll
    for (int n = 0; n < 4; ++n) { u32x4 o;
        o.x = cvt4_fp8(v[0][n] * SC_W8, v[1][n] * SC_W8, v[2][n] * SC_W8, v[3][n] * SC_W8); o.y = cvt4_fp8(v[4][n] * SC_W8, v[5][n] * SC_W8, v[6][n] * SC_W8, v[7][n] * SC_W8);
        o.z = cvt4_fp8(v[8][n] * SC_W8, v[9][n] * SC_W8, v[10][n] * SC_W8, v[11][n] * SC_W8); o.w = cvt4_fp8(v[12][n] * SC_W8, v[13][n] * SC_W8, v[14][n] * SC_W8, v[15][n] * SC_W8);
        __builtin_nontemporal_store(o, (u32x4*)(it.dst + (size_t)(it.drow0 + lc + n) * 2048 + it.k0 + 16 * lr)); }
}
__device__ __forceinline__ void convert_experts(const Args& a, int c, int G, int wave, int lane) {
    constexpr int NEXP = 48 * 32 * 32;
    int start, cnt;
    if (G == 256) { if (c >= 64 && c < 96) { cnt = 192; start = (c - 64) * 192; } else if (c < 64) { cnt = 212; start = 6144 + c * 212; } else { cnt = 184; start = 19712 + (c - 96) * 184; } }
    else { const int per = (NEXP + G - 1) / G; start = c * per; cnt = (start + per <= NEXP) ? per : (NEXP > start ? NEXP - start : 0); }
    const int end = start + cnt;
    int r = start + wave; if (r >= end) return;
    f32x4 va[16], vb[16];
    ExItem ia = ex_item(a, r), ib; ex_load(ia, va, lane);
    for (;;) {
        const bool hb = (r + NWAVES) < end; if (hb) { ib = ex_item(a, r + NWAVES); ex_load(ib, vb, lane); }
        ex_store(ia, va, lane);
        if (!hb) break;
        r += NWAVES;
        const bool ha = (r + NWAVES) < end; if (ha) { ia = ex_item(a, r + NWAVES); ex_load(ia, va, lane); }
        ex_store(ib, vb, lane);
        if (!ha) break;
        r += NWAVES;
    }
}
__device__ __forceinline__ void rms_row2_to_bf16(const float* xrow, const float* g, bf16_t* orow, unsigned char* orow8, int lane) {
    const f32x4* xr = (const f32x4*)xrow + lane; const f32x4* gr = (const f32x4*)g + lane;
    f32x4 v[2][8]; float s0 = 0.f, s1 = 0.f;
#pragma unroll
    for (int j = 0; j < 8; ++j) { v[0][j] = xr[64 * j]; v[1][j] = xr[512 + 64 * j]; }
#pragma unroll
    for (int j = 0; j < 8; ++j) { s0 += (v[0][j].x * v[0][j].x + v[0][j].y * v[0][j].y) + (v[0][j].z * v[0][j].z + v[0][j].w * v[0][j].w); s1 += (v[1][j].x * v[1][j].x + v[1][j].y * v[1][j].y) + (v[1][j].z * v[1][j].z + v[1][j].w * v[1][j].w); }
    const float inv0 = 1.0f / sqrtf(wave_sum(s0) * (1.f / DM) + EPS), inv1 = 1.0f / sqrtf(wave_sum(s1) * (1.f / DM) + EPS);
    u32x2* o8 = (u32x2*)orow + lane; unsigned* of8 = (unsigned*)orow8 + lane;
#pragma unroll
    for (int j = 0; j < 8; ++j) { const f32x4 gg = gr[64 * j]; const f32x4 h0 = v[0][j] * inv0 * gg, h1 = v[1][j] * inv1 * gg;
        u32x2 w0; w0.x = cvt_pk_bf16(h0.x, h0.y); w0.y = cvt_pk_bf16(h0.z, h0.w); o8[64 * j] = w0;
        u32x2 w1; w1.x = cvt_pk_bf16(h1.x, h1.y); w1.y = cvt_pk_bf16(h1.z, h1.w); o8[512 + 64 * j] = w1;
        of8[64 * j] = cvt4_fp8(h0.x * SC_H8, h0.y * SC_H8, h0.z * SC_H8, h0.w * SC_H8); of8[512 + 64 * j] = cvt4_fp8(h1.x * SC_H8, h1.y * SC_H8, h1.z * SC_H8, h1.w * SC_H8); }
}
__device__ __forceinline__ void phase0(const Args& a, LAS unsigned char* lds, int gw, int NGW, int wave, int lane) {
    unsigned char* ws = a.ws;
    STAMP0(0);
    LAS float* tab = (LAS float*)lds;
    { const int t_ = threadIdx.x; if (t_ < 128) { tab[t_] = cospif((float)t_ * (1.0f / 64.0f)); tab[128 + t_] = -sinpif((float)t_ * (1.0f / 64.0f)); } }
    __syncthreads();
    constexpr int I_WIN = 32 * 128, I_KV = 32 * 16, I_PP = 16 * 32, I_PF = 8 * 32, I_PM = 8 * 32, I_WO = 32 * 32;
    constexpr int NITEMS = I_WIN + I_KV + I_PP + I_PF + I_PM + I_WO;
    for (int it = gw; it < NITEMS; it += NGW) {
        int r = it;
        if (r < I_WIN) { const int kb = r / 128, nb = r % 128;
            if (nb < 32) p0_tile64<false>(a.w_in, 8192, kb * 64, nb * 64, ws + WS_WINT, 2048, nb * 64, nullptr, 1.f, lane);
            else p0_tile64<true>(a.w_in, 8192, kb * 64, nb * 64, ws + WS_WIN8, 2048, (nb - 32) * 64, nullptr, SC_W8, lane);
            continue; } r -= I_WIN;
        if (r < I_KV) { const int kb = r / 16, nb = r % 16; p0_tile64<false>(a.w_kv, 1024, kb * 64, nb * 64, ws + WS_WKVT, 2048, nb * 64, nullptr, 1.f, lane); continue; } r -= I_KV;
        if (r < I_PP) { const int kb = r / 32, nb = r % 32; p0_tile64<false>(a.proj_pool, 2048, kb * 64, nb * 64, ws + WS_PPST, 1024, nb * 64, a.pool_scale, 1.f, lane); continue; } r -= I_PP;
        if (r < I_PF) { const int kb = r / 32, nb = r % 32; p0_tile64<false>(a.proj_fourier, 2048, kb * 64, nb * 64, ws + WS_PFT, 1024, nb * 64, nullptr, 1.f, lane); continue; } r -= I_PF;
        if (r < I_PM) { const int kb = r / 32, nb = r % 32; p0_tile64<false>(a.proj_mem, 2048, kb * 64, nb * 64, (bf16_t*)(ws + WS_BCAT) + 2048, CAT_LD, nb * 64, nullptr, 1.f, lane); continue; } r -= I_PM;
        { const int kb = r / 32, nb = r % 32; p0_tile64<false>(a.w_out, 2048, kb * 64, nb * 64, ws + WS_WOT, 2048, nb * 64, nullptr, 1.f, lane); }
    }
    STAMP0(1);
    for (int m = 2 * gw; m < T; m += 2 * NGW) rms_row2_to_bf16(a.x + (size_t)m * DM, a.norm_mix_g, (bf16_t*)(ws + WS_XN) + (size_t)m * DM, ws + WS_XN8 + (size_t)m * DM, lane);
    for (int m = gw; m < NBATCH * MEML; m += NGW) rms_row_to_bf16(a.mem + (size_t)m * DM, a.norm_mem_g, (bf16_t*)(ws + WS_MN) + (size_t)m * DM, nullptr, lane);
    STAMP0(2);
    const int gt = gw * 64 + lane, NGT = NGW * 64;
    for (int i = gt; i < 1024 * 128; i += NGT) { const int row = i >> 7, col = (i & 127) * 8, g = row >> 8, c = row & 255;
        u32x4 o = (u32x4){0u, 0u, 0u, 0u};
        if ((col >> 8) == g) { const float* p = a.pool_w + ((size_t)g * 256 + c) * 256 + (col & 255); const f32x4 v0 = *(const f32x4*)p, v1 = *(const f32x4*)(p + 4);
            o.x = pk2(v0.x, v0.y); o.y = pk2(v0.z, v0.w); o.z = pk2(v1.x, v1.y); o.w = pk2(v1.z, v1.w); }
        *(u32x4*)((bf16_t*)(ws + WS_PWBD) + (size_t)row * 1024 + col) = o; }
    STAMP0(3);
    for (int i = gt; i < 1024 * 512; i += NGT) { const int row = i >> 9, col = i & 511, cs = row >> 9, g = (row >> 7) & 3, c = row & 127, g2 = col >> 7, d = col & 127;
        float v = 0.f;
        if (g2 == g) { const float* fw = a.fourier_w + (size_t)g * 128 * 128 + d; const LAS float* tb = tab + (cs ? 128 : 0);
#pragma unroll 8
            for (int j = 0; j < 128; ++j) v += tb[(c * j) & 127] * fw[(size_t)j * 128]; }
        ((bf16_t*)(ws + WS_M1BD))[(size_t)row * 1024 + col] = (bf16_t)f2bf(v); }
    STAMP0(4);
    for (int i = gt; i < 4096 * 256; i += NGT) { const int row = i >> 8, s0 = (i & 255) * 8, cs = row >> 11, k = row & 2047;
        float v[8];
#pragma unroll
        for (int j = 0; j < 8; ++j) { const float ang = (float)((k * (s0 + j)) & 2047) * (1.0f / 1024.0f); v[j] = (cs ? sinpif(ang) : cospif(ang)) * (1.0f / 512.0f); }
        u32x4 o; o.x = pk2(v[0], v[1]); o.y = pk2(v[2], v[3]); o.z = pk2(v[4], v[5]); o.w = pk2(v[6], v[7]);
        *(u32x4*)((bf16_t*)(ws + WS_TW) + (size_t)row * 2048 + s0) = o; }
    STAMP0(5);
}

__device__ __forceinline__ void pool_pass(const Args& a, int gw, int NGW, int lane) {
    const bf16_t* ZM = (const bf16_t*)(a.ws + WS_ZM); bf16_t* AC = (bf16_t*)(a.ws + WS_ACAT);
    for (int it = gw; it < 4096; it += NGW) {
        const int run = it >> 1, hf = it & 1, chunk = hf * 64 + lane, ch0 = chunk * 8, g = chunk >> 5, hw = 1 << g;
        const int t0 = run * 8, b = t0 >> 11, s0 = t0 & 2047; const bf16_t* base = ZM + (size_t)b * SEQ * 2048 + ch0;
        u32x4 rw[23];
#pragma unroll
        for (int r = 0; r < 23; ++r) { const int d = r - 8, s = s0 + d; rw[r] = (u32x4){0u, 0u, 0u, 0u};
            if (d >= -hw && d < 8 + hw - 1 && s >= 0 && s < SEQ) rw[r] = *(const u32x4*)(base + (size_t)s * 2048); }
        float sum[8];
#pragma unroll
        for (int j = 0; j < 8; ++j) sum[j] = 0.f;
#pragma unroll
        for (int r = 0; r < 16; ++r) { const int d = r - 8; if (d >= -hw && d < hw) { const u32x4 w = rw[r];
            sum[0] += bf_lo(w.x); sum[1] += bf_hi(w.x); sum[2] += bf_lo(w.y); sum[3] += bf_hi(w.y); sum[4] += bf_lo(w.z); sum[5] += bf_hi(w.z); sum[6] += bf_lo(w.w); sum[7] += bf_hi(w.w); } }
#pragma unroll
        for (int i = 0; i < 8; ++i) { const int s = s0 + i; const int lo = (s - hw) < 0 ? 0 : (s - hw), hi = (s + hw) > SEQ ? SEQ : (s + hw); const float rc = 1.0f / (float)(hi - lo);
            const u32x4 c = rw[8 + i];
            u32x4 o; o.x = cvt_pk_bf16(sum[0] * rc - bf_lo(c.x), sum[1] * rc - bf_hi(c.x)); o.y = cvt_pk_bf16(sum[2] * rc - bf_lo(c.y), sum[3] * rc - bf_hi(c.y));
            o.z = cvt_pk_bf16(sum[4] * rc - bf_lo(c.z), sum[5] * rc - bf_hi(c.z)); o.w = cvt_pk_bf16(sum[6] * rc - bf_lo(c.w), sum[7] * rc - bf_hi(c.w));
            *(u32x4*)(AC + (size_t)(t0 + i) * CAT_LD + ch0) = o;
            if (i < 7) { u32x4 wa = (u32x4){0u, 0u, 0u, 0u}, wd = wa;
#pragma unroll
                for (int k = 0; k < 4; ++k) { const int h2 = 1 << k; if (hw == h2) { wa = rw[8 + i + h2]; wd = rw[8 + i - h2]; } }
                sum[0] += bf_lo(wa.x) - bf_lo(wd.x); sum[1] += bf_hi(wa.x) - bf_hi(wd.x); sum[2] += bf_lo(wa.y) - bf_lo(wd.y); sum[3] += bf_hi(wa.y) - bf_hi(wd.y);
                sum[4] += bf_lo(wa.z) - bf_lo(wd.z); sum[5] += bf_hi(wa.z) - bf_hi(wd.z); sum[6] += bf_lo(wa.w) - bf_lo(wd.w); sum[7] += bf_hi(wa.w) - bf_hi(wd.w); } }
    }
}

constexpr int ATT_KSTR = 272, ATT_VSTR = 520, ATT_VOFF = 256 * ATT_KSTR;
__device__ __forceinline__ void attn_unit(const Args& a, LAS unsigned char* lds, int b, int h, int qb, int wave, int lane, int tid) {
    const bf16_t* ZM = (const bf16_t*)(a.ws + WS_ZM); const bf16_t* KM = (const bf16_t*)(a.ws + WS_KMEM); const bf16_t* VT = (const bf16_t*)(a.ws + WS_VT); bf16_t* AC = (bf16_t*)(a.ws + WS_ACAT);
    const int l31 = lane & 31, hh = lane >> 5;
#pragma unroll
    for (int i = 0; i < 8; ++i) { const int ch = tid + 512 * i, row = ch >> 4, cc = ch & 15;
        const u32x4 v = *(const u32x4*)(KM + (size_t)(b * MEML + row) * 512 + h * 128 + 8 * cc);
        *(LAS u32x4*)(lds + row * ATT_KSTR + 16 * cc) = v; }
#pragma unroll
    for (int i = 0; i < 8; ++i) { const int ch = tid + 512 * i, row = ch >> 5, cc = ch & 31;
        const u32x4 v = *(const u32x4*)(VT + (size_t)(h * 128 + row) * 2048 + b * MEML + 8 * cc);
        LAS unsigned* d = (LAS unsigned*)(lds + ATT_VOFF + row * ATT_VSTR + 16 * cc); d[0] = v.x; d[1] = v.y; d[2] = v.z; d[3] = v.w; }
    const int t = b * SEQ + qb * 256 + wave * 32 + l31;
    bf16x8 qf[8];
    const bf16_t* qp = ZM + (size_t)t * 2048 + 1536 + h * 128 + 8 * hh;
#pragma unroll
    for (int ks = 0; ks < 8; ++ks) qf[ks] = *(const bf16x8*)(qp + 16 * ks);
    __syncthreads();
    f32x16 sc[8];
    const LAS unsigned char* kp = lds + l31 * ATT_KSTR + 16 * hh;
#pragma unroll
    for (int kt = 0; kt < 8; ++kt) { f32x16 acc;
#pragma unroll
        for (int r = 0; r < 16; ++r) acc[r] = 0.f;
#pragma unroll
        for (int ks = 0; ks < 8; ++ks) { const bf16x8 kf = *(const LAS bf16x8*)(kp + (32 * kt) * ATT_KSTR + 32 * ks); acc = __builtin_amdgcn_mfma_f32_32x32x16_bf16(kf, qf[ks], acc, 0, 0, 0); }
        sc[kt] = acc; }
    float mx = -3.0e38f;
#pragma unroll
    for (int kt = 0; kt < 8; ++kt)
#pragma unroll
        for (int r = 0; r < 16; ++r) mx = fmaxf(mx, sc[kt][r]);
    mx = fmaxf(mx, __shfl_xor(mx, 32));
    const float cs = 0.08838834764831845f * 1.44269504089f;
    float sum = 0.f;
#pragma unroll
    for (int kt = 0; kt < 8; ++kt)
#pragma unroll
        for (int r = 0; r < 16; ++r) { const float p = __builtin_amdgcn_exp2f((sc[kt][r] - mx) * cs); sc[kt][r] = p; sum += p; }
    sum += __shfl_xor(sum, 32);
    const float rinv = 1.0f / sum;
    bf16x8 pf[8][2];
#pragma unroll
    for (int kt = 0; kt < 8; ++kt)
#pragma unroll
        for (int s = 0; s < 2; ++s) { u32x4 w; w.x = cvt_pk_bf16(sc[kt][8 * s + 0], sc[kt][8 * s + 1]); w.y = cvt_pk_bf16(sc[kt][8 * s + 2], sc[kt][8 * s + 3]);
            w.z = cvt_pk_bf16(sc[kt][8 * s + 4], sc[kt][8 * s + 5]); w.w = cvt_pk_bf16(sc[kt][8 * s + 6], sc[kt][8 * s + 7]); pf[kt][s] = __builtin_bit_cast(bf16x8, w); }
#pragma unroll
    for (int dt = 0; dt < 4; ++dt) { f32x16 o;
#pragma unroll
        for (int r = 0; r < 16; ++r) o[r] = 0.f;
        const LAS unsigned char* vp = lds + ATT_VOFF + (32 * dt + l31) * ATT_VSTR + 8 * hh;
#pragma unroll
        for (int kt = 0; kt < 8; ++kt)
#pragma unroll
            for (int s = 0; s < 2; ++s) { const u32x2 v0 = *(const LAS u32x2*)(vp + 64 * kt + 32 * s), v1 = *(const LAS u32x2*)(vp + 64 * kt + 32 * s + 16);
                const u32x4 vv = (u32x4){v0.x, v0.y, v1.x, v1.y};
                o = __builtin_amdgcn_mfma_f32_32x32x16_bf16(__builtin_bit_cast(bf16x8, vv), pf[kt][s], o, 0, 0, 0); }
        bf16_t* op = AC + (size_t)t * CAT_LD + 2048 + h * 128 + 32 * dt + 4 * hh;
#pragma unroll
        for (int rg = 0; rg < 4; ++rg) { u32x2 w; w.x = cvt_pk_bf16(o[4 * rg + 0] * rinv, o[4 * rg + 1] * rinv); w.y = cvt_pk_bf16(o[4 * rg + 2] * rinv, o[4 * rg + 3] * rinv);
            *(u32x2*)(op + 8 * rg) = w; } }
    __syncthreads();
}

__device__ __forceinline__ void router_phase(const Args& a, LAS unsigned char* lds, int vcu, int G, int wave, int lane, int tid) {
    LAS float* wrT = (LAS float*)lds;
    for (int d = tid; d < 2048; d += NTHR) { const f32x4* wp = (const f32x4*)(a.w_router + (size_t)d * 16);
#pragma unroll
        for (int q4 = 0; q4 < 4; ++q4) { const f32x4 w = wp[q4]; wrT[(4 * q4 + 0) * 2048 + d] = w.x; wrT[(4 * q4 + 1) * 2048 + d] = w.y; wrT[(4 * q4 + 2) * 2048 + d] = w.z; wrT[(4 * q4 + 3) * 2048 + d] = w.w; } }
    __syncthreads();
    const bf16_t* X1 = (const bf16_t*)(a.ws + WS_X1B); unsigned char* H2 = (unsigned char*)(a.ws + WS_H2); float* AFF = (float*)(a.ws + WS_AFF);
    for (int gp = vcu * NWAVES + wave; gp < T / 2; gp += G * NWAVES) {
        const u32x2* xr0 = (const u32x2*)(X1 + (size_t)(2 * gp) * DM) + lane; const u32x2* xr1 = xr0 + DM / 4;
        f32x4 p[8], q[8]; float s0 = 0.f, s1 = 0.f;
#pragma unroll
        for (int j = 0; j < 8; ++j) { const u32x2 pw = xr0[64 * j], qw = xr1[64 * j];
            p[j] = (f32x4){bf_lo(pw.x), bf_hi(pw.x), bf_lo(pw.y), bf_hi(pw.y)}; q[j] = (f32x4){bf_lo(qw.x), bf_hi(qw.x), bf_lo(qw.y), bf_hi(qw.y)}; }
#pragma unroll
        for (int j = 0; j < 8; ++j) { s0 += (p[j].x * p[j].x + p[j].y * p[j].y) + (p[j].z * p[j].z + p[j].w * p[j].w); s1 += (q[j].x * q[j].x + q[j].y * q[j].y) + (q[j].z * q[j].z + q[j].w * q[j].w); }
        const float inv0 = 1.0f / sqrtf(wave_sum(s0) * (1.f / DM) + EPS), inv1 = 1.0f / sqrtf(wave_sum(s1) * (1.f / DM) + EPS);
        unsigned* h0 = (unsigned*)(H2 + (size_t)(2 * gp) * DM) + lane; unsigned* h1 = h0 + DM / 4;
#pragma unroll
        for (int j = 0; j < 8; ++j) { const f32x4 gg = ((const f32x4*)a.norm_ffn_g)[64 * j + lane];
            p[j] = p[j] * inv0 * gg; q[j] = q[j] * inv1 * gg;
            h0[64 * j] = cvt4_fp8(p[j].x * SC_H8, p[j].y * SC_H8, p[j].z * SC_H8, p[j].w * SC_H8);
            h1[64 * j] = cvt4_fp8(q[j].x * SC_H8, q[j].y * SC_H8, q[j].z * SC_H8, q[j].w * SC_H8); }
        float my0 = -3.0e38f, my1 = -3.0e38f;
#pragma unroll 1
        for (int e = 0; e < 16; ++e) { const LAS float* wb = wrT + e * 2048 + 4 * lane; float d0 = 0.f, d1 = 0.f;
#pragma unroll
            for (int j = 0; j < 8; ++j) { const f32x4 w = *(const LAS f32x4*)(wb + 256 * j);
                d0 += (p[j].x * w.x + p[j].y * w.y) + (p[j].z * w.z + p[j].w * w.w);
                d1 += (q[j].x * w.x + q[j].y * w.y) + (q[j].z * w.z + q[j].w * w.w); }
            d0 = wave_sum(d0); d1 = wave_sum(d1);
            if (lane == e) { my0 = d0; my1 = d1; } }
        float mx0 = my0, mx1 = my1;
#pragma unroll
        for (int o = 1; o < 16; o <<= 1) { mx0 = fmaxf(mx0, __shfl_xor(mx0, o)); mx1 = fmaxf(mx1, __shfl_xor(mx1, o)); }
        const float e0 = __expf(my0 - mx0), e1 = __expf(my1 - mx1); float su0 = e0, su1 = e1;
#pragma unroll
        for (int o = 1; o < 16; o <<= 1) { su0 += __shfl_xor(su0, o); su1 += __shfl_xor(su1, o); }
        if (lane < 16) { const int t = 2 * gp, b = t >> 11, s = t & 2047;
            AFF[((size_t)b * 16 + lane) * SEQ + s] = e0 / su0; AFF[((size_t)b * 16 + lane) * SEQ + s + 1] = e1 / su1; }
    }
}

__device__ __forceinline__ int wave_isum(int v) {
#pragma unroll
    for (int o = 1; o < 64; o <<= 1) v += __shfl_xor(v, o);
    return v;
}
__device__ __forceinline__ int wave_excl_scan(int v, int ln) {
    int x = v;
#pragma unroll
    for (int o = 1; o < 64; o <<= 1) { const int y = __shfl(x, (ln - o) & 63); x += (ln >= o) ? y : 0; }
    return x - v;
}
__device__ __forceinline__ void topk_phase(const Args& a, LAS unsigned char* lds, int c, int wave, int ln, int tid) {
    if (c >= 128) return;
    const int b = c & 7, e = c >> 3;
    LAS int* list = (LAS int*)(lds + 1024);
    const float* AFF = (const float*)(a.ws + WS_AFF) + ((size_t)b * 16 + e) * SEQ;
    unsigned u[32];
#pragma unroll
    for (int i = 0; i < 8; ++i) { const u32x4 w = *(const u32x4*)(AFF + 32 * ln + 4 * i); u[4 * i] = w.x; u[4 * i + 1] = w.y; u[4 * i + 2] = w.z; u[4 * i + 3] = w.w; }
    unsigned Tv = 0u;
#pragma unroll 1
    for (int bit = 30; bit >= 0; --bit) { const unsigned cand = Tv | (1u << bit);
        int lc = 0;
#pragma unroll
        for (int i = 0; i < 32; ++i) lc += (u[i] >= cand) ? 1 : 0;
        if (wave_isum(lc) >= CAP) Tv = cand; }
    int ngt_l = 0, ntie_l = 0;
#pragma unroll
    for (int i = 0; i < 32; ++i) { ngt_l += (u[i] > Tv) ? 1 : 0; ntie_l += (u[i] == Tv) ? 1 : 0; }
    const int need = CAP - wave_isum(ngt_l);
    int tr = wave_excl_scan(ntie_l, ln);
    unsigned selmask = 0u; int nsel_l = 0;
#pragma unroll
    for (int i = 0; i < 32; ++i) { const bool t = (u[i] == Tv); const bool s = (u[i] > Tv) || (t && tr < need); tr += t ? 1 : 0; selmask |= s ? (1u << i) : 0u; nsel_l += s ? 1 : 0; }
    int slot = wave_excl_scan(nsel_l, ln);
    int* INV = (int*)(a.ws + WS_INV); float* SELW = (float*)(a.ws + WS_SELW);
    if ((ln >> 3) == wave) {
#pragma unroll
        for (int i = 0; i < 32; ++i) { const int s = 32 * ln + i; const bool sl = (selmask >> i) & 1u;
            INV[((size_t)b * SEQ + s) * 16 + e] = sl ? slot : -1;
            if (sl) { list[slot] = s; SELW[((size_t)e * 8 + b) * CAP + slot] = __builtin_bit_cast(float, u[i]); ++slot; } }
    }
    __syncthreads();
    const unsigned char* H2 = (const unsigned char*)(a.ws + WS_H2); unsigned char* XIN = (unsigned char*)(a.ws + WS_XIN);
    for (int q = 0; q < CAP / NWAVES; q += 8) {
        u32x4 v[8][2];
#pragma unroll
        for (int i = 0; i < 8; ++i) { const int s = list[wave + NWAVES * (q + i)];
            const u32x4* src = (const u32x4*)(H2 + ((size_t)b * SEQ + s) * DM) + ln; v[i][0] = src[0]; v[i][1] = src[64]; }
#pragma unroll
        for (int i = 0; i < 8; ++i) { const int slot2 = wave + NWAVES * (q + i);
            u32x4* dst = (u32x4*)(XIN + (((size_t)e * 8 + b) * CAP + slot2) * DM) + ln; dst[0] = v[i][0]; dst[64] = v[i][1]; }
    }
    __syncthreads();
}

__device__ __forceinline__ void combine_phase(const Args& a, int gw, int NGW, int lane) {
    const bf16_t* Y = (const bf16_t*)(a.ws + WS_Y); const int* INV = (const int*)(a.ws + WS_INV);
    for (int t = gw; t < T; t += NGW) { const int b = t >> 11;
        float* xr = a.out + (size_t)t * DM; const u32x2* x1r = (const u32x2*)((const bf16_t*)(a.ws + WS_X1B) + (size_t)t * DM);
        f32x4 v[8];
#pragma unroll
        for (int j = 0; j < 8; ++j) { const u32x2 w = x1r[64 * j + lane]; v[j] = (f32x4){bf_lo(w.x), bf_hi(w.x), bf_lo(w.y), bf_hi(w.y)}; }
        const int myinv = DBG_SKIP_MOE ? -1 : INV[(size_t)t * 16 + (lane & 15)];
        for (int e = 0; e < 16; ++e) { const int slot = __shfl(myinv, e);
            if (slot >= 0) { const u32x2* yr = (const u32x2*)(Y + (((size_t)e * 8 + b) * CAP + slot) * DM);
#pragma unroll
                for (int j = 0; j < 8; ++j) { const u32x2 w = yr[64 * j + lane]; v[j].x += bf_lo(w.x); v[j].y += bf_hi(w.x); v[j].z += bf_lo(w.y); v[j].w += bf_hi(w.y); } } }
        float s = 0.f;
#pragma unroll
        for (int j = 0; j < 8; ++j) s += (v[j].x * v[j].x + v[j].y * v[j].y) + (v[j].z * v[j].z + v[j].w * v[j].w);
        const float inv = 1.0f / sqrtf(wave_sum(s) * (1.f / DM) + EPS);
#pragma unroll
        for (int j = 0; j < 8; ++j) { const f32x4 gg = ((const f32x4*)a.norm_final_g)[64 * j + lane]; ((f32x4*)xr)[64 * j + lane] = v[j] * inv * gg; }
    }
}

using pg8::Unit;
struct SchedFold {
    unsigned char* ws; int c;
    __device__ __forceinline__ bool next(int i, Unit& u) const {
        if (i > 0 || c >= 64) return false;
        const int L = c & 31, pm = L & 7, pn = L >> 3;
        if (c < 32) { u.A = (const char*)(ws + WS_PPST) + (size_t)pm * 256 * 1024 * 2; u.B0 = (const char*)(ws + WS_PWBD) + (size_t)pn * 256 * 1024 * 2; u.nt = 16; u.c0 = pn * 256; }
        else { u.A = (const char*)(ws + WS_PFT) + (size_t)pm * 256 * 1024 * 2; u.B0 = (const char*)(ws + WS_M1BD) + (size_t)pn * 256 * 1024 * 2; u.nt = 8; u.c0 = 1024 + pn * 256; }
        u.r0 = pm * 256; u.aux = 0; return true;
    }
};
struct SchedKV {
    unsigned char* ws; int c;
    __device__ __forceinline__ bool next(int i, Unit& u) const {
        if (i > 0 || c < 64 || c >= 96) return false;
        const int L = c - 64; u.nt = 32;
        if (L < 16) { const int pm = L & 7, pn = L >> 3; u.A = (const char*)(ws + WS_MN) + (size_t)pm * 256 * 2048 * 2; u.B0 = (const char*)(ws + WS_WKVT) + (size_t)pn * 256 * 2048 * 2; u.r0 = pm * 256; u.c0 = pn * 256; u.aux = 0; }
        else { const int L2 = L - 16, pm = L2 & 1, pn = L2 >> 1; u.A = (const char*)(ws + WS_WKVT) + (size_t)(512 + pm * 256) * 2048 * 2; u.B0 = (const char*)(ws + WS_MN) + (size_t)pn * 256 * 2048 * 2; u.r0 = pm * 256; u.c0 = pn * 256; u.aux = 1; }
        return true;
    }
};
struct EpiKV {
    static __device__ __forceinline__ bool keep_acc(const Unit&) { return false; }
    bf16_t* KM; bf16_t* VT;
    __device__ __forceinline__ void operator()(const f32x4 (&acc)[2][2][4][2], const Unit& u, int wr, int wc, int fr, int fq) const {
        pg8::EpiBf16 E{u.aux ? VT : KM, u.aux ? 2048 : 512, nullptr, 1.f}; E(acc, u, wr, wc, fr, fq);
    }
};
struct SchedTiles {
    const char* A; const char* B; int lda, ldb, nM, nN, nt, G, c, ibeg, iend, esz;
    __device__ __forceinline__ bool next(int i0, Unit& u) const {
        const int i = i0 + ibeg; if (i >= iend) return false;
        const int L = i * G + c; if (L >= nM * nN) return false;
        int pm, pn; pg8::tile_order(L, nM, nN, pm, pn);
        u.A = A + (size_t)pm * 256 * lda * esz; u.B0 = B + (size_t)pn * 256 * ldb * esz; u.nt = nt; u.r0 = pm * 256; u.c0 = pn * 256; u.aux = 0; return true;
    }
};
struct SchedDFT {
    unsigned char* ws; int c;
    __device__ __forceinline__ bool next(int i, Unit& u) const {
        if (i > 0 || c >= 256) return false;
        const int b = c & 7, j = c >> 3, pm = j & 15, pn = j >> 4;
        u.A = (const char*)(ws + WS_TW) + (size_t)pm * 256 * 2048 * 2; u.B0 = (const char*)(ws + WS_UT) + (size_t)(b * 512 + pn * 256) * 2048 * 2; u.nt = 32;
        u.r0 = b * SEQ + (pm & 7) * 256; u.c0 = 1024 + (pm >> 3) * 512 + pn * 256; u.aux = 0; return true;
    }
};
struct SchedProj {
    unsigned char* ws; int G, c;
    __device__ __forceinline__ bool next(int i, Unit& u) const {
        const int ti = i / 3, si = i - 3 * ti, rot = 0, s = (si + rot) % 3; const int L = ti * G + c; if (L >= 512) return false;
        int pm, pn; pg8::tile_order(L, 64, 8, pm, pn);
        const size_t co = (size_t)s * 1024 * 2;
        u.A = (const char*)(ws + WS_ACAT) + (size_t)pm * 256 * CAT_LD * 2 + co; u.B0 = (const char*)(ws + WS_BCAT) + (size_t)pn * 256 * CAT_LD * 2 + co;
        u.nt = s == 2 ? 8 : 16; u.r0 = pm * 256; u.c0 = pn * 256; u.aux = s | (((si + 1 + rot) % 3) << 2) | (si == 2 ? 32 : 0); return true;
    }
};
struct SchedGU {
    unsigned char* ws; int G, c;
    __device__ __forceinline__ bool next(int i, Unit& u) const {
        const int L = i * G + c; if (L >= 2048) return false;
        const int e = L >> 7, j = L & 127, x = j & 7, q = j >> 3, pm = q & 7, pn = 2 * x + (q >> 3);
        u.A = (const char*)(ws + WS_XIN) + (size_t)(e * 8 + pm) * 256 * 2048; u.B0 = (const char*)(ws + WS_WGUT) + ((size_t)e * 4096 + pn * 256) * 2048;
        u.nt = 16; u.r0 = (e * 8 + pm) * 256; u.c0 = pn * 128; u.aux = 0; return true;
    }
};
struct SchedDown {
    unsigned char* ws; int G, c;
    __device__ __forceinline__ bool next(int i, Unit& u) const {
        const int L = i * G + c; if (L >= 1024) return false;
        const int e = L >> 6, j = L & 63, pn = j & 7, pm = j >> 3;
        u.A = (const char*)(ws + WS_HID) + (size_t)(e * 8 + pm) * 256 * 2048; u.B0 = (const char*)(ws + WS_WDT) + ((size_t)e * 2048 + pn * 256) * 2048;
        u.nt = 16; u.r0 = (e * 8 + pm) * 256; u.c0 = pn * 256; u.aux = 0; return true;
    }
};

__global__ void __launch_bounds__(NTHR, 2) fwd_kernel(Args a) {
    extern __shared__ __attribute__((aligned(16))) unsigned char lds_raw[];
    LAS unsigned char* lds = (LAS unsigned char*)lds_raw;
    const int tid = threadIdx.x, wave = __builtin_amdgcn_readfirstlane(tid >> 6);
#define lane opaque_lane()
    const int G = gridDim.x, c = blockIdx.x;
    const int vcu = (G % 8 == 0) ? (c % 8) * (G / 8) + c / 8 : c;
    const int gw = vcu * NWAVES + wave, NGW = G * NWAVES;
    unsigned char* ws = a.ws;
    const int lo = a.ph_lo, hi = a.ph_hi;
#define IN(k) (lo <= (k) && (k) < hi)
    volatile LAS unsigned* bst = (volatile LAS unsigned*)(lds + 143360);
    if (tid < 64) ((LAS unsigned*)(lds + 143360))[tid] = 0u;
    if (tid < 256) ((LAS unsigned*)(lds + STAMP_BASE))[tid] = 0u;
    __syncthreads();
    XcdBarrier gbar = xcd_barrier_post((unsigned*)(ws + WS_CTL) + 4096, bst);
#define SEAM(k) do { if (IN(k) && IN((k) + 1)) { xcd_barrier(gbar); } STAMPN(k, 6); if (PROBE_PHASE == (k)) { STAMP(7); if (tid == 0) STAMP_EN() = 0u; } if (PROBE_PHASE == (k) + 1 && tid == 0) STAMP_EN() = 1u; } while (0)

#define PH0 if (IN(0)) { phase0(a, lds, gw, NGW, wave, lane); __syncthreads(); }
    PH0
    if (PROBE_REP == 0) { xcd_barrier(gbar); PH0 }
    SEAM(0);
    if (PROBE_PHASE == 2 && tid == 0) STAMP_EN() = 1u;
#define PH2 \
    if (!DBG_P5_FROM_XN && IN(2)) { \
          \
          \
        { SchedFold S{ws, c}; pg8::EpiBf16 E{(bf16_t*)(ws + WS_BCAT), CAT_LD, nullptr, 1.f}; pg8::gemm_phase<false, (PROBE_PHASE == 2)>(lds, 2048, 2048, S, E); } \
        { SchedKV S{ws, c}; EpiKV E{(bf16_t*)(ws + WS_KMEM), (bf16_t*)(ws + WS_VT)}; pg8::gemm_phase<false, (PROBE_PHASE == 2)>(lds, 4096, 4096, S, E); } \
        { SchedTiles S{(const char*)(ws + WS_XN), (const char*)(ws + WS_WINT), 2048, 2048, 64, 8, 32, G, c, 0, 1 << 20, 2}; pg8::EpiZ E{(bf16_t*)(ws + WS_ZM), (bf16_t*)(ws + WS_UT)}; pg8::gemm_phase<false, (PROBE_PHASE == 2)>(lds, 4096, 4096, S, E); } \
        const int csplit = 2 * ((c >> 3) & 3); \
        pg8::EpiGates8 E8{(bf16_t*)(ws + WS_G), 1.0f / (SC_H8 * SC_W8)}; \
        { SchedTiles S{(const char*)(ws + WS_XN8), (const char*)(ws + WS_WIN8), 2048, 2048, 64, 24, 16, G, c, 0, csplit, 1}; pg8::gemm_phase<true, (PROBE_PHASE == 2)>(lds, 2048, 2048, S, E8); } \
        STAMP(8); convert_experts(a, c, G, wave, lane); STAMP(9); \
        { SchedTiles S{(const char*)(ws + WS_XN8), (const char*)(ws + WS_WIN8), 2048, 2048, 64, 24, 16, G, c, csplit, 1 << 20, 1}; pg8::gemm_phase<true, (PROBE_PHASE == 2)>(lds, 2048, 2048, S, E8); } \
    }
    PH2
    if (PROBE_REP == 2) { xcd_barrier(gbar); PH2 }
    SEAM(2);
#define PH3 \
    if (!DBG_P5_FROM_XN && IN(3)) { \
        STAMPN(3, 0); { SchedDFT S{ws, c}; pg8::EpiBf16 E{(bf16_t*)(ws + WS_ACAT), CAT_LD, nullptr, 1.f}; pg8::gemm_phase<false, (PROBE_PHASE == 3)>(lds, 4096, 4096, S, E); } STAMPN(3, 1); \
        if (c < 256) { const int b = c & 7, j = c >> 3; attn_unit(a, lds, b, j & 3, j >> 2, wave, lane, tid); } STAMPN(3, 2); \
        pool_pass(a, gw, NGW, lane); STAMPN(3, 3); \
    }
    PH3
    if (PROBE_REP == 3) { xcd_barrier(gbar); PH3 }
    SEAM(3);
#define PH4 \
    if (!DBG_P5_FROM_XN && IN(4)) { SchedProj S{ws, G, c}; pg8::EpiGate E{(bf16_t*)(ws + WS_MG), (const bf16_t*)(ws + WS_G)}; pg8::gemm_phase<false, (PROBE_PHASE == 4)>(lds, 2 * CAT_LD, 2 * CAT_LD, S, E); }
    PH4
    if (PROBE_REP == 4) { xcd_barrier(gbar); PH4 }
    SEAM(4);
#define PH5 \
    if (IN(5)) { \
        SchedTiles S{(const char*)(ws + (DBG_P5_FROM_XN ? WS_XN : WS_MG)), (const char*)(ws + WS_WOT), 2048, 2048, 64, 8, 32, G, c, 0, 1 << 20, 2}; \
        pg8::EpiResid E{a.x, (bf16_t*)(ws + WS_X1B)}; pg8::gemm_phase<false, (PROBE_PHASE == 5)>(lds, 4096, 4096, S, E); \
    }
    PH5
    if (PROBE_REP == 5) { xcd_barrier(gbar); PH5 }
    SEAM(5);
#define PH6 \
    if (!DBG_SKIP_MOE && IN(6)) { STAMPN(6, 0); router_phase(a, lds, vcu, G, wave, lane, tid); __syncthreads(); STAMPN(6, 1); }
    PH6
    if (PROBE_REP == 6) { xcd_barrier(gbar); PH6 }
    SEAM(6);
#define PH7 \
    if (!DBG_SKIP_MOE && IN(7)) { STAMPN(7, 0); topk_phase(a, lds, c, wave, lane, tid); STAMPN(7, 1); }
    PH7
    if (PROBE_REP == 7) { xcd_barrier(gbar); PH7 }
    SEAM(7);
#define PH8 \
    if (!DBG_SKIP_MOE && IN(8)) { SchedGU S{ws, G, c}; pg8::EpiSwiGLU8 E{(unsigned char*)(ws + WS_HID), 1.0f / (SC_H8 * SC_W8)}; pg8::gemm_phase<true, (PROBE_PHASE == 8)>(lds, 2048, 2048, S, E); }
    PH8
    if (PROBE_REP == 8) { xcd_barrier(gbar); PH8 }
    SEAM(8);
#define PH9 \
    if (!DBG_SKIP_MOE && IN(9)) { SchedDown S{ws, G, c}; pg8::EpiBf16 E{(bf16_t*)(ws + WS_Y), 2048, (const float*)(ws + WS_SELW), 1.0f / (SC_HID8 * SC_W8)}; pg8::gemm_phase<true, (PROBE_PHASE == 9)>(lds, 2048, 2048, S, E); }
    PH9
    if (PROBE_REP == 9) { xcd_barrier(gbar); PH9 }
    SEAM(9);
    STAMPN(10, 0); if (IN(10)) combine_phase(a, gw, NGW, lane); STAMPN(10, 1);
    if (PROBE_A >= 0 && blockIdx.x == PROBE_BLK && tid == 0) { const volatile LAS unsigned long long* st = (const volatile LAS unsigned long long*)(unsigned)STAMP_BASE;
        const unsigned long long d = (st[PROBE_A] - st[PROBE_B]) * PROBE_SCALE, t0 = __builtin_amdgcn_s_memrealtime();
        if (d < 100000000ull) while (__builtin_amdgcn_s_memrealtime() - t0 < d) __builtin_amdgcn_s_sleep(8); }
#undef IN
#undef SEAM
#undef lane
}

extern "C" void kernel_launch(void* const* d_in, const int* in_sizes, int n_in, void* d_out, int out_size, void* d_ws, size_t ws_size, hipStream_t stream) {
    static int grid = 0;
    if (grid == 0) {
        if (n_in != 19 || in_sizes[0] != T * DM || out_size != T * DM || ws_size < WS_END) {
            fprintf(stderr, "kernel_launch: unexpected shapes (n_in %d, in0 %d, out %d, ws %zu, need %zu); nothing launched\n", n_in, n_in > 0 ? in_sizes[0] : -1, out_size, ws_size, (size_t)WS_END); grid = -1; return; }
        int dev = 0, cus = 0, per_cu = 0;
        if (hipGetDevice(&dev) != hipSuccess || hipDeviceGetAttribute(&cus, hipDeviceAttributeMultiprocessorCount, dev) != hipSuccess) { fprintf(stderr, "kernel_launch: device query failed\n"); grid = -1; return; }
        if (hipFuncSetAttribute((const void*)fwd_kernel, hipFuncAttributeMaxDynamicSharedMemorySize, LDS_BYTES) != hipSuccess) { fprintf(stderr, "kernel_launch: hipFuncSetAttribute failed\n"); grid = -1; return; }
        if (hipOccupancyMaxActiveBlocksPerMultiprocessor(&per_cu, (const void*)fwd_kernel, NTHR, LDS_BYTES) != hipSuccess || per_cu < 1) { fprintf(stderr, "kernel_launch: occupancy query says %d blocks per CU\n", per_cu); (void)hipGetLastError(); grid = -1; return; }
        grid = cus;
        if (grid < 256) fprintf(stderr, "kernel_launch: note: %d CUs (< 256): some single-round phases assume 256 workgroups\n", grid);
    }
    if (grid < 0) return;
    Args a{};
    a.x = (const float*)d_in[0]; a.mem = (const float*)d_in[1]; a.norm_mix_g = (const float*)d_in[2]; a.norm_mem_g = (const float*)d_in[3]; a.w_in = (const float*)d_in[4];
    a.pool_w = (const float*)d_in[5]; a.pool_scale = (const float*)d_in[6]; a.fourier_w = (const float*)d_in[7]; a.w_kv = (const float*)d_in[8]; a.proj_pool = (const float*)d_in[9];
    a.proj_fourier = (const float*)d_in[10]; a.proj_mem = (const float*)d_in[11]; a.w_out = (const float*)d_in[12]; a.norm_ffn_g = (const float*)d_in[13]; a.w_router = (const float*)d_in[14];
    a.w_gate = (const float*)d_in[15]; a.w_up = (const float*)d_in[16]; a.w_down = (const float*)d_in[17]; a.norm_final_g = (const float*)d_in[18];
    a.out = (float*)d_out; a.ws = (unsigned char*)d_ws;
#if MK_MULTI_LAUNCH
    for (int p = 0; p < NPH; ++p) { a.ph_lo = p; a.ph_hi = p + 1; hipLaunchKernelGGL(fwd_kernel, dim3(grid), dim3(NTHR), LDS_BYTES, stream, a); }
#else
    a.ph_lo = 0; a.ph_hi = NPH;
    if (hipMemsetAsync((char*)d_ws + WS_CTL, 0, 65536, stream) != hipSuccess) { fprintf(stderr, "kernel_launch: hipMemsetAsync failed\n"); return; }
    void* args[] = {&a};
    hipError_t e = hipLaunchCooperativeKernel((const void*)fwd_kernel, dim3(grid), dim3(NTHR), args, LDS_BYTES, stream);
    if (e != hipSuccess) fprintf(stderr, "kernel_launch: cooperative launch failed: %s (grid %d)\n", hipGetErrorString(e), grid);
#endif
}
```

```cpp
#include <hip/hip_runtime.h>
#include <hip/hip_cooperative_groups.h>
#include <cstdio>
#include <cstdint>
namespace cg = cooperative_groups;

#ifndef MK_MULTI_LAUNCH
#define MK_MULTI_LAUNCH 0
#endif

#ifndef PROBE_REP
#define PROBE_REP -1
#endif
#ifndef DBG_P5_FROM_XN
#define DBG_P5_FROM_XN 0
#endif
#ifndef DBG_ONLY_BRANCH
#define DBG_ONLY_BRANCH -1
#endif
#ifndef DBG_SKIP_MOE
#define DBG_SKIP_MOE 0
#endif
#define LAS __attribute__((address_space(3)))
#define GAS __attribute__((address_space(1)))
typedef unsigned short bf16_t;
typedef short bf16x8 __attribute__((ext_vector_type(8)));
typedef short s16x4 __attribute__((ext_vector_type(4)));
typedef float f32x2 __attribute__((ext_vector_type(2)));
typedef float f32x4 __attribute__((ext_vector_type(4)));
typedef float f32x16 __attribute__((ext_vector_type(16)));
typedef unsigned u32x2 __attribute__((ext_vector_type(2)));
typedef unsigned u32x4 __attribute__((ext_vector_type(4)));

constexpr int T = 16384, DM = 2048, NBATCH = 8, SEQ = 2048, MEML = 256;
constexpr int NE = 16, CAP = 256;
constexpr int CAT_LD = 2560;
constexpr float EPS = 1e-6f;
constexpr int NWAVES = 8, NTHR = 512;
constexpr int NPH = 11;

constexpr size_t MiB = 1u << 20;
constexpr size_t WS_CTL  = 0;
constexpr size_t WS_GWT  = 512 * 1024;
constexpr size_t WS_WINT = 1 * MiB;
constexpr size_t WS_WIN8 = 9 * MiB;
constexpr size_t WS_WKVT = 33 * MiB;
constexpr size_t WS_PPST = 37 * MiB;
constexpr size_t WS_PFT  = 41 * MiB;
constexpr size_t WS_PWBD = 45 * MiB;
constexpr size_t WS_M1BD = 47 * MiB;
constexpr size_t WS_BCAT = 49 * MiB;
constexpr size_t WS_WOT  = 60 * MiB;
constexpr size_t WS_TW   = 68 * MiB;
constexpr size_t WS_WGUT = 84 * MiB;
constexpr size_t WS_WDT  = 339 * MiB;
constexpr size_t WS_ACT  = 467 * MiB;
constexpr size_t WS_XN   = WS_ACT;
constexpr size_t WS_MN   = WS_ACT + 64 * MiB;
constexpr size_t WS_ZM   = WS_ACT + 72 * MiB;
constexpr size_t WS_G    = WS_ACT + 136 * MiB;
constexpr size_t WS_UT   = WS_ACT + 328 * MiB;
constexpr size_t WS_KMEM = WS_ACT + 344 * MiB;
constexpr size_t WS_VT   = WS_ACT + 346 * MiB;
constexpr size_t WS_ACAT = WS_ACT + 348 * MiB;
constexpr size_t WS_MG   = WS_ACT + 432 * MiB;
constexpr size_t WS_H2   = WS_ACT;
constexpr size_t WS_XIN  = WS_ACT + 32 * MiB;
constexpr size_t WS_Y    = WS_ACT + 96 * MiB;
constexpr size_t WS_HID  = WS_ACT + 224 * MiB;
constexpr size_t WS_AFF  = WS_ACT + 320 * MiB;
constexpr size_t WS_SELW = WS_ACT + 321 * MiB;
constexpr size_t WS_INV  = WS_ACT + 322 * MiB;
constexpr size_t WS_X1B  = WS_ACT + 352 * MiB;
constexpr size_t WS_XN8  = WS_ACT + 497 * MiB;
constexpr size_t WS_END  = WS_ACT + 529 * MiB;

constexpr int LDS_BYTES = 147456;

#define LDS_WAIT() asm volatile("s_waitcnt lgkmcnt(0)" ::: "memory")
#define VM_WAIT() asm volatile("s_waitcnt vmcnt(0)" ::: "memory")
__device__ __forceinline__ unsigned f2bf(float f) { unsigned u = __builtin_bit_cast(unsigned, f); return (u + 0x7fffu + ((u >> 16) & 1u)) >> 16; }
__device__ __forceinline__ unsigned pk2(float lo, float hi) { return f2bf(lo) | (f2bf(hi) << 16); }
typedef __bf16 bf16x2_t __attribute__((ext_vector_type(2)));
__device__ __forceinline__ unsigned cvt_pk_bf16(float lo, float hi) { const bf16x2_t v = __builtin_convertvector((f32x2){lo, hi}, bf16x2_t); return __builtin_bit_cast(unsigned, v); }
typedef int i32x8 __attribute__((ext_vector_type(8)));
__device__ __forceinline__ unsigned cvt4_fp8(float a, float b, float c, float d) {
    a = __builtin_fminf(__builtin_fmaxf(a, -448.f), 448.f); b = __builtin_fminf(__builtin_fmaxf(b, -448.f), 448.f);
    c = __builtin_fminf(__builtin_fmaxf(c, -448.f), 448.f); d = __builtin_fminf(__builtin_fmaxf(d, -448.f), 448.f);
    unsigned w = 0u; w = (unsigned)__builtin_amdgcn_cvt_pk_fp8_f32(a, b, (int)w, false); w = (unsigned)__builtin_amdgcn_cvt_pk_fp8_f32(c, d, (int)w, true); return w; }
constexpr float SC_W8 = 256.f, SC_H8 = 16.f, SC_HID8 = 8.f;
__device__ __forceinline__ float bf_lo(unsigned w) { return __builtin_bit_cast(float, w << 16); }
__device__ __forceinline__ float bf_hi(unsigned w) { return __builtin_bit_cast(float, w & 0xffff0000u); }
__device__ __forceinline__ int opaque_lane() { int t = threadIdx.x; asm volatile("" : "+v"(t)); return t & 63; }
__device__ __forceinline__ float wave_sum(float v) {
#pragma unroll
    for (int o = 1; o < 64; o <<= 1) v += __shfl_xor(v, o);
    return v;
}
__device__ __forceinline__ float fast_sigmoid(float v) { return __builtin_amdgcn_rcpf(1.0f + __builtin_amdgcn_exp2f(-1.44269504089f * v)); }


#ifndef PROBE_A
#define PROBE_A -1
#endif
#ifndef PROBE_B
#define PROBE_B 0
#endif
#ifndef PROBE_PHASE
#define PROBE_PHASE -1
#endif
#ifndef PROBE_BLK
#define PROBE_BLK 0
#endif
#define PROBE_SCALE 10
#define STAMP_BASE (143360 + 1024)
#define STAMP_EN() (((volatile LAS unsigned*)(unsigned)(STAMP_BASE + 512))[0])
#ifndef PROBE_NG
#define PROBE_NG 0
#endif
#define STAMPN(ph, i) do { if (PROBE_A >= 0 && PROBE_NG && PROBE_PHASE == (ph) && blockIdx.x == PROBE_BLK && threadIdx.x == 0) { ((volatile LAS unsigned long long*)(unsigned)STAMP_BASE)[i] = __builtin_amdgcn_s_memrealtime(); } } while (0)
#define STAMP0(i) STAMPN(0, i)
#define STAMPG(i) do { if constexpr (PRB) { STAMP(i); } } while (0)
#define STAMP(i) do { if (PROBE_A >= 0 && !PROBE_NG && blockIdx.x == PROBE_BLK && threadIdx.x == 0 && STAMP_EN()) { ((volatile LAS unsigned long long*)(unsigned)STAMP_BASE)[i] = __builtin_amdgcn_s_memrealtime(); } } while (0)

#define XB_TMO      128
#define XB_XCNT(j)  (256  + 64 * (j))
#define XB_XSUB(j)  (1280 + 64 * (j))
#define XB_XGEN(j)  (2304 + 64 * (j))
#define XB_TOP      3328
#define XB_TOPGEN   3392
#define XCD_BAR_WORDS 3456
#define XB_SPIN_CAP (1u << 18)
__device__ __forceinline__ unsigned xb_ld(unsigned* p)              { return __hip_atomic_load(p, __ATOMIC_RELAXED, __HIP_MEMORY_SCOPE_AGENT); }
__device__ __forceinline__ unsigned xb_add(unsigned* p, unsigned v) { return __hip_atomic_fetch_add(p, v, __ATOMIC_RELAXED, __HIP_MEMORY_SCOPE_AGENT); }
__device__ __forceinline__ unsigned xb_xcc_id() { return (unsigned)__builtin_amdgcn_s_getreg((3 << 11) | 20) & 0xFu; }
#define XB_SPIN(cond, bar) do { unsigned _sp = 0; while (cond) { __builtin_amdgcn_s_sleep(1); \
    if ((++_sp & 255u) == 0u) { if (xb_ld(&(bar)[XB_TMO])) break; if (_sp > XB_SPIN_CAP) { atomicAdd(&(bar)[XB_TMO], 1u); break; } } } } while (0)
struct XcdBarrier { unsigned* bar; unsigned x; volatile LAS unsigned* st; };
__device__ __forceinline__ XcdBarrier xcd_barrier_post(unsigned* bar, volatile LAS unsigned* st) {
    XcdBarrier b; b.bar = bar; b.x = xb_xcc_id(); b.st = st;
    if (threadIdx.x == 0) (void)xb_add(&bar[XB_XCNT(b.x)], 1u);
    return b;
}
__device__ __forceinline__ void xcd_barrier_complete(unsigned* bar, unsigned x, unsigned& nloc, unsigned& nx) {
    const unsigned G = gridDim.x * gridDim.y * gridDim.z;
    unsigned sum, cnt, mine, sp = 0u;
    for (;;) {
        sum = 0u; cnt = 0u; mine = 0u;
#pragma unroll
        for (unsigned j = 0; j < 16; ++j) { const unsigned c = xb_ld(&bar[XB_XCNT(j)]); sum += c; cnt += (c > 0u) ? 1u : 0u; mine = (j == x) ? c : mine; }
        if (sum == G) break;
        __builtin_amdgcn_s_sleep(1);
        if ((++sp & 255u) == 0u) { if (xb_ld(&bar[XB_TMO])) break; if (sp > XB_SPIN_CAP) { atomicAdd(&bar[XB_TMO], 1u); break; } }
    }
    nloc = mine > 0u ? mine : 1u; nx = cnt > 0u ? cnt : 1u;
}
__device__ __forceinline__ void xcd_barrier(const XcdBarrier& b) {
    asm volatile("s_waitcnt vmcnt(0)" ::: "memory");
    __syncthreads();
    if (threadIdx.x == 0) {
        unsigned* bar = b.bar;
        __builtin_amdgcn_s_waitcnt(0);
        unsigned nloc = b.st[0], nx = b.st[1];
        if (nloc == 0u) { xcd_barrier_complete(bar, b.x, nloc, nx); b.st[0] = nloc; b.st[1] = nx; }
        const unsigned old = xb_add(&bar[XB_XSUB(b.x)], 1u);
        const unsigned gen = old / nloc;
        if (old + 1u == (gen + 1u) * nloc) {
            __builtin_amdgcn_fence(__ATOMIC_RELEASE, "agent");
            asm volatile("s_waitcnt vmcnt(0)" ::: "memory");
            const unsigned og = xb_add(&bar[XB_TOP], 1u);
            const unsigned tg = og / nx;
            if (og + 1u == (tg + 1u) * nx) xb_add(&bar[XB_TOPGEN], 1u);
            else XB_SPIN(xb_ld(&bar[XB_TOPGEN]) == tg, bar);
            __builtin_amdgcn_fence(__ATOMIC_ACQUIRE, "agent");
            xb_add(&bar[XB_XGEN(b.x)], 1u);
            asm volatile("s_waitcnt vmcnt(0)" ::: "memory");
        } else {
            XB_SPIN(xb_ld(&bar[XB_XGEN(b.x)]) == gen, bar);
            __builtin_amdgcn_fence(__ATOMIC_ACQUIRE, "agent");
            asm volatile("s_waitcnt vmcnt(0)" ::: "memory");
        }
    }
    __syncthreads();
}

namespace pg8 {
typedef int i32x4v __attribute__((ext_vector_type(4)));
template <bool F8> struct FragT { bf16x8 bf[2]; };
template <> struct FragT<true> { i32x8 f8; };
constexpr int BM = 256, BK = 64, HALF = 128, HTB = HALF * BK * 2, STAGE_BYTES = 8 * HTB;
__device__ __forceinline__ int lds_byte(int r, int c) { const int st = (r >> 4) * 2 + (c >> 5), rr = r & 15, cc = c & 31, ob = rr * 64 + cc * 2; return st * 1024 + (ob ^ (((ob >> 9) & 1) << 5)); }
__device__ __forceinline__ void stage_rc(int b, int& R, int& C) { const int st = b / 1024, sb = b % 1024, swz = sb ^ (((sb >> 9) & 1) << 5); R = (st >> 1) * 16 + swz / 64; C = (st & 1) * 32 + (swz % 64) / 2; }
__device__ __forceinline__ int perm32(int rho) { const int n = rho >> 4, i = rho & 15; return 8 * (i >> 2) + 4 * n + (i & 3); }

struct Unit { const char* A; const char* B0; int nt; int r0, c0, aux; };

__device__ __forceinline__ void tile_order(int L, int nM, int nN, int& pm, int& pn) {
    const int nwg = nM * nN;
    int wgid = L; { const int q = nwg / 8, r = nwg % 8, xcd = wgid % 8, off = wgid / 8; wgid = (xcd < r ? xcd * (q + 1) : r * (q + 1) + (xcd - r) * q) + off; }
    const int nig = 8 * nN, gid = wgid / nig, fm = gid * 8, gsz = (nM - fm) < 8 ? (nM - fm) : 8;
    pm = fm + ((wgid % nig) % gsz); pn = (wgid % nig) / gsz;
}

template <bool FP8, bool PRB = false, class Epi, class Sched>
__device__ __forceinline__ void gemm_phase(LAS unsigned char* lds, const int lda, const int ldb, const Sched& S, const Epi& E) {
    int tid = threadIdx.x; asm volatile("" : "+v"(tid));
    const int wid = __builtin_amdgcn_readfirstlane(tid >> 6), lane = tid & 63, wr = wid >> 2, wc = wid & 3, fr = lane & 15, fq = lane >> 4;
    unsigned voffA[2], voffB[2];
#pragma unroll
    for (int i = 0; i < 2; ++i) { int R, C; stage_rc(tid * 16 + i * 8192, R, C); const int Rb = (R & ~31) + perm32(R & 31);
        voffA[i] = (unsigned)(R * lda + C * 2); voffB[i] = (unsigned)(Rb * ldb + C * 2); }
    const size_t kstep = (size_t)(BK * 2);
    const size_t hstepA = (size_t)HALF * lda, hstepB = (size_t)HALF * ldb;
    const unsigned ldsw = (unsigned)wid * 1024u;
    const int aoff = lds_byte(wr * 64 + fr, FP8 ? fq * 16 : fq * 8), boff = lds_byte(wc * 32 + fr, FP8 ? fq * 16 : fq * 8);
#define PG8_SA(b, h) (((b) * 2 + (h)) * HTB)
#define PG8_SB(b, h) ((4 + (b) * 2 + (h)) * HTB)
#define PG8_STAGE(bufoff, gbase, voff) do { const char* _gb = (const char*)(gbase); asm volatile("" : "+s"(_gb)); _Pragma("unroll") for (int _i = 0; _i < 2; ++_i) { \
        unsigned _vo = (voff)[_i]; asm volatile("" : "+v"(_vo)); \
        __builtin_amdgcn_global_load_lds((const unsigned*)(_gb + _vo), (LAS unsigned*)(lds + (bufoff) + ldsw + _i * 8192), 16, 0, 0); } } while (0)
#define PG8_LDA(dst, b, h) do { _Pragma("unroll") for (int m = 0; m < 4; ++m) { if constexpr (FP8) { \
            const i32x4v lo_ = *(const LAS i32x4v*)(lds + PG8_SA(b, h) + aoff + m * 2048), hi_ = *(const LAS i32x4v*)(lds + PG8_SA(b, h) + aoff + m * 2048 + 16); \
            dst[m].f8 = __builtin_shufflevector(lo_, hi_, 0, 1, 2, 3, 4, 5, 6, 7); } \
        else { _Pragma("unroll") for (int k = 0; k < 2; ++k) dst[m].bf[k] = *(const LAS bf16x8*)(lds + PG8_SA(b, h) + aoff + m * 2048 + k * 1024); } } } while (0)
#define PG8_LDB(dst, b, h) do { _Pragma("unroll") for (int n = 0; n < 2; ++n) { if constexpr (FP8) { \
            const i32x4v lo_ = *(const LAS i32x4v*)(lds + PG8_SB(b, h) + boff + n * 2048), hi_ = *(const LAS i32x4v*)(lds + PG8_SB(b, h) + boff + n * 2048 + 16); \
            dst[n].f8 = __builtin_shufflevector(lo_, hi_, 0, 1, 2, 3, 4, 5, 6, 7); } \
        else { _Pragma("unroll") for (int k = 0; k < 2; ++k) dst[n].bf[k] = *(const LAS bf16x8*)(lds + PG8_SB(b, h) + boff + n * 2048 + k * 1024); } } } while (0)
#define PG8_MMA(ai, bj, At, Bt) do { __builtin_amdgcn_s_setprio(1); _Pragma("unroll") for (int m = 0; m < 4; ++m) _Pragma("unroll") for (int n = 0; n < 2; ++n) { \
        if constexpr (FP8) acc[ai][bj][m][n] = __builtin_amdgcn_mfma_scale_f32_16x16x128_f8f6f4(Bt[n].f8, At[m].f8, acc[ai][bj][m][n], 0, 0, 0, 0x7F7F7F7F, 0, 0x7F7F7F7F); \
        else { _Pragma("unroll") for (int k = 0; k < 2; ++k) acc[ai][bj][m][n] = __builtin_amdgcn_mfma_f32_16x16x32_bf16(Bt[n].bf[k], At[m].bf[k], acc[ai][bj][m][n], 0, 0, 0); } } \
        __builtin_amdgcn_s_setprio(0); } while (0)
#define PG8_WAIT_V(n) asm volatile("s_waitcnt vmcnt(" #n ")" ::: "memory")
#define PG8_WAIT_L(n) asm volatile("s_waitcnt lgkmcnt(" #n ")" ::: "memory")
#define PG8_BAR __builtin_amdgcn_s_barrier()
#define PG8_SCHED __builtin_amdgcn_sched_barrier(0)
    Unit cur, nxt; int ui = 0;
    STAMPG(0);
    if (!S.next(0, cur)) return;
    f32x4 acc[2][2][4][2];
#pragma unroll
    for (int a = 0; a < 2; ++a)
#pragma unroll
        for (int b = 0; b < 2; ++b)
#pragma unroll
            for (int m = 0; m < 4; ++m)
#pragma unroll
                for (int n = 0; n < 2; ++n) acc[a][b][m][n] = (f32x4){0.f, 0.f, 0.f, 0.f};
    FragT<FP8> At[4], B0[2], B1[2];
    const char* cA = cur.A; const char* cB0 = cur.B0;
    PG8_STAGE(PG8_SB(0, 0), cB0, voffB); PG8_STAGE(PG8_SB(0, 1), cB0 + hstepB, voffB); PG8_STAGE(PG8_SA(0, 0), cA, voffA); PG8_STAGE(PG8_SA(0, 1), cA + hstepA, voffA);
    if (wr == 1) PG8_BAR;
    PG8_WAIT_V(2); PG8_BAR;
    PG8_STAGE(PG8_SB(1, 0), cB0 + kstep, voffB); PG8_STAGE(PG8_SA(1, 0), cA + kstep, voffA); PG8_STAGE(PG8_SB(1, 1), cB0 + hstepB + kstep, voffB);
    PG8_WAIT_V(6); PG8_BAR;
    STAMPG(1);
    for (;;) {
        const bool has_next = S.next(ui + 1, nxt);
        const char* nA = has_next ? nxt.A : cA; const char* nB0 = has_next ? nxt.B0 : cB0;
        const int nt = cur.nt;
        for (int t = 0; t < nt; t += 2) {
            const bool last = (t == nt - 2);
            const char* a1 = cA + (size_t)(t + 1) * kstep;
            const char* a2 = last ? nA : cA + (size_t)(t + 2) * kstep;
            const char* b20 = last ? nB0 : cB0 + (size_t)(t + 2) * kstep; const char* b21 = b20 + hstepB;
            const char* a3 = a2 + kstep; const char* b30 = b20 + kstep; const char* b31 = b21 + kstep;
            PG8_LDB(B0, 0, 0); PG8_LDB(B1, 0, 1); PG8_SCHED; PG8_LDA(At, 0, 0); PG8_STAGE(PG8_SA(1, 1), a1 + hstepA, voffA);
            PG8_WAIT_V(8); PG8_WAIT_L(0); PG8_BAR; PG8_MMA(0, 0, At, B0); PG8_MMA(0, 1, At, B1); PG8_BAR; PG8_SCHED;
            PG8_LDA(At, 0, 1); PG8_STAGE(PG8_SB(0, 0), b20, voffB); PG8_STAGE(PG8_SB(0, 1), b21, voffB); PG8_STAGE(PG8_SA(0, 0), a2, voffA);
            PG8_WAIT_V(8); PG8_WAIT_L(0); PG8_BAR; PG8_MMA(1, 0, At, B0); PG8_MMA(1, 1, At, B1); PG8_BAR; PG8_SCHED;
            PG8_LDB(B0, 1, 0); PG8_LDB(B1, 1, 1); PG8_SCHED; PG8_LDA(At, 1, 0); PG8_STAGE(PG8_SA(0, 1), a2 + hstepA, voffA);
            PG8_WAIT_V(8); PG8_WAIT_L(0); PG8_BAR; PG8_MMA(0, 0, At, B0); PG8_MMA(0, 1, At, B1); PG8_BAR; PG8_SCHED;
            PG8_LDA(At, 1, 1); PG8_STAGE(PG8_SB(1, 0), b30, voffB); PG8_STAGE(PG8_SB(1, 1), b31, voffB); PG8_STAGE(PG8_SA(1, 0), a3, voffA);
            PG8_WAIT_V(8); PG8_WAIT_L(0); PG8_BAR; PG8_MMA(1, 0, At, B0); PG8_MMA(1, 1, At, B1); PG8_BAR; PG8_SCHED;
        }
        if (wr == 0) PG8_BAR;
        if (ui == 0) STAMPG(2); STAMPG(4);
        E(acc, cur, wr, wc, fr, fq);
        if (PROBE_A >= 0 && PRB) { asm volatile("s_waitcnt vmcnt(0)" ::: "memory"); } if (ui == 0) STAMPG(3); STAMPG(5);
        if (!has_next) break;
        if (!Epi::keep_acc(cur)) {
#pragma unroll
        for (int a = 0; a < 2; ++a)
#pragma unroll
            for (int b = 0; b < 2; ++b)
#pragma unroll
                for (int m = 0; m < 4; ++m)
#pragma unroll
                    for (int n = 0; n < 2; ++n) acc[a][b][m][n] = (f32x4){0.f, 0.f, 0.f, 0.f}; }
        cur = nxt; cA = nA; cB0 = nB0; ++ui;
        if (wr == 1) PG8_BAR;
    }
    PG8_WAIT_V(0);
    PG8_BAR;
    STAMPG(6);
#undef PG8_SA
#undef PG8_SB
#undef PG8_STAGE
#undef PG8_LDA
#undef PG8_LDB
#undef PG8_MMA
#undef PG8_WAIT_V
#undef PG8_WAIT_L
#undef PG8_BAR
#undef PG8_SCHED
}

struct EpiBf16 {
    static __device__ __forceinline__ bool keep_acc(const Unit&) { return false; }
    bf16_t* O; int ldc; const float* rowscale; float mul;
    __device__ __forceinline__ void operator()(const f32x4 (&acc)[2][2][4][2], const Unit& u, int wr, int wc, int fr, int fq) const {
        const int row0 = u.r0 + wr * 64 + fr, col0 = u.c0 + wc * 32 + 8 * fq;
#pragma unroll
        for (int ai = 0; ai < 2; ++ai)
#pragma unroll
            for (int m = 0; m < 4; ++m) { const int row = row0 + ai * HALF + m * 16; const float sc = rowscale ? rowscale[row] * mul : mul;
                bf16_t* rowp = O + (size_t)row * ldc + col0;
#pragma unroll
                for (int bj = 0; bj < 2; ++bj) { const f32x4 v0 = acc[ai][bj][m][0] * sc, v1 = acc[ai][bj][m][1] * sc;
                    u32x4 w; w.x = cvt_pk_bf16(v0[0], v0[1]); w.y = cvt_pk_bf16(v0[2], v0[3]); w.z = cvt_pk_bf16(v1[0], v1[1]); w.w = cvt_pk_bf16(v1[2], v1[3]);
                    *(u32x4*)(rowp + bj * HALF) = w; } }
    }
};
struct EpiZ {
    static __device__ __forceinline__ bool keep_acc(const Unit&) { return false; }
    bf16_t* ZM; bf16_t* UT;
    __device__ __forceinline__ void operator()(const f32x4 (&acc)[2][2][4][2], const Unit& u, int wr, int wc, int fr, int fq) const {
        const int row0 = u.r0 + wr * 64 + fr, col0 = u.c0 + wc * 32 + 8 * fq;
        if (u.c0 >= 1024 && u.c0 < 1536) {
#pragma unroll
            for (int ai = 0; ai < 2; ++ai)
#pragma unroll
                for (int m = 0; m < 4; ++m) { const int row = row0 + ai * HALF + m * 16; const int b = row >> 11, s = row & 2047;
                    bf16_t* base = UT + ((size_t)b * 512 + (col0 - 1024)) * 2048 + s;
#pragma unroll
                    for (int bj = 0; bj < 2; ++bj)
#pragma unroll
                        for (int n = 0; n < 2; ++n)
#pragma unroll
                            for (int j = 0; j < 4; ++j) base[(size_t)(bj * HALF + 4 * n + j) * 2048] = (bf16_t)f2bf(acc[ai][bj][m][n][j]); }
        } else {
#pragma unroll
            for (int ai = 0; ai < 2; ++ai)
#pragma unroll
                for (int m = 0; m < 4; ++m) { bf16_t* rowp = ZM + (size_t)(row0 + ai * HALF + m * 16) * 2048 + col0;
#pragma unroll
                    for (int bj = 0; bj < 2; ++bj) { const f32x4 v0 = acc[ai][bj][m][0], v1 = acc[ai][bj][m][1];
                        u32x4 w; w.x = cvt_pk_bf16(v0[0], v0[1]); w.y = cvt_pk_bf16(v0[2], v0[3]); w.z = cvt_pk_bf16(v1[0], v1[1]); w.w = cvt_pk_bf16(v1[2], v1[3]);
                        *(u32x4*)(rowp + bj * HALF) = w; } }
        }
    }
};
struct EpiGates8 {
    static __device__ __forceinline__ bool keep_acc(const Unit&) { return false; }
    bf16_t* G; float inmul;
    __device__ __forceinline__ void operator()(const f32x4 (&acc)[2][2][4][2], const Unit& u, int wr, int wc, int fr, int fq) const {
        const int row0 = u.r0 + wr * 64 + fr, col0 = u.c0 + wc * 32 + 8 * fq;
#pragma unroll
        for (int ai = 0; ai < 2; ++ai)
#pragma unroll
            for (int m = 0; m < 4; ++m) { bf16_t* rowp = G + (size_t)(row0 + ai * HALF + m * 16) * 6144 + col0;
#pragma unroll
                for (int bj = 0; bj < 2; ++bj) { const f32x4 a0 = acc[ai][bj][m][0] * inmul, a1 = acc[ai][bj][m][1] * inmul;
                    u32x4 w; w.x = cvt_pk_bf16(fast_sigmoid(a0[0]), fast_sigmoid(a0[1])); w.y = cvt_pk_bf16(fast_sigmoid(a0[2]), fast_sigmoid(a0[3]));
                    w.z = cvt_pk_bf16(fast_sigmoid(a1[0]), fast_sigmoid(a1[1])); w.w = cvt_pk_bf16(fast_sigmoid(a1[2]), fast_sigmoid(a1[3]));
                    *(u32x4*)(rowp + bj * HALF) = w; } }
    }
};
struct EpiGate {
    static __device__ __forceinline__ bool keep_acc(const Unit& u) { return (u.aux & 32) == 0; }
    bf16_t* MG; const bf16_t* G;
    __device__ __forceinline__ void operator()(f32x4 (&acc)[2][2][4][2], const Unit& u, int wr, int wc, int fr, int fq) const {
        const int row0 = u.r0 + wr * 64 + fr, col0 = u.c0 + wc * 32 + 8 * fq; const int gs = u.aux & 3, gn = (u.aux >> 2) & 3; const bool last = (u.aux & 32) != 0;
#pragma unroll
        for (int ai = 0; ai < 2; ++ai)
#pragma unroll
            for (int m = 0; m < 4; ++m) { const int row = row0 + ai * HALF + m * 16;
                const bf16_t* gp = G + (size_t)row * 6144 + gs * 2048 + col0; const bf16_t* gq = G + (size_t)row * 6144 + gn * 2048 + col0;
#pragma unroll
                for (int bj = 0; bj < 2; ++bj) { const u32x4 g = *(const u32x4*)(gp + bj * HALF);
                    float f[8] = {bf_lo(g.x), bf_hi(g.x), bf_lo(g.y), bf_hi(g.y), bf_lo(g.z), bf_hi(g.z), bf_lo(g.w), bf_hi(g.w)};
                    if (!last) { const u32x4 h = *(const u32x4*)(gq + bj * HALF);
                        const float d[8] = {bf_lo(h.x), bf_hi(h.x), bf_lo(h.y), bf_hi(h.y), bf_lo(h.z), bf_hi(h.z), bf_lo(h.w), bf_hi(h.w)};
#pragma unroll
                        for (int j = 0; j < 8; ++j) f[j] = f[j] * __builtin_amdgcn_rcpf(__builtin_fmaxf(d[j], 1e-30f)); }
                    f32x4 a0 = acc[ai][bj][m][0], a1 = acc[ai][bj][m][1];
                    a0[0] *= f[0]; a0[1] *= f[1]; a0[2] *= f[2]; a0[3] *= f[3]; a1[0] *= f[4]; a1[1] *= f[5]; a1[2] *= f[6]; a1[3] *= f[7];
                    if (last) { u32x4 w; w.x = cvt_pk_bf16(a0[0], a0[1]); w.y = cvt_pk_bf16(a0[2], a0[3]); w.z = cvt_pk_bf16(a1[0], a1[1]); w.w = cvt_pk_bf16(a1[2], a1[3]);
                        *(u32x4*)(MG + (size_t)row * 2048 + col0 + bj * HALF) = w; }
                    else { acc[ai][bj][m][0] = a0; acc[ai][bj][m][1] = a1; } } }
    }
};
struct EpiResid {
    static __device__ __forceinline__ bool keep_acc(const Unit&) { return false; }
    const float* X; bf16_t* O;
    __device__ __forceinline__ void operator()(const f32x4 (&acc)[2][2][4][2], const Unit& u, int wr, int wc, int fr, int fq) const {
        const int row0 = u.r0 + wr * 64 + fr, col0 = u.c0 + wc * 32 + 8 * fq;
#pragma unroll
        for (int ai = 0; ai < 2; ++ai)
#pragma unroll
            for (int m = 0; m < 4; ++m) { const size_t off = (size_t)(row0 + ai * HALF + m * 16) * 2048 + col0;
#pragma unroll
                for (int bj = 0; bj < 2; ++bj) { const f32x4 x0 = *(const f32x4*)(X + off + bj * HALF), x1 = *(const f32x4*)(X + off + bj * HALF + 4);
                    const f32x4 v0 = x0 + acc[ai][bj][m][0], v1 = x1 + acc[ai][bj][m][1];
                    u32x4 w; w.x = cvt_pk_bf16(v0[0], v0[1]); w.y = cvt_pk_bf16(v0[2], v0[3]); w.z = cvt_pk_bf16(v1[0], v1[1]); w.w = cvt_pk_bf16(v1[2], v1[3]);
                    *(u32x4*)(O + off + bj * HALF) = w; } }
    }
};
struct EpiSwiGLU8 {
    static __device__ __forceinline__ bool keep_acc(const Unit&) { return false; }
    unsigned char* H; float inmul;
    __device__ __forceinline__ void operator()(const f32x4 (&acc)[2][2][4][2], const Unit& u, int wr, int wc, int fr, int fq) const {
        const int row0 = u.r0 + wr * 64 + fr, col0 = u.c0 + wc * 32 + 8 * fq;
#pragma unroll
        for (int ai = 0; ai < 2; ++ai)
#pragma unroll
            for (int m = 0; m < 4; ++m) { unsigned char* rowp = H + (size_t)(row0 + ai * HALF + m * 16) * 2048 + col0;
                float h[8];
#pragma unroll
                for (int n = 0; n < 2; ++n)
#pragma unroll
                    for (int j = 0; j < 4; ++j) { const float g = acc[ai][0][m][n][j] * inmul, up = acc[ai][1][m][n][j] * inmul; h[4 * n + j] = g * fast_sigmoid(g) * up * SC_HID8; }
                u32x2 w; w.x = cvt4_fp8(h[0], h[1], h[2], h[3]); w.y = cvt4_fp8(h[4], h[5], h[6], h[7]);
                *(u32x2*)rowp = w; }
    }
};
}

struct Args {
    const float* x; const float* mem; const float* norm_mix_g; const float* norm_mem_g; const float* w_in; const float* pool_w; const float* pool_scale; const float* fourier_w;
    const float* w_kv; const float* proj_pool; const float* proj_fourier; const float* proj_mem; const float* w_out; const float* norm_ffn_g; const float* w_router;
    const float* w_gate; const float* w_up; const float* w_down; const float* norm_final_g;
    float* out; unsigned char* ws; int ph_lo, ph_hi;
};

template <bool FP8>
__device__ __forceinline__ void p0_tile64(const float* W, int N, int k0, int n0, void* WT, int ldt, int drow0, const float* kscale, float mul, int lane) {
    if constexpr (FP8) {
        const int lr = lane >> 4, lc = 4 * (lane & 15);
        f32x4 v[16];
#pragma unroll
        for (int i = 0; i < 16; ++i) v[i] = *(const f32x4*)(W + (size_t)(k0 + 16 * lr + i) * N + n0 + lc);
#pragma unroll
        for (int i = 0; i < 16; ++i) { float sc = mul; if (kscale) sc *= kscale[k0 + 16 * lr + i]; v[i] = v[i] * sc; }
#pragma unroll
        for (int n = 0; n < 4; ++n) { u32x4 o;
            o.x = cvt4_fp8(v[0][n], v[1][n], v[2][n], v[3][n]); o.y = cvt4_fp8(v[4][n], v[5][n], v[6][n], v[7][n]);
            o.z = cvt4_fp8(v[8][n], v[9][n], v[10][n], v[11][n]); o.w = cvt4_fp8(v[12][n], v[13][n], v[14][n], v[15][n]);
            *(u32x4*)((unsigned char*)WT + (size_t)(drow0 + lc + n) * ldt + k0 + 16 * lr) = o; }
    } else {
        const int kq = lane & 7, cg = lane >> 3;
        f32x4 v[2][8];
#pragma unroll
        for (int h = 0; h < 2; ++h)
#pragma unroll
            for (int i = 0; i < 8; ++i) v[h][i] = *(const f32x4*)(W + (size_t)(k0 + 8 * kq + i) * N + n0 + 32 * h + 4 * cg);
        if (kscale) {
#pragma unroll
            for (int i = 0; i < 8; ++i) { const float sc = kscale[k0 + 8 * kq + i]; v[0][i] = v[0][i] * sc; v[1][i] = v[1][i] * sc; } }
#pragma unroll
        for (int h = 0; h < 2; ++h)
#pragma unroll
            for (int n = 0; n < 4; ++n) { u32x4 o;
                o.x = cvt_pk_bf16(v[h][0][n], v[h][1][n]); o.y = cvt_pk_bf16(v[h][2][n], v[h][3][n]); o.z = cvt_pk_bf16(v[h][4][n], v[h][5][n]); o.w = cvt_pk_bf16(v[h][6][n], v[h][7][n]);
                *(u32x4*)((bf16_t*)WT + (size_t)(drow0 + 32 * h + 4 * cg + n) * ldt + k0 + 8 * kq) = o; }
    }
}
__device__ __forceinline__ void rms_row_to_bf16(const float* xrow, const float* g, bf16_t* orow, unsigned char* orow8, int lane) {
    const f32x4* xr = (const f32x4*)xrow + lane; const f32x4* gr = (const f32x4*)g + lane;
    f32x4 v[8]; float s = 0.f;
#pragma unroll
    for (int j = 0; j < 8; ++j) { v[j] = xr[64 * j]; s += (v[j].x * v[j].x + v[j].y * v[j].y) + (v[j].z * v[j].z + v[j].w * v[j].w); }
    const float inv = 1.0f / sqrtf(wave_sum(s) * (1.f / DM) + EPS);
    u32x2* o8 = (u32x2*)orow + lane;
#pragma unroll
    for (int j = 0; j < 8; ++j) { const f32x4 gg = gr[64 * j]; const f32x4 h = v[j] * inv * gg; u32x2 w; w.x = cvt_pk_bf16(h.x, h.y); w.y = cvt_pk_bf16(h.z, h.w); o8[64 * j] = w;
        if (orow8) ((unsigned*)orow8)[64 * j + lane] = cvt4_fp8(h.x * SC_H8, h.y * SC_H8, h.z * SC_H8, h.w * SC_H8); }
}

struct ExItem { const float* src; unsigned char* dst; int k0, n0, drow0; };
__device__ __forceinline__ ExItem ex_item(const Args& a, int r) {
    constexpr int I_EX = 32 * 32; const int mat = r / I_EX, w = r % I_EX, type = mat / 16, e = mat % 16, kb = w / 32, nb = w % 32, n0 = nb * 64;
    ExItem it; it.src = (type == 0 ? a.w_gate : (type == 1 ? a.w_up : a.w_down)) + (size_t)e * 2048 * 2048; it.k0 = kb * 64; it.n0 = n0;
    if (type < 2) { it.dst = a.ws + WS_WGUT + (size_t)e * 4096 * 2048; it.drow0 = ((n0 >> 7) << 8) + (n0 & 127) + (type == 1 ? 128 : 0); }
    else { it.dst = a.ws + WS_WDT + (size_t)e * 2048 * 2048; it.drow0 = n0; }
    return it;
}
__device__ __forceinline__ void ex_load(const ExItem& it, f32x4 (&v)[16], int lane) {
    const int lr = lane >> 4, lc = 4 * (lane & 15);
#pragma unroll
    for (int i = 0; i < 16; ++i) v[i] = __builtin_nontemporal_load((const f32x4*)(it.src + (size_t)(it.k0 + 16 * lr + i) * 2048 + it.n0 + lc));
}
__device__ __forceinline__ void ex_store(const ExItem& it, const f32x4 (&v)[16], int lane) {
    const int lr = lane >> 4, lc = 4 * (lane & 15);
#pragma unroll
    for (int n = 0; n < 4; ++n) { u32x4 o;
        o.x = cvt4_fp8(v[0][n] * SC_W8, v[1][n] * SC_W8, v[2][n] * SC_W8, v[3][n] * SC_W8); o.y = cvt4_fp8(v[4][n] * SC_W8, v[5][n] * SC_W8, v[6][n] * SC_W8, v[7][n] * SC_W8);
        o.z = cvt4_fp8(v[8][n] * SC_W8, v[9][n] * SC_W8, v[10][n] * SC_W8, v[11][n] * SC_W8); o.w = cvt4_fp8(v[12][n] * SC_W8, v[13][n] * SC_W8, v[14][n] * SC_W8, v[15][n] * SC_W8);
        __builtin_nontemporal_store(o, (u32x4*)(it.dst + (size_t)(it.drow0 + lc + n) * 2048 + it.k0 + 16 * lr)); }
}
__device__ __forceinline__ void convert_experts(const Args& a, int c, int G, int wave, int lane) {
    constexpr int NEXP = 48 * 32 * 32;
    int start, cnt;
    if (G == 256) { if (c >= 64 && c < 96) { cnt = 192; start = (c - 64) * 192; } else if (c < 64) { cnt = 212; start = 6144 + c * 212; } else { cnt = 184; start = 19712 + (c - 96) * 184; } }
    else { const int per = (NEXP + G - 1) / G; start = c * per; cnt = (start + per <= NEXP) ? per : (NEXP > start ? NEXP - start : 0); }
    const int end = start + cnt;
    int r = start + wave; if (r >= end) return;
    f32x4 va[16], vb[16];
    ExItem ia = ex_item(a, r), ib; ex_load(ia, va, lane);
    for (;;) {
        const bool hb = (r + NWAVES) < end; if (hb) { ib = ex_item(a, r + NWAVES); ex_load(ib, vb, lane); }
        ex_store(ia, va, lane);
        if (!hb) break;
        r += NWAVES;
        const bool ha = (r + NWAVES) < end; if (ha) { ia = ex_item(a, r + NWAVES); ex_load(ia, va, lane); }
        ex_store(ib, vb, lane);
        if (!ha) break;
        r += NWAVES;
    }
}
__device__ __forceinline__ void rms_row2_to_bf16(const float* xrow, const float* g, bf16_t* orow, unsigned char* orow8, int lane) {
    const f32x4* xr = (const f32x4*)xrow + lane; const f32x4* gr = (const f32x4*)g + lane;
    f32x4 v[2][8]; float s0 = 0.f, s1 = 0.f;
#pragma unroll
    for (int j = 0; j < 8; ++j) { v[0][j] = xr[64 * j]; v[1][j] = xr[512 + 64 * j]; }
#pragma unroll
    for (int j = 0; j < 8; ++j) { s0 += (v[0][j].x * v[0][j].x + v[0][j].y * v[0][j].y) + (v[0][j].z * v[0][j].z + v[0][j].w * v[0][j].w); s1 += (v[1][j].x * v[1][j].x + v[1][j].y * v[1][j].y) + (v[1][j].z * v[1][j].z + v[1][j].w * v[1][j].w); }
    const float inv0 = 1.0f / sqrtf(wave_sum(s0) * (1.f / DM) + EPS), inv1 = 1.0f / sqrtf(wave_sum(s1) * (1.f / DM) + EPS);
    u32x2* o8 = (u32x2*)orow + lane; unsigned* of8 = (unsigned*)orow8 + lane;
#pragma unroll
    for (int j = 0; j < 8; ++j) { const f32x4 gg = gr[64 * j]; const f32x4 h0 = v[0][j] * inv0 * gg, h1 = v[1][j] * inv1 * gg;
        u32x2 w0; w0.x = cvt_pk_bf16(h0.x, h0.y); w0.y = cvt_pk_bf16(h0.z, h0.w); o8[64 * j] = w0;
        u32x2 w1; w1.x = cvt_pk_bf16(h1.x, h1.y); w1.y = cvt_pk_bf16(h1.z, h1.w); o8[512 + 64 * j] = w1;
        of8[64 * j] = cvt4_fp8(h0.x * SC_H8, h0.y * SC_H8, h0.z * SC_H8, h0.w * SC_H8); of8[512 + 64 * j] = cvt4_fp8(h1.x * SC_H8, h1.y * SC_H8, h1.z * SC_H8, h1.w * SC_H8); }
}
__device__ __forceinline__ void phase0(const Args& a, LAS unsigned char* lds, int gw, int NGW, int wave, int lane) {
    unsigned char* ws = a.ws;
    STAMP0(0);
    LAS float* tab = (LAS float*)lds;
    { const int t_ = threadIdx.x; if (t_ < 128) { tab[t_] = cospif((float)t_ * (1.0f / 64.0f)); tab[128 + t_] = -sinpif((float)t_ * (1.0f / 64.0f)); } }
    __syncthreads();
    constexpr int I_WIN = 32 * 128, I_KV = 32 * 16, I_PP = 16 * 32, I_PF = 8 * 32, I_PM = 8 * 32, I_WO = 32 * 32;
    constexpr int NITEMS = I_WIN + I_KV + I_PP + I_PF + I_PM + I_WO;
    for (int it = gw; it < NITEMS; it += NGW) {
        int r = it;
        if (r < I_WIN) { const int kb = r / 128, nb = r % 128;
            if (nb < 32) p0_tile64<false>(a.w_in, 8192, kb * 64, nb * 64, ws + WS_WINT, 2048, nb * 64, nullptr, 1.f, lane);
            else p0_tile64<true>(a.w_in, 8192, kb * 64, nb * 64, ws + WS_WIN8, 2048, (nb - 32) * 64, nullptr, SC_W8, lane);
            continue; } r -= I_WIN;
        if (r < I_KV) { const int kb = r / 16, nb = r % 16; p0_tile64<false>(a.w_kv, 1024, kb * 64, nb * 64, ws + WS_WKVT, 2048, nb * 64, nullptr, 1.f, lane); continue; } r -= I_KV;
        if (r < I_PP) { const int kb = r / 32, nb = r % 32; p0_tile64<false>(a.proj_pool, 2048, kb * 64, nb * 64, ws + WS_PPST, 1024, nb * 64, a.pool_scale, 1.f, lane); continue; } r -= I_PP;
        if (r < I_PF) { const int kb = r / 32, nb = r % 32; p0_tile64<false>(a.proj_fourier, 2048, kb * 64, nb * 64, ws + WS_PFT, 1024, nb * 64, nullptr, 1.f, lane); continue; } r -= I_PF;
        if (r < I_PM) { const int kb = r / 32, nb = r % 32; p0_tile64<false>(a.proj_mem, 2048, kb * 64, nb * 64, (bf16_t*)(ws + WS_BCAT) + 2048, CAT_LD, nb * 64, nullptr, 1.f, lane); continue; } r -= I_PM;
        { const int kb = r / 32, nb = r % 32; p0_tile64<false>(a.w_out, 2048, kb * 64, nb * 64, ws + WS_WOT, 2048, nb * 64, nullptr, 1.f, lane); }
    }
    STAMP0(1);
    for (int m = 2 * gw; m < T; m += 2 * NGW) rms_row2_to_bf16(a.x + (size_t)m * DM, a.norm_mix_g, (bf16_t*)(ws + WS_XN) + (size_t)m * DM, ws + WS_XN8 + (size_t)m * DM, lane);
    for (int m = gw; m < NBATCH * MEML; m += NGW) rms_row_to_bf16(a.mem + (size_t)m * DM, a.norm_mem_g, (bf16_t*)(ws + WS_MN) + (size_t)m * DM, nullptr, lane);
    STAMP0(2);
    const int gt = gw * 64 + lane, NGT = NGW * 64;
    for (int i = gt; i < 1024 * 128; i += NGT) { const int row = i >> 7, col = (i & 127) * 8, g = row >> 8, c = row & 255;
        u32x4 o = (u32x4){0u, 0u, 0u, 0u};
        if ((col >> 8) == g) { const float* p = a.pool_w + ((size_t)g * 256 + c) * 256 + (col & 255); const f32x4 v0 = *(const f32x4*)p, v1 = *(const f32x4*)(p + 4);
            o.x = pk2(v0.x, v0.y); o.y = pk2(v0.z, v0.w); o.z = pk2(v1.x, v1.y); o.w = pk2(v1.z, v1.w); }
        *(u32x4*)((bf16_t*)(ws + WS_PWBD) + (size_t)row * 1024 + col) = o; }
    for (int i = gt; i < 16 * 2048; i += NGT) { const int e = i >> 11, d = i & 2047; ((bf16_t*)(ws + WS_GWT))[i] = (bf16_t)f2bf(a.norm_ffn_g[d] * a.w_router[d * 16 + e]); }
    STAMP0(3);
    for (int i = gt; i < 1024 * 512; i += NGT) { const int row = i >> 9, col = i & 511, cs = row >> 9, g = (row >> 7) & 3, c = row & 127, g2 = col >> 7, d = col & 127;
        float v = 0.f;
        if (g2 == g) { const float* fw = a.fourier_w + (size_t)g * 128 * 128 + d; const LAS float* tb = tab + (cs ? 128 : 0);
#pragma unroll 8
            for (int j = 0; j < 128; ++j) v += tb[(c * j) & 127] * fw[(size_t)j * 128]; }
        ((bf16_t*)(ws + WS_M1BD))[(size_t)row * 1024 + col] = (bf16_t)f2bf(v); }
    STAMP0(4);
    for (int i = gt; i < 4096 * 256; i += NGT) { const int row = i >> 8, s0 = (i & 255) * 8, cs = row >> 11, k = row & 2047;
        float v[8];
#pragma unroll
        for (int j = 0; j < 8; ++j) { const float ang = (float)((k * (s0 + j)) & 2047) * (1.0f / 1024.0f); v[j] = (cs ? sinpif(ang) : cospif(ang)) * (1.0f / 512.0f); }
        u32x4 o; o.x = pk2(v[0], v[1]); o.y = pk2(v[2], v[3]); o.z = pk2(v[4], v[5]); o.w = pk2(v[6], v[7]);
        *(u32x4*)((bf16_t*)(ws + WS_TW) + (size_t)row * 2048 + s0) = o; }
    STAMP0(5);
}

__device__ __forceinline__ void pool_pass(const Args& a, int gw, int NGW, int lane) {
    const bf16_t* ZM = (const bf16_t*)(a.ws + WS_ZM); bf16_t* AC = (bf16_t*)(a.ws + WS_ACAT);
    for (int it = gw; it < 4096; it += NGW) {
        const int run = it >> 1, hf = it & 1, chunk = hf * 64 + lane, ch0 = chunk * 8, g = chunk >> 5, hw = 1 << g;
        const int t0 = run * 8, b = t0 >> 11, s0 = t0 & 2047; const bf16_t* base = ZM + (size_t)b * SEQ * 2048 + ch0;
        u32x4 rw[23];
#pragma unroll
        for (int r = 0; r < 23; ++r) { const int d = r - 8, s = s0 + d; rw[r] = (u32x4){0u, 0u, 0u, 0u};
            if (d >= -hw && d < 8 + hw - 1 && s >= 0 && s < SEQ) rw[r] = *(const u32x4*)(base + (size_t)s * 2048); }
        float sum[8];
#pragma unroll
        for (int j = 0; j < 8; ++j) sum[j] = 0.f;
#pragma unroll
        for (int r = 0; r < 16; ++r) { const int d = r - 8; if (d >= -hw && d < hw) { const u32x4 w = rw[r];
            sum[0] += bf_lo(w.x); sum[1] += bf_hi(w.x); sum[2] += bf_lo(w.y); sum[3] += bf_hi(w.y); sum[4] += bf_lo(w.z); sum[5] += bf_hi(w.z); sum[6] += bf_lo(w.w); sum[7] += bf_hi(w.w); } }
#pragma unroll
        for (int i = 0; i < 8; ++i) { const int s = s0 + i; const int lo = (s - hw) < 0 ? 0 : (s - hw), hi = (s + hw) > SEQ ? SEQ : (s + hw); const float rc = 1.0f / (float)(hi - lo);
            const u32x4 c = rw[8 + i];
            u32x4 o; o.x = cvt_pk_bf16(sum[0] * rc - bf_lo(c.x), sum[1] * rc - bf_hi(c.x)); o.y = cvt_pk_bf16(sum[2] * rc - bf_lo(c.y), sum[3] * rc - bf_hi(c.y));
            o.z = cvt_pk_bf16(sum[4] * rc - bf_lo(c.z), sum[5] * rc - bf_hi(c.z)); o.w = cvt_pk_bf16(sum[6] * rc - bf_lo(c.w), sum[7] * rc - bf_hi(c.w));
            *(u32x4*)(AC + (size_t)(t0 + i) * CAT_LD + ch0) = o;
            if (i < 7) { u32x4 wa = (u32x4){0u, 0u, 0u, 0u}, wd = wa;
#pragma unroll
                for (int k = 0; k < 4; ++k) { const int h2 = 1 << k; if (hw == h2) { wa = rw[8 + i + h2]; wd = rw[8 + i - h2]; } }
                sum[0] += bf_lo(wa.x) - bf_lo(wd.x); sum[1] += bf_hi(wa.x) - bf_hi(wd.x); sum[2] += bf_lo(wa.y) - bf_lo(wd.y); sum[3] += bf_hi(wa.y) - bf_hi(wd.y);
                sum[4] += bf_lo(wa.z) - bf_lo(wd.z); sum[5] += bf_hi(wa.z) - bf_hi(wd.z); sum[6] += bf_lo(wa.w) - bf_lo(wd.w); sum[7] += bf_hi(wa.w) - bf_hi(wd.w); } }
    }
}

constexpr int ATT_KSTR = 272, ATT_VSTR = 520, ATT_VOFF = 256 * ATT_KSTR;
__device__ __forceinline__ void attn_unit(const Args& a, LAS unsigned char* lds, int b, int h, int qb, int wave, int lane, int tid) {
    const bf16_t* ZM = (const bf16_t*)(a.ws + WS_ZM); const bf16_t* KM = (const bf16_t*)(a.ws + WS_KMEM); const bf16_t* VT = (const bf16_t*)(a.ws + WS_VT); bf16_t* AC = (bf16_t*)(a.ws + WS_ACAT);
    const int l31 = lane & 31, hh = lane >> 5;
#pragma unroll
    for (int i = 0; i < 8; ++i) { const int ch = tid + 512 * i, row = ch >> 4, cc = ch & 15;
        const u32x4 v = *(const u32x4*)(KM + (size_t)(b * MEML + row) * 512 + h * 128 + 8 * cc);
        *(LAS u32x4*)(lds + row * ATT_KSTR + 16 * cc) = v; }
#pragma unroll
    for (int i = 0; i < 8; ++i) { const int ch = tid + 512 * i, row = ch >> 5, cc = ch & 31;
        const u32x4 v = *(const u32x4*)(VT + (size_t)(h * 128 + row) * 2048 + b * MEML + 8 * cc);
        LAS unsigned* d = (LAS unsigned*)(lds + ATT_VOFF + row * ATT_VSTR + 16 * cc); d[0] = v.x; d[1] = v.y; d[2] = v.z; d[3] = v.w; }
    const int t = b * SEQ + qb * 256 + wave * 32 + l31;
    bf16x8 qf[8];
    const bf16_t* qp = ZM + (size_t)t * 2048 + 1536 + h * 128 + 8 * hh;
#pragma unroll
    for (int ks = 0; ks < 8; ++ks) qf[ks] = *(const bf16x8*)(qp + 16 * ks);
    __syncthreads();
    f32x16 sc[8];
    const LAS unsigned char* kp = lds + l31 * ATT_KSTR + 16 * hh;
#pragma unroll
    for (int kt = 0; kt < 8; ++kt) { f32x16 acc;
#pragma unroll
        for (int r = 0; r < 16; ++r) acc[r] = 0.f;
#pragma unroll
        for (int ks = 0; ks < 8; ++ks) { const bf16x8 kf = *(const LAS bf16x8*)(kp + (32 * kt) * ATT_KSTR + 32 * ks); acc = __builtin_amdgcn_mfma_f32_32x32x16_bf16(kf, qf[ks], acc, 0, 0, 0); }
        sc[kt] = acc; }
    float mx = -3.0e38f;
#pragma unroll
    for (int kt = 0; kt < 8; ++kt)
#pragma unroll
        for (int r = 0; r < 16; ++r) mx = fmaxf(mx, sc[kt][r]);
    mx = fmaxf(mx, __shfl_xor(mx, 32));
    const float cs = 0.08838834764831845f * 1.44269504089f;
    float sum = 0.f;
#pragma unroll
    for (int kt = 0; kt < 8; ++kt)
#pragma unroll
        for (int r = 0; r < 16; ++r) { const float p = __builtin_amdgcn_exp2f((sc[kt][r] - mx) * cs); sc[kt][r] = p; sum += p; }
    sum += __shfl_xor(sum, 32);
    const float rinv = 1.0f / sum;
    bf16x8 pf[8][2];
#pragma unroll
    for (int kt = 0; kt < 8; ++kt)
#pragma unroll
        for (int s = 0; s < 2; ++s) { u32x4 w; w.x = cvt_pk_bf16(sc[kt][8 * s + 0], sc[kt][8 * s + 1]); w.y = cvt_pk_bf16(sc[kt][8 * s + 2], sc[kt][8 * s + 3]);
            w.z = cvt_pk_bf16(sc[kt][8 * s + 4], sc[kt][8 * s + 5]); w.w = cvt_pk_bf16(sc[kt][8 * s + 6], sc[kt][8 * s + 7]); pf[kt][s] = __builtin_bit_cast(bf16x8, w); }
#pragma unroll
    for (int dt = 0; dt < 4; ++dt) { f32x16 o;
#pragma unroll
        for (int r = 0; r < 16; ++r) o[r] = 0.f;
        const LAS unsigned char* vp = lds + ATT_VOFF + (32 * dt + l31) * ATT_VSTR + 8 * hh;
#pragma unroll
        for (int kt = 0; kt < 8; ++kt)
#pragma unroll
            for (int s = 0; s < 2; ++s) { const u32x2 v0 = *(const LAS u32x2*)(vp + 64 * kt + 32 * s), v1 = *(const LAS u32x2*)(vp + 64 * kt + 32 * s + 16);
                const u32x4 vv = (u32x4){v0.x, v0.y, v1.x, v1.y};
                o = __builtin_amdgcn_mfma_f32_32x32x16_bf16(__builtin_bit_cast(bf16x8, vv), pf[kt][s], o, 0, 0, 0); }
        bf16_t* op = AC + (size_t)t * CAT_LD + 2048 + h * 128 + 32 * dt + 4 * hh;
#pragma unroll
        for (int rg = 0; rg < 4; ++rg) { u32x2 w; w.x = cvt_pk_bf16(o[4 * rg + 0] * rinv, o[4 * rg + 1] * rinv); w.y = cvt_pk_bf16(o[4 * rg + 2] * rinv, o[4 * rg + 3] * rinv);
            *(u32x2*)(op + 8 * rg) = w; } }
    __syncthreads();
}

__device__ __forceinline__ void router_phase(const Args& a, LAS unsigned char* lds, int vcu, int G, int wave, int lane, int tid) {
    const bf16_t* X1 = (const bf16_t*)(a.ws + WS_X1B); const bf16_t* GWT = (const bf16_t*)(a.ws + WS_GWT); unsigned char* H2 = (unsigned char*)(a.ws + WS_H2); float* AFF = (float*)(a.ws + WS_AFF);
    LAS float* part = (LAS float*)lds;
    LAS float* ssq = (LAS float*)(lds + 32768);
    LAS float* invs = (LAS float*)(lds + 32768 + 2048);
    const int fr = lane & 15, fq = lane >> 4;
    bf16x8 bfrag[8];
#pragma unroll
    for (int ks = 0; ks < 8; ++ks) bfrag[ks] = *(const bf16x8*)(GWT + (size_t)fr * 2048 + 256 * wave + 32 * ks + 8 * fq);
    f32x4 gg[8];
#pragma unroll
    for (int j = 0; j < 8; ++j) gg[j] = ((const f32x4*)a.norm_ffn_g)[64 * j + lane];
    STAMPN(6, 2);
    for (int blk = vcu; blk < T / 64; blk += G) { const int row0 = blk * 64;
#pragma unroll
        for (int rt = 0; rt < 4; ++rt) { f32x4 acc = (f32x4){0.f, 0.f, 0.f, 0.f}; float sq = 0.f;
            const bf16_t* xp = X1 + (size_t)(row0 + 16 * rt + fr) * DM + 256 * wave + 8 * fq;
            bf16x8 af[8];
#pragma unroll
            for (int ks = 0; ks < 8; ++ks) af[ks] = *(const bf16x8*)(xp + 32 * ks);
#pragma unroll
            for (int ks = 0; ks < 8; ++ks) { acc = __builtin_amdgcn_mfma_f32_16x16x32_bf16(af[ks], bfrag[ks], acc, 0, 0, 0);
                const u32x4 w = __builtin_bit_cast(u32x4, af[ks]);
                const float v0 = bf_lo(w.x), v1 = bf_hi(w.x), v2 = bf_lo(w.y), v3 = bf_hi(w.y), v4 = bf_lo(w.z), v5 = bf_hi(w.z), v6 = bf_lo(w.w), v7 = bf_hi(w.w);
                sq += (v0 * v0 + v1 * v1) + (v2 * v2 + v3 * v3) + (v4 * v4 + v5 * v5) + (v6 * v6 + v7 * v7); }
            sq += __shfl_xor(sq, 16); sq += __shfl_xor(sq, 32);
            if (fq == 0) ssq[wave * 64 + 16 * rt + fr] = sq;
#pragma unroll
            for (int j = 0; j < 4; ++j) part[(wave * 64 + 16 * rt + 4 * fq + j) * 16 + fr] = acc[j]; }
        __syncthreads(); STAMPN(6, 3);
#pragma unroll
        for (int ps = 0; ps < 2; ++ps) { const int row = 32 * ps + (tid >> 4), e = tid & 15;
            float s = 0.f, q = 0.f;
#pragma unroll
            for (int w = 0; w < 8; ++w) { s += part[(w * 64 + row) * 16 + e]; q += ssq[w * 64 + row]; }
            const float inv = 1.0f / sqrtf(q * (1.f / DM) + EPS), lg = s * inv;
            float mx = lg;
#pragma unroll
            for (int o = 1; o < 16; o <<= 1) mx = fmaxf(mx, __shfl_xor(mx, o));
            const float ex = __expf(lg - mx); float su = ex;
#pragma unroll
            for (int o = 1; o < 16; o <<= 1) su += __shfl_xor(su, o);
            const int t = row0 + row, b = t >> 11, sx = t & 2047;
            AFF[((size_t)b * 16 + e) * SEQ + sx] = ex / su;
            if (e == 0) invs[row] = inv; }
        __syncthreads(); STAMPN(6, 4);
#pragma unroll 2
        for (int r = 0; r < 8; ++r) { const int row = 8 * wave + r; const float inv = invs[row] * SC_H8;
            const u32x2* xr = (const u32x2*)(X1 + (size_t)(row0 + row) * DM) + lane; unsigned* hr = (unsigned*)(H2 + (size_t)(row0 + row) * DM) + lane;
#pragma unroll
            for (int j = 0; j < 8; ++j) { const u32x2 w = xr[64 * j];
                hr[64 * j] = cvt4_fp8(bf_lo(w.x) * inv * gg[j].x, bf_hi(w.x) * inv * gg[j].y, bf_lo(w.y) * inv * gg[j].z, bf_hi(w.y) * inv * gg[j].w); } }
        __syncthreads();
    }
}

__device__ __forceinline__ int wave_isum(int v) {
#pragma unroll
    for (int o = 1; o < 64; o <<= 1) v += __shfl_xor(v, o);
    return v;
}
__device__ __forceinline__ int wave_excl_scan(int v, int ln) {
    int x = v;
#pragma unroll
    for (int o = 1; o < 64; o <<= 1) { const int y = __shfl(x, (ln - o) & 63); x += (ln >= o) ? y : 0; }
    return x - v;
}
__device__ __forceinline__ void topk_phase(const Args& a, LAS unsigned char* lds, int c, int wave, int ln, int tid) {
    if (c >= 128) return;
    const int b = c & 7, e = c >> 3;
    LAS int* list = (LAS int*)(lds + 1024);
    const float* AFF = (const float*)(a.ws + WS_AFF) + ((size_t)b * 16 + e) * SEQ;
    unsigned u[32];
#pragma unroll
    for (int i = 0; i < 8; ++i) { const u32x4 w = *(const u32x4*)(AFF + 32 * ln + 4 * i); u[4 * i] = w.x; u[4 * i + 1] = w.y; u[4 * i + 2] = w.z; u[4 * i + 3] = w.w; }
    unsigned Tv = 0u;
#pragma unroll 1
    for (int bit = 30; bit >= 0; --bit) { const unsigned cand = Tv | (1u << bit);
        int lc = 0;
#pragma unroll
        for (int i = 0; i < 32; ++i) lc += (u[i] >= cand) ? 1 : 0;
        if (wave_isum(lc) >= CAP) Tv = cand; }
    int ngt_l = 0, ntie_l = 0;
#pragma unroll
    for (int i = 0; i < 32; ++i) { ngt_l += (u[i] > Tv) ? 1 : 0; ntie_l += (u[i] == Tv) ? 1 : 0; }
    const int need = CAP - wave_isum(ngt_l);
    int tr = wave_excl_scan(ntie_l, ln);
    unsigned selmask = 0u; int nsel_l = 0;
#pragma unroll
    for (int i = 0; i < 32; ++i) { const bool t = (u[i] == Tv); const bool s = (u[i] > Tv) || (t && tr < need); tr += t ? 1 : 0; selmask |= s ? (1u << i) : 0u; nsel_l += s ? 1 : 0; }
    int slot = wave_excl_scan(nsel_l, ln);
    int* INV = (int*)(a.ws + WS_INV); float* SELW = (float*)(a.ws + WS_SELW);
    if ((ln >> 3) == wave) {
#pragma unroll
        for (int i = 0; i < 32; ++i) { const int s = 32 * ln + i; const bool sl = (selmask >> i) & 1u;
            INV[((size_t)b * SEQ + s) * 16 + e] = sl ? slot : -1;
            if (sl) { list[slot] = s; SELW[((size_t)e * 8 + b) * CAP + slot] = __builtin_bit_cast(float, u[i]); ++slot; } }
    }
    __syncthreads();
    const unsigned char* H2 = (const unsigned char*)(a.ws + WS_H2); unsigned char* XIN = (unsigned char*)(a.ws + WS_XIN);
    for (int q = 0; q < CAP / NWAVES; q += 8) {
        u32x4 v[8][2];
#pragma unroll
        for (int i = 0; i < 8; ++i) { const int s = list[wave + NWAVES * (q + i)];
            const u32x4* src = (const u32x4*)(H2 + ((size_t)b * SEQ + s) * DM) + ln; v[i][0] = src[0]; v[i][1] = src[64]; }
#pragma unroll
        for (int i = 0; i < 8; ++i) { const int slot2 = wave + NWAVES * (q + i);
            u32x4* dst = (u32x4*)(XIN + (((size_t)e * 8 + b) * CAP + slot2) * DM) + ln; dst[0] = v[i][0]; dst[64] = v[i][1]; }
    }
    __syncthreads();
}

__device__ __forceinline__ void combine_phase(const Args& a, int gw, int NGW, int lane) {
    const bf16_t* Y = (const bf16_t*)(a.ws + WS_Y); const int* INV = (const int*)(a.ws + WS_INV);
    for (int t = gw; t < T; t += NGW) { const int b = t >> 11;
        float* xr = a.out + (size_t)t * DM; const u32x2* x1r = (const u32x2*)((const bf16_t*)(a.ws + WS_X1B) + (size_t)t * DM);
        f32x4 v[8];
#pragma unroll
        for (int j = 0; j < 8; ++j) { const u32x2 w = x1r[64 * j + lane]; v[j] = (f32x4){bf_lo(w.x), bf_hi(w.x), bf_lo(w.y), bf_hi(w.y)}; }
        const int myinv = DBG_SKIP_MOE ? -1 : INV[(size_t)t * 16 + (lane & 15)];
        for (int e = 0; e < 16; ++e) { const int slot = __shfl(myinv, e);
            if (slot >= 0) { const u32x2* yr = (const u32x2*)(Y + (((size_t)e * 8 + b) * CAP + slot) * DM);
#pragma unroll
                for (int j = 0; j < 8; ++j) { const u32x2 w = yr[64 * j + lane]; v[j].x += bf_lo(w.x); v[j].y += bf_hi(w.x); v[j].z += bf_lo(w.y); v[j].w += bf_hi(w.y); } } }
        float s = 0.f;
#pragma unroll
        for (int j = 0; j < 8; ++j) s += (v[j].x * v[j].x + v[j].y * v[j].y) + (v[j].z * v[j].z + v[j].w * v[j].w);
        const float inv = 1.0f / sqrtf(wave_sum(s) * (1.f / DM) + EPS);
#pragma unroll
        for (int j = 0; j < 8; ++j) { const f32x4 gg = ((const f32x4*)a.norm_final_g)[64 * j + lane]; ((f32x4*)xr)[64 * j + lane] = v[j] * inv * gg; }
    }
}

using pg8::Unit;
struct SchedFold {
    unsigned char* ws; int c;
    __device__ __forceinline__ bool next(int i, Unit& u) const {
        if (i > 0 || c >= 64) return false;
        const int L = c & 31, pm = L & 7, pn = L >> 3;
        if (c < 32) { u.A = (const char*)(ws + WS_PPST) + (size_t)pm * 256 * 1024 * 2; u.B0 = (const char*)(ws + WS_PWBD) + (size_t)pn * 256 * 1024 * 2; u.nt = 16; u.c0 = pn * 256; }
        else { u.A = (const char*)(ws + WS_PFT) + (size_t)pm * 256 * 1024 * 2; u.B0 = (const char*)(ws + WS_M1BD) + (size_t)pn * 256 * 1024 * 2; u.nt = 8; u.c0 = 1024 + pn * 256; }
        u.r0 = pm * 256; u.aux = 0; return true;
    }
};
struct SchedKV {
    unsigned char* ws; int c;
    __device__ __forceinline__ bool next(int i, Unit& u) const {
        if (i > 0 || c < 64 || c >= 96) return false;
        const int L = c - 64; u.nt = 32;
        if (L < 16) { const int pm = L & 7, pn = L >> 3; u.A = (const char*)(ws + WS_MN) + (size_t)pm * 256 * 2048 * 2; u.B0 = (const char*)(ws + WS_WKVT) + (size_t)pn * 256 * 2048 * 2; u.r0 = pm * 256; u.c0 = pn * 256; u.aux = 0; }
        else { const int L2 = L - 16, pm = L2 & 1, pn = L2 >> 1; u.A = (const char*)(ws + WS_WKVT) + (size_t)(512 + pm * 256) * 2048 * 2; u.B0 = (const char*)(ws + WS_MN) + (size_t)pn * 256 * 2048 * 2; u.r0 = pm * 256; u.c0 = pn * 256; u.aux = 1; }
        return true;
    }
};
struct EpiKV {
    static __device__ __forceinline__ bool keep_acc(const Unit&) { return false; }
    bf16_t* KM; bf16_t* VT;
    __device__ __forceinline__ void operator()(const f32x4 (&acc)[2][2][4][2], const Unit& u, int wr, int wc, int fr, int fq) const {
        pg8::EpiBf16 E{u.aux ? VT : KM, u.aux ? 2048 : 512, nullptr, 1.f}; E(acc, u, wr, wc, fr, fq);
    }
};
struct SchedTiles {
    const char* A; const char* B; int lda, ldb, nM, nN, nt, G, c, ibeg, iend, esz;
    __device__ __forceinline__ bool next(int i0, Unit& u) const {
        const int i = i0 + ibeg; if (i >= iend) return false;
        const int L = i * G + c; if (L >= nM * nN) return false;
        int pm, pn; pg8::tile_order(L, nM, nN, pm, pn);
        u.A = A + (size_t)pm * 256 * lda * esz; u.B0 = B + (size_t)pn * 256 * ldb * esz; u.nt = nt; u.r0 = pm * 256; u.c0 = pn * 256; u.aux = 0; return true;
    }
};
struct SchedDFT {
    unsigned char* ws; int c;
    __device__ __forceinline__ bool next(int i, Unit& u) const {
        if (i > 0 || c >= 256) return false;
        const int b = c & 7, j = c >> 3, pm = j & 15, pn = j >> 4;
        u.A = (const char*)(ws + WS_TW) + (size_t)pm * 256 * 2048 * 2; u.B0 = (const char*)(ws + WS_UT) + (size_t)(b * 512 + pn * 256) * 2048 * 2; u.nt = 32;
        u.r0 = b * SEQ + (pm & 7) * 256; u.c0 = 1024 + (pm >> 3) * 512 + pn * 256; u.aux = 0; return true;
    }
};
struct SchedProj {
    unsigned char* ws; int G, c;
    __device__ __forceinline__ bool next(int i, Unit& u) const {
        const int ti = i / 3, si = i - 3 * ti, rot = 0, s = (si + rot) % 3; const int L = ti * G + c; if (L >= 512) return false;
        int pm, pn; pg8::tile_order(L, 64, 8, pm, pn);
        const size_t co = (size_t)s * 1024 * 2;
        u.A = (const char*)(ws + WS_ACAT) + (size_t)pm * 256 * CAT_LD * 2 + co; u.B0 = (const char*)(ws + WS_BCAT) + (size_t)pn * 256 * CAT_LD * 2 + co;
        u.nt = s == 2 ? 8 : 16; u.r0 = pm * 256; u.c0 = pn * 256; u.aux = s | (((si + 1 + rot) % 3) << 2) | (si == 2 ? 32 : 0); return true;
    }
};
struct SchedGU {
    unsigned char* ws; int G, c;
    __device__ __forceinline__ bool next(int i, Unit& u) const {
        const int L = i * G + c; if (L >= 2048) return false;
        const int e = L >> 7, j = L & 127, x = j & 7, q = j >> 3, pm = q & 7, pn = 2 * x + (q >> 3);
        u.A = (const char*)(ws + WS_XIN) + (size_t)(e * 8 + pm) * 256 * 2048; u.B0 = (const char*)(ws + WS_WGUT) + ((size_t)e * 4096 + pn * 256) * 2048;
        u.nt = 16; u.r0 = (e * 8 + pm) * 256; u.c0 = pn * 128; u.aux = 0; return true;
    }
};
struct SchedDown {
    unsigned char* ws; int G, c;
    __device__ __forceinline__ bool next(int i, Unit& u) const {
        const int L = i * G + c; if (L >= 1024) return false;
        const int e = L >> 6, j = L & 63, pn = j & 7, pm = j >> 3;
        u.A = (const char*)(ws + WS_HID) + (size_t)(e * 8 + pm) * 256 * 2048; u.B0 = (const char*)(ws + WS_WDT) + ((size_t)e * 2048 + pn * 256) * 2048;
        u.nt = 16; u.r0 = (e * 8 + pm) * 256; u.c0 = pn * 256; u.aux = 0; return true;
    }
};

__global__ void __launch_bounds__(NTHR, 2) fwd_kernel(Args a) {
    extern __shared__ __attribute__((aligned(16))) unsigned char lds_raw[];
    LAS unsigned char* lds = (LAS unsigned char*)lds_raw;
    const int tid = threadIdx.x, wave = __builtin_amdgcn_readfirstlane(tid >> 6);
#define lane opaque_lane()
    const int G = gridDim.x, c = blockIdx.x;
    const int vcu = (G % 8 == 0) ? (c % 8) * (G / 8) + c / 8 : c;
    const int gw = vcu * NWAVES + wave, NGW = G * NWAVES;
    unsigned char* ws = a.ws;
    const int lo = a.ph_lo, hi = a.ph_hi;
#define IN(k) (lo <= (k) && (k) < hi)
    volatile LAS unsigned* bst = (volatile LAS unsigned*)(lds + 143360);
    if (tid < 64) ((LAS unsigned*)(lds + 143360))[tid] = 0u;
    if (tid < 256) ((LAS unsigned*)(lds + STAMP_BASE))[tid] = 0u;
    __syncthreads();
    XcdBarrier gbar = xcd_barrier_post((unsigned*)(ws + WS_CTL) + 4096, bst);
#define SEAM(k) do { if (IN(k) && IN((k) + 1)) { xcd_barrier(gbar); } STAMPN(k, 6); if (PROBE_PHASE == (k)) { STAMP(7); if (tid == 0) STAMP_EN() = 0u; } if (PROBE_PHASE == (k) + 1 && tid == 0) STAMP_EN() = 1u; } while (0)

#define PH0 if (IN(0)) { phase0(a, lds, gw, NGW, wave, lane); __syncthreads(); }
    PH0
    if (PROBE_REP == 0) { xcd_barrier(gbar); PH0 }
    SEAM(0);
    if (PROBE_PHASE == 2 && tid == 0) STAMP_EN() = 1u;
#define PH2 \
    if (!DBG_P5_FROM_XN && IN(2)) { \
          \
          \
        { SchedFold S{ws, c}; pg8::EpiBf16 E{(bf16_t*)(ws + WS_BCAT), CAT_LD, nullptr, 1.f}; pg8::gemm_phase<false, (PROBE_PHASE == 2)>(lds, 2048, 2048, S, E); } \
        { SchedKV S{ws, c}; EpiKV E{(bf16_t*)(ws + WS_KMEM), (bf16_t*)(ws + WS_VT)}; pg8::gemm_phase<false, (PROBE_PHASE == 2)>(lds, 4096, 4096, S, E); } \
        { SchedTiles S{(const char*)(ws + WS_XN), (const char*)(ws + WS_WINT), 2048, 2048, 64, 8, 32, G, c, 0, 1 << 20, 2}; pg8::EpiZ E{(bf16_t*)(ws + WS_ZM), (bf16_t*)(ws + WS_UT)}; pg8::gemm_phase<false, (PROBE_PHASE == 2)>(lds, 4096, 4096, S, E); } \
        const int csplit = 2 * ((c >> 3) & 3); \
        pg8::EpiGates8 E8{(bf16_t*)(ws + WS_G), 1.0f / (SC_H8 * SC_W8)}; \
        { SchedTiles S{(const char*)(ws + WS_XN8), (const char*)(ws + WS_WIN8), 2048, 2048, 64, 24, 16, G, c, 0, csplit, 1}; pg8::gemm_phase<true, (PROBE_PHASE == 2)>(lds, 2048, 2048, S, E8); } \
        STAMP(8); convert_experts(a, c, G, wave, lane); STAMP(9); \
        { SchedTiles S{(const char*)(ws + WS_XN8), (const char*)(ws + WS_WIN8), 2048, 2048, 64, 24, 16, G, c, csplit, 1 << 20, 1}; pg8::gemm_phase<true, (PROBE_PHASE == 2)>(lds, 2048, 2048, S, E8); } \
    }
    PH2
    if (PROBE_REP == 2) { xcd_barrier(gbar); PH2 }
    SEAM(2);
#define PH3 \
    if (!DBG_P5_FROM_XN && IN(3)) { \
        STAMPN(3, 0); { SchedDFT S{ws, c}; pg8::EpiBf16 E{(bf16_t*)(ws + WS_ACAT), CAT_LD, nullptr, 1.f}; pg8::gemm_phase<false, (PROBE_PHASE == 3)>(lds, 4096, 4096, S, E); } STAMPN(3, 1); \
        if (c < 256) { const int b = c & 7, j = c >> 3; attn_unit(a, lds, b, j & 3, j >> 2, wave, lane, tid); } STAMPN(3, 2); \
        pool_pass(a, gw, NGW, lane); STAMPN(3, 3); \
    }
    PH3
    if (PROBE_REP == 3) { xcd_barrier(gbar); PH3 }
    SEAM(3);
#define PH4 \
    if (!DBG_P5_FROM_XN && IN(4)) { SchedProj S{ws, G, c}; pg8::EpiGate E{(bf16_t*)(ws + WS_MG), (const bf16_t*)(ws + WS_G)}; pg8::gemm_phase<false, (PROBE_PHASE == 4)>(lds, 2 * CAT_LD, 2 * CAT_LD, S, E); }
    PH4
    if (PROBE_REP == 4) { xcd_barrier(gbar); PH4 }
    SEAM(4);
#define PH5 \
    if (IN(5)) { \
        SchedTiles S{(const char*)(ws + (DBG_P5_FROM_XN ? WS_XN : WS_MG)), (const char*)(ws + WS_WOT), 2048, 2048, 64, 8, 32, G, c, 0, 1 << 20, 2}; \
        pg8::EpiResid E{a.x, (bf16_t*)(ws + WS_X1B)}; pg8::gemm_phase<false, (PROBE_PHASE == 5)>(lds, 4096, 4096, S, E); \
    }
    PH5
    if (PROBE_REP == 5) { xcd_barrier(gbar); PH5 }
    SEAM(5);
#define PH6 \
    if (!DBG_SKIP_MOE && IN(6)) { STAMPN(6, 0); router_phase(a, lds, vcu, G, wave, lane, tid); __syncthreads(); STAMPN(6, 1); }
    PH6
    if (PROBE_REP == 6) { xcd_barrier(gbar); PH6 }
    SEAM(6);
#define PH7 \
    if (!DBG_SKIP_MOE && IN(7)) { STAMPN(7, 0); topk_phase(a, lds, c, wave, lane, tid); STAMPN(7, 1); }
    PH7
    if (PROBE_REP == 7) { xcd_barrier(gbar); PH7 }
    SEAM(7);
#define PH8 \
    if (!DBG_SKIP_MOE && IN(8)) { SchedGU S{ws, G, c}; pg8::EpiSwiGLU8 E{(unsigned char*)(ws + WS_HID), 1.0f / (SC_H8 * SC_W8)}; pg8::gemm_phase<true, (PROBE_PHASE == 8)>(lds, 2048, 2048, S, E); }
    PH8
    if (PROBE_REP == 8) { xcd_barrier(gbar); PH8 }
    SEAM(8);
#define PH9 \
    if (!DBG_SKIP_MOE && IN(9)) { SchedDown S{ws, G, c}; pg8::EpiBf16 E{(bf16_t*)(ws + WS_Y), 2048, (const float*)(ws + WS_SELW), 1.0f / (SC_HID8 * SC_W8)}; pg8::gemm_phase<true, (PROBE_PHASE == 9)>(lds, 2048, 2048, S, E); }
    PH9
    if (PROBE_REP == 9) { xcd_barrier(gbar); PH9 }
    SEAM(9);
    STAMPN(10, 0); if (IN(10)) combine_phase(a, gw, NGW, lane); STAMPN(10, 1);
    if (PROBE_A >= 0 && blockIdx.x == PROBE_BLK && tid == 0) { const volatile LAS unsigned long long* st = (const volatile LAS unsigned long long*)(unsigned)STAMP_BASE;
        const unsigned long long d = (st[PROBE_A] - st[PROBE_B]) * PROBE_SCALE, t0 = __builtin_amdgcn_s_memrealtime();
        if (d < 100000000ull) while (__builtin_amdgcn_s_memrealtime() - t0 < d) __builtin_amdgcn_s_sleep(8); }
#undef IN
#undef SEAM
#undef lane
}

extern "C" void kernel_launch(void* const* d_in, const int* in_sizes, int n_in, void* d_out, int out_size, void* d_ws, size_t ws_size, hipStream_t stream) {
    static int grid = 0;
    if (grid == 0) {
        if (n_in != 19 || in_sizes[0] != T * DM || out_size != T * DM || ws_size < WS_END) {
            fprintf(stderr, "kernel_launch: unexpected shapes (n_in %d, in0 %d, out %d, ws %zu, need %zu); nothing launched\n", n_in, n_in > 0 ? in_sizes[0] : -1, out_size, ws_size, (size_t)WS_END); grid = -1; return; }
        int dev = 0, cus = 0, per_cu = 0;
        if (hipGetDevice(&dev) != hipSuccess || hipDeviceGetAttribute(&cus, hipDeviceAttributeMultiprocessorCount, dev) != hipSuccess) { fprintf(stderr, "kernel_launch: device query failed\n"); grid = -1; return; }
        if (hipFuncSetAttribute((const void*)fwd_kernel, hipFuncAttributeMaxDynamicSharedMemorySize, LDS_BYTES) != hipSuccess) { fprintf(stderr, "kernel_launch: hipFuncSetAttribute failed\n"); grid = -1; return; }
        if (hipOccupancyMaxActiveBlocksPerMultiprocessor(&per_cu, (const void*)fwd_kernel, NTHR, LDS_BYTES) != hipSuccess || per_cu < 1) { fprintf(stderr, "kernel_launch: occupancy query says %d blocks per CU\n", per_cu); (void)hipGetLastError(); grid = -1; return; }
        grid = cus;
        if (grid < 256) fprintf(stderr, "kernel_launch: note: %d CUs (< 256): some single-round phases assume 256 workgroups\n", grid);
    }
    if (grid < 0) return;
    Args a{};
    a.x = (const float*)d_in[0]; a.mem = (const float*)d_in[1]; a.norm_mix_g = (const float*)d_in[2]; a.norm_mem_g = (const float*)d_in[3]; a.w_in = (const float*)d_in[4];
    a.pool_w = (const float*)d_in[5]; a.pool_scale = (const float*)d_in[6]; a.fourier_w = (const float*)d_in[7]; a.w_kv = (const float*)d_in[8]; a.proj_pool = (const float*)d_in[9];
    a.proj_fourier = (const float*)d_in[10]; a.proj_mem = (const float*)d_in[11]; a.w_out = (const float*)d_in[12]; a.norm_ffn_g = (const float*)d_in[13]; a.w_router = (const float*)d_in[14];
    a.w_gate = (const float*)d_in[15]; a.w_up = (const float*)d_in[16]; a.w_down = (const float*)d_in[17]; a.norm_final_g = (const float*)d_in[18];
    a.out = (float*)d_out; a.ws = (unsigned char*)d_ws;
#if MK_MULTI_LAUNCH
    for (int p = 0; p < NPH; ++p) { a.ph_lo = p; a.ph_hi = p + 1; hipLaunchKernelGGL(fwd_kernel, dim3(grid), dim3(NTHR), LDS_BYTES, stream, a); }
#else
    a.ph_lo = 0; a.ph_hi = NPH;
    if (hipMemsetAsync((char*)d_ws + WS_CTL, 0, 65536, stream) != hipSuccess) { fprintf(stderr, "kernel_launch: hipMemsetAsync failed\n"); return; }
    void* args[] = {&a};
    hipError_t e = hipLaunchCooperativeKernel((const void*)fwd_kernel, dim3(grid), dim3(NTHR), args, LDS_BYTES, stream);
    if (e != hipSuccess) fprintf(stderr, "kernel_launch: cooperative launch failed: %s (grid %d)\n", hipGetErrorString(e), grid);
#endif
}
```

```cpp
#include <hip/hip_runtime.h>
#include <hip/hip_cooperative_groups.h>
#include <cstdio>
#include <cstdint>
namespace cg = cooperative_groups;

#ifndef MK_MULTI_LAUNCH
#define MK_MULTI_LAUNCH 0
#endif

#ifndef PROBE_REP
#define PROBE_REP -1
#endif
#ifndef DBG_P5_FROM_XN
#define DBG_P5_FROM_XN 0
#endif
#ifndef DBG_ONLY_BRANCH
#define DBG_ONLY_BRANCH -1
#endif
#ifndef DBG_SKIP_MOE
#define DBG_SKIP_MOE 0
#endif
#define LAS __attribute__((address_space(3)))
#define GAS __attribute__((address_space(1)))
typedef unsigned short bf16_t;
typedef short bf16x8 __attribute__((ext_vector_type(8)));
typedef short s16x4 __attribute__((ext_vector_type(4)));
typedef float f32x2 __attribute__((ext_vector_type(2)));
typedef float f32x4 __attribute__((ext_vector_type(4)));
typedef float f32x16 __attribute__((ext_vector_type(16)));
typedef unsigned u32x2 __attribute__((ext_vector_type(2)));
typedef unsigned u32x4 __attribute__((ext_vector_type(4)));

constexpr int T = 16384, DM = 2048, NBATCH = 8, SEQ = 2048, MEML = 256;
constexpr int NE = 16, CAP = 256;
constexpr int CAT_LD = 2560;
constexpr float EPS = 1e-6f;
constexpr int NWAVES = 8, NTHR = 512;
constexpr int NPH = 11;

constexpr size_t MiB = 1u << 20;
constexpr size_t WS_CTL  = 0;
constexpr size_t WS_GWT  = 512 * 1024;
constexpr size_t WS_WINT = 1 * MiB;
constexpr size_t WS_WIN8 = 9 * MiB;
constexpr size_t WS_WKVT = 33 * MiB;
constexpr size_t WS_PPST = 37 * MiB;
constexpr size_t WS_PFT  = 41 * MiB;
constexpr size_t WS_PWBD = 45 * MiB;
constexpr size_t WS_M1BD = 47 * MiB;
constexpr size_t WS_BCAT = 49 * MiB;
constexpr size_t WS_WOT  = 60 * MiB;
constexpr size_t WS_TW   = 68 * MiB;
constexpr size_t WS_WGUT = 84 * MiB;
constexpr size_t WS_WDT  = 339 * MiB;
constexpr size_t WS_ACT  = 467 * MiB;
constexpr size_t WS_XN   = WS_ACT;
constexpr size_t WS_MN   = WS_ACT + 64 * MiB;
constexpr size_t WS_ZM   = WS_ACT + 72 * MiB;
constexpr size_t WS_G    = WS_ACT + 136 * MiB;
constexpr size_t WS_UT   = WS_ACT + 328 * MiB;
constexpr size_t WS_KMEM = WS_ACT + 344 * MiB;
constexpr size_t WS_VT   = WS_ACT + 346 * MiB;
constexpr size_t WS_ACAT = WS_ACT + 348 * MiB;
constexpr size_t WS_MG   = WS_ACT + 432 * MiB;
constexpr size_t WS_H2   = WS_ACT;
constexpr size_t WS_XIN  = WS_ACT + 32 * MiB;
constexpr size_t WS_Y    = WS_ACT + 96 * MiB;
constexpr size_t WS_HID  = WS_ACT + 224 * MiB;
constexpr size_t WS_AFF  = WS_ACT + 320 * MiB;
constexpr size_t WS_SELW = WS_ACT + 321 * MiB;
constexpr size_t WS_INV  = WS_ACT + 322 * MiB;
constexpr size_t WS_X1B  = WS_ACT + 352 * MiB;
constexpr size_t WS_XN8  = WS_ACT + 497 * MiB;
constexpr size_t WS_END  = WS_ACT + 529 * MiB;

constexpr int LDS_BYTES = 147456;

#define LDS_WAIT() asm volatile("s_waitcnt lgkmcnt(0)" ::: "memory")
#define VM_WAIT() asm volatile("s_waitcnt vmcnt(0)" ::: "memory")
__device__ __forceinline__ unsigned f2bf(float f) { unsigned u = __builtin_bit_cast(unsigned, f); return (u + 0x7fffu + ((u >> 16) & 1u)) >> 16; }
__device__ __forceinline__ unsigned pk2(float lo, float hi) { return f2bf(lo) | (f2bf(hi) << 16); }
typedef __bf16 bf16x2_t __attribute__((ext_vector_type(2)));
__device__ __forceinline__ unsigned cvt_pk_bf16(float lo, float hi) { const bf16x2_t v = __builtin_convertvector((f32x2){lo, hi}, bf16x2_t); return __builtin_bit_cast(unsigned, v); }
typedef int i32x8 __attribute__((ext_vector_type(8)));
__device__ __forceinline__ unsigned cvt4_fp8(float a, float b, float c, float d) {
    a = __builtin_fminf(__builtin_fmaxf(a, -448.f), 448.f); b = __builtin_fminf(__builtin_fmaxf(b, -448.f), 448.f);
    c = __builtin_fminf(__builtin_fmaxf(c, -448.f), 448.f); d = __builtin_fminf(__builtin_fmaxf(d, -448.f), 448.f);
    unsigned w = 0u; w = (unsigned)__builtin_amdgcn_cvt_pk_fp8_f32(a, b, (int)w, false); w = (unsigned)__builtin_amdgcn_cvt_pk_fp8_f32(c, d, (int)w, true); return w; }
constexpr float SC_W8 = 256.f, SC_H8 = 16.f, SC_HID8 = 8.f;
__device__ __forceinline__ float bf_lo(unsigned w) { return __builtin_bit_cast(float, w << 16); }
__device__ __forceinline__ float bf_hi(unsigned w) { return __builtin_bit_cast(float, w & 0xffff0000u); }
__device__ __forceinline__ int opaque_lane() { int t = threadIdx.x; asm volatile("" : "+v"(t)); return t & 63; }
__device__ __forceinline__ float wave_sum(float v) {
#pragma unroll
    for (int o = 1; o < 64; o <<= 1) v += __shfl_xor(v, o);
    return v;
}
__device__ __forceinline__ float fast_sigmoid(float v) { return __builtin_amdgcn_rcpf(1.0f + __builtin_amdgcn_exp2f(-1.44269504089f * v)); }


#ifndef PROBE_A
#define PROBE_A -1
#endif
#ifndef PROBE_B
#define PROBE_B 0
#endif
#ifndef PROBE_PHASE
#define PROBE_PHASE -1
#endif
#ifndef PROBE_BLK
#define PROBE_BLK 0
#endif
#define PROBE_SCALE 10
#define STAMP_BASE (143360 + 1024)
#define STAMP_EN() (((volatile LAS unsigned*)(unsigned)(STAMP_BASE + 512))[0])
#ifndef PROBE_NG
#define PROBE_NG 0
#endif
#define STAMPN(ph, i) do { if (PROBE_A >= 0 && PROBE_NG && PROBE_PHASE == (ph) && blockIdx.x == PROBE_BLK && threadIdx.x == 0) { ((volatile LAS unsigned long long*)(unsigned)STAMP_BASE)[i] = __builtin_amdgcn_s_memrealtime(); } } while (0)
#define STAMP0(i) STAMPN(0, i)
#define STAMPG(i) do { if constexpr (PRB) { STAMP(i); } } while (0)
#define STAMP(i) do { if (PROBE_A >= 0 && !PROBE_NG && blockIdx.x == PROBE_BLK && threadIdx.x == 0 && STAMP_EN()) { ((volatile LAS unsigned long long*)(unsigned)STAMP_BASE)[i] = __builtin_amdgcn_s_memrealtime(); } } while (0)

#define XB_TMO      128
#define XB_XCNT(j)  (256  + 64 * (j))
#define XB_XSUB(j)  (1280 + 64 * (j))
#define XB_XGEN(j)  (2304 + 64 * (j))
#define XB_TOP      3328
#define XB_TOPGEN   3392
#define XCD_BAR_WORDS 3456
#define XB_SPIN_CAP (1u << 18)
__device__ __forceinline__ unsigned xb_ld(unsigned* p)              { return __hip_atomic_load(p, __ATOMIC_RELAXED, __HIP_MEMORY_SCOPE_AGENT); }
__device__ __forceinline__ unsigned xb_add(unsigned* p, unsigned v) { return __hip_atomic_fetch_add(p, v, __ATOMIC_RELAXED, __HIP_MEMORY_SCOPE_AGENT); }
__device__ __forceinline__ unsigned xb_xcc_id() { return (unsigned)__builtin_amdgcn_s_getreg((3 << 11) | 20) & 0xFu; }
#define XB_SPIN(cond, bar) do { unsigned _sp = 0; while (cond) { __builtin_amdgcn_s_sleep(1); \
    if ((++_sp & 255u) == 0u) { if (xb_ld(&(bar)[XB_TMO])) break; if (_sp > XB_SPIN_CAP) { atomicAdd(&(bar)[XB_TMO], 1u); break; } } } } while (0)
struct XcdBarrier { unsigned* bar; unsigned x; volatile LAS unsigned* st; };
__device__ __forceinline__ XcdBarrier xcd_barrier_post(unsigned* bar, volatile LAS unsigned* st) {
    XcdBarrier b; b.bar = bar; b.x = xb_xcc_id(); b.st = st;
    if (threadIdx.x == 0) (void)xb_add(&bar[XB_XCNT(b.x)], 1u);
    return b;
}
__device__ __forceinline__ void xcd_barrier_complete(unsigned* bar, unsigned x, unsigned& nloc, unsigned& nx) {
    const unsigned G = gridDim.x * gridDim.y * gridDim.z;
    unsigned sum, cnt, mine, sp = 0u;
    for (;;) {
        sum = 0u; cnt = 0u; mine = 0u;
#pragma unroll
        for (unsigned j = 0; j < 16; ++j) { const unsigned c = xb_ld(&bar[XB_XCNT(j)]); sum += c; cnt += (c > 0u) ? 1u : 0u; mine = (j == x) ? c : mine; }
        if (sum == G) break;
        __builtin_amdgcn_s_sleep(1);
        if ((++sp & 255u) == 0u) { if (xb_ld(&bar[XB_TMO])) break; if (sp > XB_SPIN_CAP) { atomicAdd(&bar[XB_TMO], 1u); break; } }
    }
    nloc = mine > 0u ? mine : 1u; nx = cnt > 0u ? cnt : 1u;
}
__device__ __forceinline__ void xcd_barrier(const XcdBarrier& b) {
    asm volatile("s_waitcnt vmcnt(0)" ::: "memory");
    __syncthreads();
    if (threadIdx.x == 0) {
        unsigned* bar = b.bar;
        __builtin_amdgcn_s_waitcnt(0);
        unsigned nloc = b.st[0], nx = b.st[1];
        if (nloc == 0u) { xcd_barrier_complete(bar, b.x, nloc, nx); b.st[0] = nloc; b.st[1] = nx; }
        const unsigned old = xb_add(&bar[XB_XSUB(b.x)], 1u);
        const unsigned gen = old / nloc;
        if (old + 1u == (gen + 1u) * nloc) {
            __builtin_amdgcn_fence(__ATOMIC_RELEASE, "agent");
            asm volatile("s_waitcnt vmcnt(0)" ::: "memory");
            const unsigned og = xb_add(&bar[XB_TOP], 1u);
            const unsigned tg = og / nx;
            if (og + 1u == (tg + 1u) * nx) xb_add(&bar[XB_TOPGEN], 1u);
            else XB_SPIN(xb_ld(&bar[XB_TOPGEN]) == tg, bar);
            __builtin_amdgcn_fence(__ATOMIC_ACQUIRE, "agent");
            xb_add(&bar[XB_XGEN(b.x)], 1u);
            asm volatile("s_waitcnt vmcnt(0)" ::: "memory");
        } else {
            XB_SPIN(xb_ld(&bar[XB_XGEN(b.x)]) == gen, bar);
            __builtin_amdgcn_fence(__ATOMIC_ACQUIRE, "agent");
            asm volatile("s_waitcnt vmcnt(0)" ::: "memory");
        }
    }
    __syncthreads();
}

namespace pg8 {
typedef int i32x4v __attribute__((ext_vector_type(4)));
template <bool F8> struct FragT { bf16x8 bf[2]; };
template <> struct FragT<true> { i32x8 f8; };
constexpr int BM = 256, BK = 64, HALF = 128, HTB = HALF * BK * 2, STAGE_BYTES = 8 * HTB;
__device__ __forceinline__ int lds_byte(int r, int c) { const int st = (r >> 4) * 2 + (c >> 5), rr = r & 15, cc = c & 31, ob = rr * 64 + cc * 2; return st * 1024 + (ob ^ (((ob >> 9) & 1) << 5)); }
__device__ __forceinline__ void stage_rc(int b, int& R, int& C) { const int st = b / 1024, sb = b % 1024, swz = sb ^ (((sb >> 9) & 1) << 5); R = (st >> 1) * 16 + swz / 64; C = (st & 1) * 32 + (swz % 64) / 2; }
__device__ __forceinline__ int perm32(int rho) { const int n = rho >> 4, i = rho & 15; return 8 * (i >> 2) + 4 * n + (i & 3); }

struct Unit { const char* A; const char* B0; int nt; int r0, c0, aux; };

__device__ __forceinline__ void tile_order(int L, int nM, int nN, int& pm, int& pn) {
    const int nwg = nM * nN;
    int wgid = L; { const int q = nwg / 8, r = nwg % 8, xcd = wgid % 8, off = wgid / 8; wgid = (xcd < r ? xcd * (q + 1) : r * (q + 1) + (xcd - r) * q) + off; }
    const int nig = 8 * nN, gid = wgid / nig, fm = gid * 8, gsz = (nM - fm) < 8 ? (nM - fm) : 8;
    pm = fm + ((wgid % nig) % gsz); pn = (wgid % nig) / gsz;
}

template <bool FP8, bool PRB = false, class Epi, class Sched>
__device__ __forceinline__ void gemm_phase(LAS unsigned char* lds, const int lda, const int ldb, const Sched& S, const Epi& E) {
    int tid = threadIdx.x; asm volatile("" : "+v"(tid));
    const int wid = __builtin_amdgcn_readfirstlane(tid >> 6), lane = tid & 63, wr = wid >> 2, wc = wid & 3, fr = lane & 15, fq = lane >> 4;
    unsigned voffA[2], voffB[2];
#pragma unroll
    for (int i = 0; i < 2; ++i) { int R, C; stage_rc(tid * 16 + i * 8192, R, C); const int Rb = (R & ~31) + perm32(R & 31);
        voffA[i] = (unsigned)(R * lda + C * 2); voffB[i] = (unsigned)(Rb * ldb + C * 2); }
    const size_t kstep = (size_t)(BK * 2);
    const size_t hstepA = (size_t)HALF * lda, hstepB = (size_t)HALF * ldb;
    const unsigned ldsw = (unsigned)wid * 1024u;
    const int aoff = lds_byte(wr * 64 + fr, FP8 ? fq * 16 : fq * 8), boff = lds_byte(wc * 32 + fr, FP8 ? fq * 16 : fq * 8);
#define PG8_SA(b, h) (((b) * 2 + (h)) * HTB)
#define PG8_SB(b, h) ((4 + (b) * 2 + (h)) * HTB)
#define PG8_STAGE(bufoff, gbase, voff) do { const char* _gb = (const char*)(gbase); asm volatile("" : "+s"(_gb)); _Pragma("unroll") for (int _i = 0; _i < 2; ++_i) { \
        unsigned _vo = (voff)[_i]; asm volatile("" : "+v"(_vo)); \
        __builtin_amdgcn_global_load_lds((const unsigned*)(_gb + _vo), (LAS unsigned*)(lds + (bufoff) + ldsw + _i * 8192), 16, 0, 0); } } while (0)
#define PG8_LDA(dst, b, h) do { _Pragma("unroll") for (int m = 0; m < 4; ++m) { if constexpr (FP8) { \
            const i32x4v lo_ = *(const LAS i32x4v*)(lds + PG8_SA(b, h) + aoff + m * 2048), hi_ = *(const LAS i32x4v*)(lds + PG8_SA(b, h) + aoff + m * 2048 + 16); \
            dst[m].f8 = __builtin_shufflevector(lo_, hi_, 0, 1, 2, 3, 4, 5, 6, 7); } \
        else { _Pragma("unroll") for (int k = 0; k < 2; ++k) dst[m].bf[k] = *(const LAS bf16x8*)(lds + PG8_SA(b, h) + aoff + m * 2048 + k * 1024); } } } while (0)
#define PG8_LDB(dst, b, h) do { _Pragma("unroll") for (int n = 0; n < 2; ++n) { if constexpr (FP8) { \
            const i32x4v lo_ = *(const LAS i32x4v*)(lds + PG8_SB(b, h) + boff + n * 2048), hi_ = *(const LAS i32x4v*)(lds + PG8_SB(b, h) + boff + n * 2048 + 16); \
            dst[n].f8 = __builtin_shufflevector(lo_, hi_, 0, 1, 2, 3, 4, 5, 6, 7); } \
        else { _Pragma("unroll") for (int k = 0; k < 2; ++k) dst[n].bf[k] = *(const LAS bf16x8*)(lds + PG8_SB(b, h) + boff + n * 2048 + k * 1024); } } } while (0)
#define PG8_MMA(ai, bj, At, Bt) do { __builtin_amdgcn_s_setprio(1); _Pragma("unroll") for (int m = 0; m < 4; ++m) _Pragma("unroll") for (int n = 0; n < 2; ++n) { \
        if constexpr (FP8) acc[ai][bj][m][n] = __builtin_amdgcn_mfma_scale_f32_16x16x128_f8f6f4(Bt[n].f8, At[m].f8, acc[ai][bj][m][n], 0, 0, 0, 0x7F7F7F7F, 0, 0x7F7F7F7F); \
        else { _Pragma("unroll") for (int k = 0; k < 2; ++k) acc[ai][bj][m][n] = __builtin_amdgcn_mfma_f32_16x16x32_bf16(Bt[n].bf[k], At[m].bf[k], acc[ai][bj][m][n], 0, 0, 0); } } \
        __builtin_amdgcn_s_setprio(0); } while (0)
#define PG8_WAIT_V(n) asm volatile("s_waitcnt vmcnt(" #n ")" ::: "memory")
#define PG8_WAIT_L(n) asm volatile("s_waitcnt lgkmcnt(" #n ")" ::: "memory")
#define PG8_BAR __builtin_amdgcn_s_barrier()
#define PG8_SCHED __builtin_amdgcn_sched_barrier(0)
    Unit cur, nxt; int ui = 0;
    STAMPG(0);
    if (!S.next(0, cur)) return;
    f32x4 acc[2][2][4][2];
#pragma unroll
    for (int a = 0; a < 2; ++a)
#pragma unroll
        for (int b = 0; b < 2; ++b)
#pragma unroll
            for (int m = 0; m < 4; ++m)
#pragma unroll
                for (int n = 0; n < 2; ++n) acc[a][b][m][n] = (f32x4){0.f, 0.f, 0.f, 0.f};
    FragT<FP8> At[4], B0[2], B1[2];
    const char* cA = cur.A; const char* cB0 = cur.B0;
    PG8_STAGE(PG8_SB(0, 0), cB0, voffB); PG8_STAGE(PG8_SB(0, 1), cB0 + hstepB, voffB); PG8_STAGE(PG8_SA(0, 0), cA, voffA); PG8_STAGE(PG8_SA(0, 1), cA + hstepA, voffA);
    if (wr == 1) PG8_BAR;
    PG8_WAIT_V(2); PG8_BAR;
    PG8_STAGE(PG8_SB(1, 0), cB0 + kstep, voffB); PG8_STAGE(PG8_SA(1, 0), cA + kstep, voffA); PG8_STAGE(PG8_SB(1, 1), cB0 + hstepB + kstep, voffB);
    PG8_WAIT_V(6); PG8_BAR;
    STAMPG(1);
    for (;;) {
        const bool has_next = S.next(ui + 1, nxt);
        const char* nA = has_next ? nxt.A : cA; const char* nB0 = has_next ? nxt.B0 : cB0;
        const int nt = cur.nt;
        for (int t = 0; t < nt; t += 2) {
            const bool last = (t == nt - 2);
            const char* a1 = cA + (size_t)(t + 1) * kstep;
            const char* a2 = last ? nA : cA + (size_t)(t + 2) * kstep;
            const char* b20 = last ? nB0 : cB0 + (size_t)(t + 2) * kstep; const char* b21 = b20 + hstepB;
            const char* a3 = a2 + kstep; const char* b30 = b20 + kstep; const char* b31 = b21 + kstep;
            PG8_LDB(B0, 0, 0); PG8_LDB(B1, 0, 1); PG8_SCHED; PG8_LDA(At, 0, 0); PG8_STAGE(PG8_SA(1, 1), a1 + hstepA, voffA);
            PG8_WAIT_V(8); PG8_WAIT_L(0); PG8_BAR; PG8_MMA(0, 0, At, B0); PG8_MMA(0, 1, At, B1); PG8_BAR; PG8_SCHED;
            PG8_LDA(At, 0, 1); PG8_STAGE(PG8_SB(0, 0), b20, voffB); PG8_STAGE(PG8_SB(0, 1), b21, voffB); PG8_STAGE(PG8_SA(0, 0), a2, voffA);
            PG8_WAIT_V(8); PG8_WAIT_L(0); PG8_BAR; PG8_MMA(1, 0, At, B0); PG8_MMA(1, 1, At, B1); PG8_BAR; PG8_SCHED;
            PG8_LDB(B0, 1, 0); PG8_LDB(B1, 1, 1); PG8_SCHED; PG8_LDA(At, 1, 0); PG8_STAGE(PG8_SA(0, 1), a2 + hstepA, voffA);
            PG8_WAIT_V(8); PG8_WAIT_L(0); PG8_BAR; PG8_MMA(0, 0, At, B0); PG8_MMA(0, 1, At, B1); PG8_BAR; PG8_SCHED;
            PG8_LDA(At, 1, 1); PG8_STAGE(PG8_SB(1, 0), b30, voffB); PG8_STAGE(PG8_SB(1, 1), b31, voffB); PG8_STAGE(PG8_SA(1, 0), a3, voffA);
            PG8_WAIT_V(8); PG8_WAIT_L(0); PG8_BAR; PG8_MMA(1, 0, At, B0); PG8_MMA(1, 1, At, B1); PG8_BAR; PG8_SCHED;
        }
        if (wr == 0) PG8_BAR;
        if (ui == 0) STAMPG(2); STAMPG(4);
        E(acc, cur, wr, wc, fr, fq);
        if (PROBE_A >= 0 && PRB) { asm volatile("s_waitcnt vmcnt(0)" ::: "memory"); } if (ui == 0) STAMPG(3); STAMPG(5);
        if (!has_next) break;
        if (!Epi::keep_acc(cur)) {
#pragma unroll
        for (int a = 0; a < 2; ++a)
#pragma unroll
            for (int b = 0; b < 2; ++b)
#pragma unroll
                for (int m = 0; m < 4; ++m)
#pragma unroll
                    for (int n = 0; n < 2; ++n) acc[a][b][m][n] = (f32x4){0.f, 0.f, 0.f, 0.f}; }
        cur = nxt; cA = nA; cB0 = nB0; ++ui;
        if (wr == 1) PG8_BAR;
    }
    PG8_WAIT_V(0);
    PG8_BAR;
    STAMPG(6);
#undef PG8_SA
#undef PG8_SB
#undef PG8_STAGE
#undef PG8_LDA
#undef PG8_LDB
#undef PG8_MMA
#undef PG8_WAIT_V
#undef PG8_WAIT_L
#undef PG8_BAR
#undef PG8_SCHED
}

struct EpiBf16 {
    static __device__ __forceinline__ bool keep_acc(const Unit&) { return false; }
    bf16_t* O; int ldc; const float* rowscale; float mul;
    __device__ __forceinline__ void operator()(const f32x4 (&acc)[2][2][4][2], const Unit& u, int wr, int wc, int fr, int fq) const {
        const int row0 = u.r0 + wr * 64 + fr, col0 = u.c0 + wc * 32 + 8 * fq;
#pragma unroll
        for (int ai = 0; ai < 2; ++ai)
#pragma unroll
            for (int m = 0; m < 4; ++m) { const int row = row0 + ai * HALF + m * 16; const float sc = rowscale ? rowscale[row] * mul : mul;
                bf16_t* rowp = O + (size_t)row * ldc + col0;
#pragma unroll
                for (int bj = 0; bj < 2; ++bj) { const f32x4 v0 = acc[ai][bj][m][0] * sc, v1 = acc[ai][bj][m][1] * sc;
                    u32x4 w; w.x = cvt_pk_bf16(v0[0], v0[1]); w.y = cvt_pk_bf16(v0[2], v0[3]); w.z = cvt_pk_bf16(v1[0], v1[1]); w.w = cvt_pk_bf16(v1[2], v1[3]);
                    *(u32x4*)(rowp + bj * HALF) = w; } }
    }
};
struct EpiZ {
    static __device__ __forceinline__ bool keep_acc(const Unit&) { return false; }
    bf16_t* ZM; bf16_t* UT;
    __device__ __forceinline__ void operator()(const f32x4 (&acc)[2][2][4][2], const Unit& u, int wr, int wc, int fr, int fq) const {
        const int row0 = u.r0 + wr * 64 + fr, col0 = u.c0 + wc * 32 + 8 * fq;
        if (u.c0 >= 1024 && u.c0 < 1536) {
#pragma unroll
            for (int ai = 0; ai < 2; ++ai)
#pragma unroll
                for (int m = 0; m < 4; ++m) { const int row = row0 + ai * HALF + m * 16; const int b = row >> 11, s = row & 2047;
                    bf16_t* base = UT + ((size_t)b * 512 + (col0 - 1024)) * 2048 + s;
#pragma unroll
                    for (int bj = 0; bj < 2; ++bj)
#pragma unroll
                        for (int n = 0; n < 2; ++n)
#pragma unroll
                            for (int j = 0; j < 4; ++j) base[(size_t)(bj * HALF + 4 * n + j) * 2048] = (bf16_t)f2bf(acc[ai][bj][m][n][j]); }
        } else {
#pragma unroll
            for (int ai = 0; ai < 2; ++ai)
#pragma unroll
                for (int m = 0; m < 4; ++m) { bf16_t* rowp = ZM + (size_t)(row0 + ai * HALF + m * 16) * 2048 + col0;
#pragma unroll
                    for (int bj = 0; bj < 2; ++bj) { const f32x4 v0 = acc[ai][bj][m][0], v1 = acc[ai][bj][m][1];
                        u32x4 w; w.x = cvt_pk_bf16(v0[0], v0[1]); w.y = cvt_pk_bf16(v0[2], v0[3]); w.z = cvt_pk_bf16(v1[0], v1[1]); w.w = cvt_pk_bf16(v1[2], v1[3]);
                        *(u32x4*)(rowp + bj * HALF) = w; } }
        }
    }
};
struct EpiGates8 {
    static __device__ __forceinline__ bool keep_acc(const Unit&) { return false; }
    bf16_t* G; float inmul;
    __device__ __forceinline__ void operator()(const f32x4 (&acc)[2][2][4][2], const Unit& u, int wr, int wc, int fr, int fq) const {
        const int row0 = u.r0 + wr * 64 + fr, col0 = u.c0 + wc * 32 + 8 * fq;
#pragma unroll
        for (int ai = 0; ai < 2; ++ai)
#pragma unroll
            for (int m = 0; m < 4; ++m) { bf16_t* rowp = G + (size_t)(row0 + ai * HALF + m * 16) * 6144 + col0;
#pragma unroll
                for (int bj = 0; bj < 2; ++bj) { const f32x4 a0 = acc[ai][bj][m][0] * inmul, a1 = acc[ai][bj][m][1] * inmul;
                    u32x4 w; w.x = cvt_pk_bf16(fast_sigmoid(a0[0]), fast_sigmoid(a0[1])); w.y = cvt_pk_bf16(fast_sigmoid(a0[2]), fast_sigmoid(a0[3]));
                    w.z = cvt_pk_bf16(fast_sigmoid(a1[0]), fast_sigmoid(a1[1])); w.w = cvt_pk_bf16(fast_sigmoid(a1[2]), fast_sigmoid(a1[3]));
                    *(u32x4*)(rowp + bj * HALF) = w; } }
    }
};
struct EpiGate {
    static __device__ __forceinline__ bool keep_acc(const Unit& u) { return (u.aux & 32) == 0; }
    bf16_t* MG; const bf16_t* G;
    __device__ __forceinline__ void operator()(f32x4 (&acc)[2][2][4][2], const Unit& u, int wr, int wc, int fr, int fq) const {
        const int row0 = u.r0 + wr * 64 + fr, col0 = u.c0 + wc * 32 + 8 * fq; const int gs = u.aux & 3, gn = (u.aux >> 2) & 3; const bool last = (u.aux & 32) != 0;
#pragma unroll
        for (int ai = 0; ai < 2; ++ai)
#pragma unroll
            for (int m = 0; m < 4; ++m) { const int row = row0 + ai * HALF + m * 16;
                const bf16_t* gp = G + (size_t)row * 6144 + gs * 2048 + col0; const bf16_t* gq = G + (size_t)row * 6144 + gn * 2048 + col0;
#pragma unroll
                for (int bj = 0; bj < 2; ++bj) { const u32x4 g = *(const u32x4*)(gp + bj * HALF);
                    float f[8] = {bf_lo(g.x), bf_hi(g.x), bf_lo(g.y), bf_hi(g.y), bf_lo(g.z), bf_hi(g.z), bf_lo(g.w), bf_hi(g.w)};
                    if (!last) { const u32x4 h = *(const u32x4*)(gq + bj * HALF);
                        const float d[8] = {bf_lo(h.x), bf_hi(h.x), bf_lo(h.y), bf_hi(h.y), bf_lo(h.z), bf_hi(h.z), bf_lo(h.w), bf_hi(h.w)};
#pragma unroll
                        for (int j = 0; j < 8; ++j) f[j] = f[j] * __builtin_amdgcn_rcpf(__builtin_fmaxf(d[j], 1e-30f)); }
                    f32x4 a0 = acc[ai][bj][m][0], a1 = acc[ai][bj][m][1];
                    a0[0] *= f[0]; a0[1] *= f[1]; a0[2] *= f[2]; a0[3] *= f[3]; a1[0] *= f[4]; a1[1] *= f[5]; a1[2] *= f[6]; a1[3] *= f[7];
                    if (last) { u32x4 w; w.x = cvt_pk_bf16(a0[0], a0[1]); w.y = cvt_pk_bf16(a0[2], a0[3]); w.z = cvt_pk_bf16(a1[0], a1[1]); w.w = cvt_pk_bf16(a1[2], a1[3]);
                        *(u32x4*)(MG + (size_t)row * 2048 + col0 + bj * HALF) = w; }
                    else { acc[ai][bj][m][0] = a0; acc[ai][bj][m][1] = a1; } } }
    }
};
struct EpiResid {
    static __device__ __forceinline__ bool keep_acc(const Unit&) { return false; }
    const float* X; bf16_t* O;
    __device__ __forceinline__ void operator()(const f32x4 (&acc)[2][2][4][2], const Unit& u, int wr, int wc, int fr, int fq) const {
        const int row0 = u.r0 + wr * 64 + fr, col0 = u.c0 + wc * 32 + 8 * fq;
#pragma unroll
        for (int ai = 0; ai < 2; ++ai)
#pragma unroll
            for (int m = 0; m < 4; ++m) { const size_t off = (size_t)(row0 + ai * HALF + m * 16) * 2048 + col0;
#pragma unroll
                for (int bj = 0; bj < 2; ++bj) { const f32x4 x0 = *(const f32x4*)(X + off + bj * HALF), x1 = *(const f32x4*)(X + off + bj * HALF + 4);
                    const f32x4 v0 = x0 + acc[ai][bj][m][0], v1 = x1 + acc[ai][bj][m][1];
                    u32x4 w; w.x = cvt_pk_bf16(v0[0], v0[1]); w.y = cvt_pk_bf16(v0[2], v0[3]); w.z = cvt_pk_bf16(v1[0], v1[1]); w.w = cvt_pk_bf16(v1[2], v1[3]);
                    *(u32x4*)(O + off + bj * HALF) = w; } }
    }
};
struct EpiSwiGLU8 {
    static __device__ __forceinline__ bool keep_acc(const Unit&) { return false; }
    unsigned char* H; float inmul;
    __device__ __forceinline__ void operator()(const f32x4 (&acc)[2][2][4][2], const Unit& u, int wr, int wc, int fr, int fq) const {
        const int row0 = u.r0 + wr * 64 + fr, col0 = u.c0 + wc * 32 + 8 * fq;
#pragma unroll
        for (int ai = 0; ai < 2; ++ai)
#pragma unroll
            for (int m = 0; m < 4; ++m) { unsigned char* rowp = H + (size_t)(row0 + ai * HALF + m * 16) * 2048 + col0;
                float h[8];
#pragma unroll
                for (int n = 0; n < 2; ++n)
#pragma unroll
                    for (int j = 0; j < 4; ++j) { const float g = acc[ai][0][m][n][j] * inmul, up = acc[ai][1][m][n][j] * inmul; h[4 * n + j] = g * fast_sigmoid(g) * up * SC_HID8; }
                u32x2 w; w.x = cvt4_fp8(h[0], h[1], h[2], h[3]); w.y = cvt4_fp8(h[4], h[5], h[6], h[7]);
                *(u32x2*)rowp = w; }
    }
};
}

struct Args {
    const float* x; const float* mem; const float* norm_mix_g; const float* norm_mem_g; const float* w_in; const float* pool_w; const float* pool_scale; const float* fourier_w;
    const float* w_kv; const float* proj_pool; const float* proj_fourier; const float* proj_mem; const float* w_out; const float* norm_ffn_g; const float* w_router;
    const float* w_gate; const float* w_up; const float* w_down; const float* norm_final_g;
    float* out; unsigned char* ws; int ph_lo, ph_hi;
};

template <bool FP8>
__device__ __forceinline__ void p0_tile64(const float* W, int N, int k0, int n0, void* WT, int ldt, int drow0, const float* kscale, float mul, int lane) {
    if constexpr (FP8) {
        const int lr = lane >> 4, lc = 4 * (lane & 15);
        f32x4 v[16];
#pragma unroll
        for (int i = 0; i < 16; ++i) v[i] = *(const f32x4*)(W + (size_t)(k0 + 16 * lr + i) * N + n0 + lc);
#pragma unroll
        for (int i = 0; i < 16; ++i) { float sc = mul; if (kscale) sc *= kscale[k0 + 16 * lr + i]; v[i] = v[i] * sc; }
#pragma unroll
        for (int n = 0; n < 4; ++n) { u32x4 o;
            o.x = cvt4_fp8(v[0][n], v[1][n], v[2][n], v[3][n]); o.y = cvt4_fp8(v[4][n], v[5][n], v[6][n], v[7][n]);
            o.z = cvt4_fp8(v[8][n], v[9][n], v[10][n], v[11][n]); o.w = cvt4_fp8(v[12][n], v[13][n], v[14][n], v[15][n]);
            *(u32x4*)((unsigned char*)WT + (size_t)(drow0 + lc + n) * ldt + k0 + 16 * lr) = o; }
    } else {
        const int kq = lane & 7, cg = lane >> 3;
        f32x4 v[2][8];
#pragma unroll
        for (int h = 0; h < 2; ++h)
#pragma unroll
            for (int i = 0; i < 8; ++i) v[h][i] = *(const f32x4*)(W + (size_t)(k0 + 8 * kq + i) * N + n0 + 32 * h + 4 * cg);
        if (kscale) {
#pragma unroll
            for (int i = 0; i < 8; ++i) { const float sc = kscale[k0 + 8 * kq + i]; v[0][i] = v[0][i] * sc; v[1][i] = v[1][i] * sc; } }
#pragma unroll
        for (int h = 0; h < 2; ++h)
#pragma unroll
            for (int n = 0; n < 4; ++n) { u32x4 o;
                o.x = cvt_pk_bf16(v[h][0][n], v[h][1][n]); o.y = cvt_pk_bf16(v[h][2][n], v[h][3][n]); o.z = cvt_pk_bf16(v[h][4][n], v[h][5][n]); o.w = cvt_pk_bf16(v[h][6][n], v[h][7][n]);
                *(u32x4*)((bf16_t*)WT + (size_t)(drow0 + 32 * h + 4 * cg + n) * ldt + k0 + 8 * kq) = o; }
    }
}
__device__ __forceinline__ void rms_row_to_bf16(const float* xrow, const float* g, bf16_t* orow, unsigned char* orow8, int lane) {
    const f32x4* xr = (const f32x4*)xrow + lane; const f32x4* gr = (const f32x4*)g + lane;
    f32x4 v[8]; float s = 0.f;
#pragma unroll
    for (int j = 0; j < 8; ++j) { v[j] = xr[64 * j]; s += (v[j].x * v[j].x + v[j].y * v[j].y) + (v[j].z * v[j].z + v[j].w * v[j].w); }
    const float inv = 1.0f / sqrtf(wave_sum(s) * (1.f / DM) + EPS);
    u32x2* o8 = (u32x2*)orow + lane;
#pragma unroll
    for (int j = 0; j < 8; ++j) { const f32x4 gg = gr[64 * j]; const f32x4 h = v[j] * inv * gg; u32x2 w; w.x = cvt_pk_bf16(h.x, h.y); w.y = cvt_pk_bf16(h.z, h.w); o8[64 * j] = w;
        if (orow8) ((unsigned*)orow8)[64 * j + lane] = cvt4_fp8(h.x * SC_H8, h.y * SC_H8, h.z * SC_H8, h.w * SC_H8); }
}

struct ExItem { const float* src; unsigned char* dst; int k0, n0, drow0; };
__device__ __forceinline__ ExItem ex_item(const Args& a, int r) {
    constexpr int I_EX = 32 * 32; const int mat = r / I_EX, w = r % I_EX, type = mat / 16, e = mat % 16, kb = w / 32, nb = w % 32, n0 = nb * 64;
    ExItem it; it.src = (type == 0 ? a.w_gate : (type == 1 ? a.w_up : a.w_down)) + (size_t)e * 2048 * 2048; it.k0 = kb * 64; it.n0 = n0;
    if (type < 2) { it.dst = a.ws + WS_WGUT + (size_t)e * 4096 * 2048; it.drow0 = ((n0 >> 7) << 8) + (n0 & 127) + (type == 1 ? 128 : 0); }
    else { it.dst = a.ws + WS_WDT + (size_t)e * 2048 * 2048; it.drow0 = n0; }
    return it;
}
__device__ __forceinline__ void ex_load(const ExItem& it, f32x4 (&v)[16], int lane) {
    const int lr = lane >> 4, lc = 4 * (lane & 15);
#pragma unroll
    for (int i = 0; i < 16; ++i) v[i] = __builtin_nontemporal_load((const f32x4*)(it.src + (size_t)(it.k0 + 16 * lr + i) * 2048 + it.n0 + lc));
}
__device__ __forceinline__ void ex_store(const ExItem& it, const f32x4 (&v)[16], int lane) {
    const int lr = lane >> 4, lc = 4 * (lane & 15);
#pragma unroll
    for (int n = 0; n < 4; ++n) { u32x4 o;
        o.x = cvt4_fp8(v[0][n] * SC_W8, v[1][n] * SC_W8, v[2][n] * SC_W8, v[3][n] * SC_W8); o.y = cvt4_fp8(v[4][n] * SC_W8, v[5][n] * SC_W8, v[6][n] * SC_W8, v[7][n] * SC_W8);
        o.z = cvt4_fp8(v[8][n] * SC_W8, v[9][n] * SC_W8, v[10][n] * SC_W8, v[11][n] * SC_W8); o.w = cvt4_fp8(v[12][n] * SC_W8, v[13][n] * SC_W8, v[14][n] * SC_W8, v[15][n] * SC_W8);
        __builtin_nontemporal_store(o, (u32x4*)(it.dst + (size_t)(it.drow0 + lc + n) * 2048 + it.k0 + 16 * lr)); }
}
__device__ __forceinline__ void convert_experts(const Args& a, int c, int G, int wave, int lane) {
    constexpr int NEXP = 48 * 32 * 32;
    int start, cnt;
    if (G == 256) { if (c >= 64 && c < 96) { cnt = 192; start = (c - 64) * 192; } else if (c < 64) { cnt = 212; start = 6144 + c * 212; } else { cnt = 184; start = 19712 + (c - 96) * 184; } }
    else { const int per = (NEXP + G - 1) / G; start = c * per; cnt = (start + per <= NEXP) ? per : (NEXP > start ? NEXP - start : 0); }
    const int end = start + cnt;
    int r = start + wave; if (r >= end) return;
    f32x4 va[16], vb[16];
    ExItem ia = ex_item(a, r), ib; ex_load(ia, va, lane);
    for (;;) {
        const bool hb = (r + NWAVES) < end; if (hb) { ib = ex_item(a, r + NWAVES); ex_load(ib, vb, lane); }
        ex_store(ia, va, lane);
        if (!hb) break;
        r += NWAVES;
        const bool ha = (r + NWAVES) < end; if (ha) { ia = ex_item(a, r + NWAVES); ex_load(ia, va, lane); }
        ex_store(ib, vb, lane);
        if (!ha) break;
        r += NWAVES;
    }
}
__device__ __forceinline__ void rms_row2_to_bf16(const float* xrow, const float* g, bf16_t* orow, unsigned char* orow8, int lane) {
    const f32x4* xr = (const f32x4*)xrow + lane; const f32x4* gr = (const f32x4*)g + lane;
    f32x4 v[2][8]; float s0 = 0.f, s1 = 0.f;
#pragma unroll
    for (int j = 0; j < 8; ++j) { v[0][j] = xr[64 * j]; v[1][j] = xr[512 + 64 * j]; }
#pragma unroll
    for (int j = 0; j < 8; ++j) { s0 += (v[0][j].x * v[0][j].x + v[0][j].y * v[0][j].y) + (v[0][j].z * v[0][j].z + v[0][j].w * v[0][j].w); s1 += (v[1][j].x * v[1][j].x + v[1][j].y * v[1][j].y) + (v[1][j].z * v[1][j].z + v[1][j].w * v[1][j].w); }
    const float inv0 = 1.0f / sqrtf(wave_sum(s0) * (1.f / DM) + EPS), inv1 = 1.0f / sqrtf(wave_sum(s1) * (1.f / DM) + EPS);
    u32x2* o8 = (u32x2*)orow + lane; unsigned* of8 = (unsigned*)orow8 + lane;
#pragma unroll
    for (int j = 0; j < 8; ++j) { const f32x4 gg = gr[64 * j]; const f32x4 h0 = v[0][j] * inv0 * gg, h1 = v[1][j] * inv1 * gg;
        u32x2 w0; w0.x = cvt_pk_bf16(h0.x, h0.y); w0.y = cvt_pk_bf16(h0.z, h0.w); o8[64 * j] = w0;
        u32x2 w1; w1.x = cvt_pk_bf16(h1.x, h1.y); w1.y = cvt_pk_bf16(h1.z, h1.w); o8[512 + 64 * j] = w1;
        of8[64 * j] = cvt4_fp8(h0.x * SC_H8, h0.y * SC_H8, h0.z * SC_H8, h0.w * SC_H8); of8[512 + 64 * j] = cvt4_fp8(h1.x * SC_H8, h1.y * SC_H8, h1.z * SC_H8, h1.w * SC_H8); }
}
__device__ __forceinline__ void phase0(const Args& a, LAS unsigned char* lds, int gw, int NGW, int wave, int lane) {
    unsigned char* ws = a.ws;
    STAMP0(0);
    LAS float* tab = (LAS float*)lds;
    { const int t_ = threadIdx.x; if (t_ < 128) { tab[t_] = cospif((float)t_ * (1.0f / 64.0f)); tab[128 + t_] = -sinpif((float)t_ * (1.0f / 64.0f)); } }
    __syncthreads();
    constexpr int I_WIN = 32 * 128, I_KV = 32 * 16, I_PP = 16 * 32, I_PF = 8 * 32, I_PM = 8 * 32, I_WO = 32 * 32;
    constexpr int NITEMS = I_WIN + I_KV + I_PP + I_PF + I_PM + I_WO;
    for (int it = gw; it < NITEMS; it += NGW) {
        int r = it;
        if (r < I_WIN) { const int kb = r / 128, nb = r % 128;
            if (nb < 32) p0_tile64<false>(a.w_in, 8192, kb * 64, nb * 64, ws + WS_WINT, 2048, nb * 64, nullptr, 1.f, lane);
            else p0_tile64<true>(a.w_in, 8192, kb * 64, nb * 64, ws + WS_WIN8, 2048, (nb - 32) * 64, nullptr, SC_W8, lane);
            continue; } r -= I_WIN;
        if (r < I_KV) { const int kb = r / 16, nb = r % 16; p0_tile64<false>(a.w_kv, 1024, kb * 64, nb * 64, ws + WS_WKVT, 2048, nb * 64, nullptr, 1.f, lane); continue; } r -= I_KV;
        if (r < I_PP) { const int kb = r / 32, nb = r % 32; p0_tile64<false>(a.proj_pool, 2048, kb * 64, nb * 64, ws + WS_PPST, 1024, nb * 64, a.pool_scale, 1.f, lane); continue; } r -= I_PP;
        if (r < I_PF) { const int kb = r / 32, nb = r % 32; p0_tile64<false>(a.proj_fourier, 2048, kb * 64, nb * 64, ws + WS_PFT, 1024, nb * 64, nullptr, 1.f, lane); continue; } r -= I_PF;
        if (r < I_PM) { const int kb = r / 32, nb = r % 32; p0_tile64<false>(a.proj_mem, 2048, kb * 64, nb * 64, (bf16_t*)(ws + WS_BCAT) + 2048, CAT_LD, nb * 64, nullptr, 1.f, lane); continue; } r -= I_PM;
        { const int kb = r / 32, nb = r % 32; p0_tile64<false>(a.w_out, 2048, kb * 64, nb * 64, ws + WS_WOT, 2048, nb * 64, nullptr, 1.f, lane); }
    }
    STAMP0(1);
    for (int m = 2 * gw; m < T; m += 2 * NGW) rms_row2_to_bf16(a.x + (size_t)m * DM, a.norm_mix_g, (bf16_t*)(ws + WS_XN) + (size_t)m * DM, ws + WS_XN8 + (size_t)m * DM, lane);
    for (int m = gw; m < NBATCH * MEML; m += NGW) rms_row_to_bf16(a.mem + (size_t)m * DM, a.norm_mem_g, (bf16_t*)(ws + WS_MN) + (size_t)m * DM, nullptr, lane);
    STAMP0(2);
    const int gt = gw * 64 + lane, NGT = NGW * 64;
    for (int i = gt; i < 1024 * 128; i += NGT) { const int row = i >> 7, col = (i & 127) * 8, g = row >> 8, c = row & 255;
        u32x4 o = (u32x4){0u, 0u, 0u, 0u};
        if ((col >> 8) == g) { const float* p = a.pool_w + ((size_t)g * 256 + c) * 256 + (col & 255); const f32x4 v0 = *(const f32x4*)p, v1 = *(const f32x4*)(p + 4);
            o.x = pk2(v0.x, v0.y); o.y = pk2(v0.z, v0.w); o.z = pk2(v1.x, v1.y); o.w = pk2(v1.z, v1.w); }
        *(u32x4*)((bf16_t*)(ws + WS_PWBD) + (size_t)row * 1024 + col) = o; }
    for (int i = gt; i < 16 * 2048; i += NGT) { const int e = i >> 11, d = i & 2047; ((bf16_t*)(ws + WS_GWT))[i] = (bf16_t)f2bf(a.norm_ffn_g[d] * a.w_router[d * 16 + e]); }
    STAMP0(3);
    for (int i = gt; i < 1024 * 512; i += NGT) { const int row = i >> 9, col = i & 511, cs = row >> 9, g = (row >> 7) & 3, c = row & 127, g2 = col >> 7, d = col & 127;
        float v = 0.f;
        if (g2 == g) { const float* fw = a.fourier_w + (size_t)g * 128 * 128 + d; const LAS float* tb = tab + (cs ? 128 : 0);
#pragma unroll 8
            for (int j = 0; j < 128; ++j) v += tb[(c * j) & 127] * fw[(size_t)j * 128]; }
        ((bf16_t*)(ws + WS_M1BD))[(size_t)row * 1024 + col] = (bf16_t)f2bf(v); }
    STAMP0(4);
    for (int i = gt; i < 4096 * 256; i += NGT) { const int row = i >> 8, s0 = (i & 255) * 8, cs = row >> 11, k = row & 2047;
        float v[8];
#pragma unroll
        for (int j = 0; j < 8; ++j) { const float ang = (float)((k * (s0 + j)) & 2047) * (1.0f / 1024.0f); v[j] = (cs ? sinpif(ang) : cospif(ang)) * (1.0f / 512.0f); }
        u32x4 o; o.x = pk2(v[0], v[1]); o.y = pk2(v[2], v[3]); o.z = pk2(v[4], v[5]); o.w = pk2(v[6], v[7]);
        *(u32x4*)((bf16_t*)(ws + WS_TW) + (size_t)row * 2048 + s0) = o; }
    STAMP0(5);
}

__device__ __forceinline__ void pool_pass(const Args& a, int gw, int NGW, int lane) {
    const bf16_t* ZM = (const bf16_t*)(a.ws + WS_ZM); bf16_t* AC = (bf16_t*)(a.ws + WS_ACAT);
    for (int it = gw; it < 4096; it += NGW) {
        const int run = it >> 1, hf = it & 1, chunk = hf * 64 + lane, ch0 = chunk * 8, g = chunk >> 5, hw = 1 << g;
        const int t0 = run * 8, b = t0 >> 11, s0 = t0 & 2047; const bf16_t* base = ZM + (size_t)b * SEQ * 2048 + ch0;
        u32x4 rw[23];
#pragma unroll
        for (int r = 0; r < 23; ++r) { const int d = r - 8, s = s0 + d; rw[r] = (u32x4){0u, 0u, 0u, 0u};
            if (d >= -hw && d < 8 + hw - 1 && s >= 0 && s < SEQ) rw[r] = *(const u32x4*)(base + (size_t)s * 2048); }
        float sum[8];
#pragma unroll
        for (int j = 0; j < 8; ++j) sum[j] = 0.f;
#pragma unroll
        for (int r = 0; r < 16; ++r) { const int d = r - 8; if (d >= -hw && d < hw) { const u32x4 w = rw[r];
            sum[0] += bf_lo(w.x); sum[1] += bf_hi(w.x); sum[2] += bf_lo(w.y); sum[3] += bf_hi(w.y); sum[4] += bf_lo(w.z); sum[5] += bf_hi(w.z); sum[6] += bf_lo(w.w); sum[7] += bf_hi(w.w); } }
#pragma unroll
        for (int i = 0; i < 8; ++i) { const int s = s0 + i; const int lo = (s - hw) < 0 ? 0 : (s - hw), hi = (s + hw) > SEQ ? SEQ : (s + hw); const float rc = 1.0f / (float)(hi - lo);
            const u32x4 c = rw[8 + i];
            u32x4 o; o.x = cvt_pk_bf16(sum[0] * rc - bf_lo(c.x), sum[1] * rc - bf_hi(c.x)); o.y = cvt_pk_bf16(sum[2] * rc - bf_lo(c.y), sum[3] * rc - bf_hi(c.y));
            o.z = cvt_pk_bf16(sum[4] * rc - bf_lo(c.z), sum[5] * rc - bf_hi(c.z)); o.w = cvt_pk_bf16(sum[6] * rc - bf_lo(c.w), sum[7] * rc - bf_hi(c.w));
            *(u32x4*)(AC + (size_t)(t0 + i) * CAT_LD + ch0) = o;
            if (i < 7) { u32x4 wa = (u32x4){0u, 0u, 0u, 0u}, wd = wa;
#pragma unroll
                for (int k = 0; k < 4; ++k) { const int h2 = 1 << k; if (hw == h2) { wa = rw[8 + i + h2]; wd = rw[8 + i - h2]; } }
                sum[0] += bf_lo(wa.x) - bf_lo(wd.x); sum[1] += bf_hi(wa.x) - bf_hi(wd.x); sum[2] += bf_lo(wa.y) - bf_lo(wd.y); sum[3] += bf_hi(wa.y) - bf_hi(wd.y);
                sum[4] += bf_lo(wa.z) - bf_lo(wd.z); sum[5] += bf_hi(wa.z) - bf_hi(wd.z); sum[6] += bf_lo(wa.w) - bf_lo(wd.w); sum[7] += bf_hi(wa.w) - bf_hi(wd.w); } }
    }
}

constexpr int ATT_KSTR = 272, ATT_VSTR = 520, ATT_VOFF = 256 * ATT_KSTR;
__device__ __forceinline__ void attn_unit(const Args& a, LAS unsigned char* lds, int b, int h, int qb, int wave, int lane, int tid) {
    const bf16_t* ZM = (const bf16_t*)(a.ws + WS_ZM); const bf16_t* KM = (const bf16_t*)(a.ws + WS_KMEM); const bf16_t* VT = (const bf16_t*)(a.ws + WS_VT); bf16_t* AC = (bf16_t*)(a.ws + WS_ACAT);
    const int l31 = lane & 31, hh = lane >> 5;
#pragma unroll
    for (int i = 0; i < 8; ++i) { const int ch = tid + 512 * i, row = ch >> 4, cc = ch & 15;
        const u32x4 v = *(const u32x4*)(KM + (size_t)(b * MEML + row) * 512 + h * 128 + 8 * cc);
        *(LAS u32x4*)(lds + row * ATT_KSTR + 16 * cc) = v; }
#pragma unroll
    for (int i = 0; i < 8; ++i) { const int ch = tid + 512 * i, row = ch >> 5, cc = ch & 31;
        const u32x4 v = *(const u32x4*)(VT + (size_t)(h * 128 + row) * 2048 + b * MEML + 8 * cc);
        LAS unsigned* d = (LAS unsigned*)(lds + ATT_VOFF + row * ATT_VSTR + 16 * cc); d[0] = v.x; d[1] = v.y; d[2] = v.z; d[3] = v.w; }
    const int t = b * SEQ + qb * 256 + wave * 32 + l31;
    bf16x8 qf[8];
    const bf16_t* qp = ZM + (size_t)t * 2048 + 1536 + h * 128 + 8 * hh;
#pragma unroll
    for (int ks = 0; ks < 8; ++ks) qf[ks] = *(const bf16x8*)(qp + 16 * ks);
    __syncthreads();
    f32x16 sc[8];
    const LAS unsigned char* kp = lds + l31 * ATT_KSTR + 16 * hh;
#pragma unroll
    for (int kt = 0; kt < 8; ++kt) { f32x16 acc;
#pragma unroll
        for (int r = 0; r < 16; ++r) acc[r] = 0.f;
#pragma unroll
        for (int ks = 0; ks < 8; ++ks) { const bf16x8 kf = *(const LAS bf16x8*)(kp + (32 * kt) * ATT_KSTR + 32 * ks); acc = __builtin_amdgcn_mfma_f32_32x32x16_bf16(kf, qf[ks], acc, 0, 0, 0); }
        sc[kt] = acc; }
    float mx = -3.0e38f;
#pragma unroll
    for (int kt = 0; kt < 8; ++kt)
#pragma unroll
        for (int r = 0; r < 16; ++r) mx = fmaxf(mx, sc[kt][r]);
    mx = fmaxf(mx, __shfl_xor(mx, 32));
    const float cs = 0.08838834764831845f * 1.44269504089f;
    float sum = 0.f;
#pragma unroll
    for (int kt = 0; kt < 8; ++kt)
#pragma unroll
        for (int r = 0; r < 16; ++r) { const float p = __builtin_amdgcn_exp2f((sc[kt][r] - mx) * cs); sc[kt][r] = p; sum += p; }
    sum += __shfl_xor(sum, 32);
    const float rinv = 1.0f / sum;
    bf16x8 pf[8][2];
#pragma unroll
    for (int kt = 0; kt < 8; ++kt)
#pragma unroll
        for (int s = 0; s < 2; ++s) { u32x4 w; w.x = cvt_pk_bf16(sc[kt][8 * s + 0], sc[kt][8 * s + 1]); w.y = cvt_pk_bf16(sc[kt][8 * s + 2], sc[kt][8 * s + 3]);
            w.z = cvt_pk_bf16(sc[kt][8 * s + 4], sc[kt][8 * s + 5]); w.w = cvt_pk_bf16(sc[kt][8 * s + 6], sc[kt][8 * s + 7]); pf[kt][s] = __builtin_bit_cast(bf16x8, w); }
#pragma unroll
    for (int dt = 0; dt < 4; ++dt) { f32x16 o;
#pragma unroll
        for (int r = 0; r < 16; ++r) o[r] = 0.f;
        const LAS unsigned char* vp = lds + ATT_VOFF + (32 * dt + l31) * ATT_VSTR + 8 * hh;
#pragma unroll
        for (int kt = 0; kt < 8; ++kt)
#pragma unroll
            for (int s = 0; s < 2; ++s) { const u32x2 v0 = *(const LAS u32x2*)(vp + 64 * kt + 32 * s), v1 = *(const LAS u32x2*)(vp + 64 * kt + 32 * s + 16);
                const u32x4 vv = (u32x4){v0.x, v0.y, v1.x, v1.y};
                o = __builtin_amdgcn_mfma_f32_32x32x16_bf16(__builtin_bit_cast(bf16x8, vv), pf[kt][s], o, 0, 0, 0); }
        bf16_t* op = AC + (size_t)t * CAT_LD + 2048 + h * 128 + 32 * dt + 4 * hh;
#pragma unroll
        for (int rg = 0; rg < 4; ++rg) { u32x2 w; w.x = cvt_pk_bf16(o[4 * rg + 0] * rinv, o[4 * rg + 1] * rinv); w.y = cvt_pk_bf16(o[4 * rg + 2] * rinv, o[4 * rg + 3] * rinv);
            *(u32x2*)(op + 8 * rg) = w; } }
    __syncthreads();
}

__device__ __forceinline__ void router_phase(const Args& a, LAS unsigned char* lds, int vcu, int G, int wave, int lane, int tid) {
    const bf16_t* X1 = (const bf16_t*)(a.ws + WS_X1B); const bf16_t* GWT = (const bf16_t*)(a.ws + WS_GWT); unsigned char* H2 = (unsigned char*)(a.ws + WS_H2); float* AFF = (float*)(a.ws + WS_AFF);
    LAS float* part = (LAS float*)lds;
    LAS float* ssq = (LAS float*)(lds + 32768);
    LAS float* invs = (LAS float*)(lds + 32768 + 2048);
    const int fr = lane & 15, fq = lane >> 4;
    bf16x8 bfrag[8];
#pragma unroll
    for (int ks = 0; ks < 8; ++ks) bfrag[ks] = *(const bf16x8*)(GWT + (size_t)fr * 2048 + 256 * wave + 32 * ks + 8 * fq);
    f32x4 gg[8];
#pragma unroll
    for (int j = 0; j < 8; ++j) gg[j] = ((const f32x4*)a.norm_ffn_g)[64 * j + lane];
    STAMPN(6, 2);
    for (int blk = vcu; blk < T / 64; blk += G) { const int row0 = blk * 64;
#pragma unroll
        for (int rt = 0; rt < 4; ++rt) { f32x4 acc = (f32x4){0.f, 0.f, 0.f, 0.f}; float sq = 0.f;
            const bf16_t* xp = X1 + (size_t)(row0 + 16 * rt + fr) * DM + 256 * wave + 8 * fq;
            bf16x8 af[8];
#pragma unroll
            for (int ks = 0; ks < 8; ++ks) af[ks] = *(const bf16x8*)(xp + 32 * ks);
#pragma unroll
            for (int ks = 0; ks < 8; ++ks) { acc = __builtin_amdgcn_mfma_f32_16x16x32_bf16(af[ks], bfrag[ks], acc, 0, 0, 0);
                const u32x4 w = __builtin_bit_cast(u32x4, af[ks]);
                const float v0 = bf_lo(w.x), v1 = bf_hi(w.x), v2 = bf_lo(w.y), v3 = bf_hi(w.y), v4 = bf_lo(w.z), v5 = bf_hi(w.z), v6 = bf_lo(w.w), v7 = bf_hi(w.w);
                sq += (v0 * v0 + v1 * v1) + (v2 * v2 + v3 * v3) + (v4 * v4 + v5 * v5) + (v6 * v6 + v7 * v7); }
            sq += __shfl_xor(sq, 16); sq += __shfl_xor(sq, 32);
            if (fq == 0) ssq[wave * 64 + 16 * rt + fr] = sq;
#pragma unroll
            for (int j = 0; j < 4; ++j) part[(wave * 64 + 16 * rt + 4 * fq + j) * 16 + fr] = acc[j]; }
        __syncthreads(); STAMPN(6, 3);
#pragma unroll
        for (int ps = 0; ps < 2; ++ps) { const int row = 32 * ps + (tid >> 4), e = tid & 15;
            float s = 0.f, q = 0.f;
#pragma unroll
            for (int w = 0; w < 8; ++w) { s += part[(w * 64 + row) * 16 + e]; q += ssq[w * 64 + row]; }
            const float inv = 1.0f / sqrtf(q * (1.f / DM) + EPS), lg = s * inv;
            float mx = lg;
#pragma unroll
            for (int o = 1; o < 16; o <<= 1) mx = fmaxf(mx, __shfl_xor(mx, o));
            const float ex = __expf(lg - mx); float su = ex;
#pragma unroll
            for (int o = 1; o < 16; o <<= 1) su += __shfl_xor(su, o);
            const int t = row0 + row, b = t >> 11, sx = t & 2047;
            AFF[((size_t)b * 16 + e) * SEQ + sx] = ex / su;
            if (e == 0) invs[row] = inv; }
        __syncthreads(); STAMPN(6, 4);
#pragma unroll
        for (int hf = 0; hf < 2; ++hf) { u32x2 xw[4][8];
#pragma unroll
            for (int r = 0; r < 4; ++r) { const u32x2* xr = (const u32x2*)(X1 + (size_t)(row0 + 8 * wave + 4 * hf + r) * DM) + lane;
#pragma unroll
                for (int j = 0; j < 8; ++j) xw[r][j] = xr[64 * j]; }
#pragma unroll
            for (int r = 0; r < 4; ++r) { const int row = 8 * wave + 4 * hf + r; const float inv = invs[row] * SC_H8; unsigned* hr = (unsigned*)(H2 + (size_t)(row0 + row) * DM) + lane;
#pragma unroll
                for (int j = 0; j < 8; ++j) { const u32x2 w = xw[r][j];
                    hr[64 * j] = cvt4_fp8(bf_lo(w.x) * inv * gg[j].x, bf_hi(w.x) * inv * gg[j].y, bf_lo(w.y) * inv * gg[j].z, bf_hi(w.y) * inv * gg[j].w); } } }
        __syncthreads();
    }
}

__device__ __forceinline__ int wave_isum(int v) {
#pragma unroll
    for (int o = 1; o < 64; o <<= 1) v += __shfl_xor(v, o);
    return v;
}
__device__ __forceinline__ int wave_excl_scan(int v, int ln) {
    int x = v;
#pragma unroll
    for (int o = 1; o < 64; o <<= 1) { const int y = __shfl(x, (ln - o) & 63); x += (ln >= o) ? y : 0; }
    return x - v;
}
__device__ __forceinline__ void topk_phase(const Args& a, LAS unsigned char* lds, int c, int wave, int ln, int tid) {
    if (c >= 128) return;
    const int b = c & 7, e = c >> 3;
    LAS int* list = (LAS int*)(lds + 1024);
    const float* AFF = (const float*)(a.ws + WS_AFF) + ((size_t)b * 16 + e) * SEQ;
    unsigned u[32];
#pragma unroll
    for (int i = 0; i < 8; ++i) { const u32x4 w = *(const u32x4*)(AFF + 32 * ln + 4 * i); u[4 * i] = w.x; u[4 * i + 1] = w.y; u[4 * i + 2] = w.z; u[4 * i + 3] = w.w; }
    unsigned Tv = 0u;
#pragma unroll 1
    for (int bit = 30; bit >= 0; --bit) { const unsigned cand = Tv | (1u << bit);
        int lc = 0;
#pragma unroll
        for (int i = 0; i < 32; ++i) lc += (u[i] >= cand) ? 1 : 0;
        if (wave_isum(lc) >= CAP) Tv = cand; }
    int ngt_l = 0, ntie_l = 0;
#pragma unroll
    for (int i = 0; i < 32; ++i) { ngt_l += (u[i] > Tv) ? 1 : 0; ntie_l += (u[i] == Tv) ? 1 : 0; }
    const int need = CAP - wave_isum(ngt_l);
    int tr = wave_excl_scan(ntie_l, ln);
    unsigned selmask = 0u; int nsel_l = 0;
#pragma unroll
    for (int i = 0; i < 32; ++i) { const bool t = (u[i] == Tv); const bool s = (u[i] > Tv) || (t && tr < need); tr += t ? 1 : 0; selmask |= s ? (1u << i) : 0u; nsel_l += s ? 1 : 0; }
    int slot = wave_excl_scan(nsel_l, ln);
    int* INV = (int*)(a.ws + WS_INV); float* SELW = (float*)(a.ws + WS_SELW);
    if ((ln >> 3) == wave) {
#pragma unroll
        for (int i = 0; i < 32; ++i) { const int s = 32 * ln + i; const bool sl = (selmask >> i) & 1u;
            INV[((size_t)b * SEQ + s) * 16 + e] = sl ? slot : -1;
            if (sl) { list[slot] = s; SELW[((size_t)e * 8 + b) * CAP + slot] = __builtin_bit_cast(float, u[i]); ++slot; } }
    }
    __syncthreads();
    const unsigned char* H2 = (const unsigned char*)(a.ws + WS_H2); unsigned char* XIN = (unsigned char*)(a.ws + WS_XIN);
    for (int q = 0; q < CAP / NWAVES; q += 8) {
        u32x4 v[8][2];
#pragma unroll
        for (int i = 0; i < 8; ++i) { const int s = list[wave + NWAVES * (q + i)];
            const u32x4* src = (const u32x4*)(H2 + ((size_t)b * SEQ + s) * DM) + ln; v[i][0] = src[0]; v[i][1] = src[64]; }
#pragma unroll
        for (int i = 0; i < 8; ++i) { const int slot2 = wave + NWAVES * (q + i);
            u32x4* dst = (u32x4*)(XIN + (((size_t)e * 8 + b) * CAP + slot2) * DM) + ln; dst[0] = v[i][0]; dst[64] = v[i][1]; }
    }
    __syncthreads();
}

__device__ __forceinline__ void combine_phase(const Args& a, int gw, int NGW, int lane) {
    const bf16_t* Y = (const bf16_t*)(a.ws + WS_Y); const int* INV = (const int*)(a.ws + WS_INV); const bf16_t* X1 = (const bf16_t*)(a.ws + WS_X1B);
    for (int t = 2 * gw; t < T; t += 2 * NGW) { const int b = t >> 11;
        f32x4 v0[8], v1[8];
        { const u32x2* r0 = (const u32x2*)(X1 + (size_t)t * DM) + lane; const u32x2* r1 = r0 + DM / 4;
#pragma unroll
            for (int j = 0; j < 8; ++j) { const u32x2 w = r0[64 * j], x = r1[64 * j];
                v0[j] = (f32x4){bf_lo(w.x), bf_hi(w.x), bf_lo(w.y), bf_hi(w.y)}; v1[j] = (f32x4){bf_lo(x.x), bf_hi(x.x), bf_lo(x.y), bf_hi(x.y)}; } }
        const int myinv = INV[(size_t)t * 16 + (lane & 31)];
#pragma unroll 1
        for (int e = 0; e < 16; ++e) { const int s0 = __shfl(myinv, e), s1 = __shfl(myinv, 16 + e);
            u32x2 y0[8], y1[8];
            if (s0 >= 0) { const u32x2* yr = (const u32x2*)(Y + (((size_t)e * 8 + b) * CAP + s0) * DM) + lane;
#pragma unroll
                for (int j = 0; j < 8; ++j) y0[j] = yr[64 * j]; }
            if (s1 >= 0) { const u32x2* yr = (const u32x2*)(Y + (((size_t)e * 8 + b) * CAP + s1) * DM) + lane;
#pragma unroll
                for (int j = 0; j < 8; ++j) y1[j] = yr[64 * j]; }
            if (s0 >= 0) {
#pragma unroll
                for (int j = 0; j < 8; ++j) { v0[j].x += bf_lo(y0[j].x); v0[j].y += bf_hi(y0[j].x); v0[j].z += bf_lo(y0[j].y); v0[j].w += bf_hi(y0[j].y); } }
            if (s1 >= 0) {
#pragma unroll
                for (int j = 0; j < 8; ++j) { v1[j].x += bf_lo(y1[j].x); v1[j].y += bf_hi(y1[j].x); v1[j].z += bf_lo(y1[j].y); v1[j].w += bf_hi(y1[j].y); } } }
        float q0 = 0.f, q1 = 0.f;
#pragma unroll
        for (int j = 0; j < 8; ++j) { q0 += (v0[j].x * v0[j].x + v0[j].y * v0[j].y) + (v0[j].z * v0[j].z + v0[j].w * v0[j].w); q1 += (v1[j].x * v1[j].x + v1[j].y * v1[j].y) + (v1[j].z * v1[j].z + v1[j].w * v1[j].w); }
        const float i0 = 1.0f / sqrtf(wave_sum(q0) * (1.f / DM) + EPS), i1 = 1.0f / sqrtf(wave_sum(q1) * (1.f / DM) + EPS);
        f32x4* o0 = (f32x4*)(a.out + (size_t)t * DM) + lane; f32x4* o1 = o0 + DM / 4;
#pragma unroll
        for (int j = 0; j < 8; ++j) { const f32x4 gg = ((const f32x4*)a.norm_final_g)[64 * j + lane]; o0[64 * j] = v0[j] * i0 * gg; o1[64 * j] = v1[j] * i1 * gg; }
    }
}

using pg8::Unit;
struct SchedFold {
    unsigned char* ws; int c;
    __device__ __forceinline__ bool next(int i, Unit& u) const {
        if (i > 0 || c >= 64) return false;
        const int L = c & 31, pm = L & 7, pn = L >> 3;
        if (c < 32) { u.A = (const char*)(ws + WS_PPST) + (size_t)pm * 256 * 1024 * 2; u.B0 = (const char*)(ws + WS_PWBD) + (size_t)pn * 256 * 1024 * 2; u.nt = 16; u.c0 = pn * 256; }
        else { u.A = (const char*)(ws + WS_PFT) + (size_t)pm * 256 * 1024 * 2; u.B0 = (const char*)(ws + WS_M1BD) + (size_t)pn * 256 * 1024 * 2; u.nt = 8; u.c0 = 1024 + pn * 256; }
        u.r0 = pm * 256; u.aux = 0; return true;
    }
};
struct SchedKV {
    unsigned char* ws; int c;
    __device__ __forceinline__ bool next(int i, Unit& u) const {
        if (i > 0 || c < 64 || c >= 96) return false;
        const int L = c - 64; u.nt = 32;
        if (L < 16) { const int pm = L & 7, pn = L >> 3; u.A = (const char*)(ws + WS_MN) + (size_t)pm * 256 * 2048 * 2; u.B0 = (const char*)(ws + WS_WKVT) + (size_t)pn * 256 * 2048 * 2; u.r0 = pm * 256; u.c0 = pn * 256; u.aux = 0; }
        else { const int L2 = L - 16, pm = L2 & 1, pn = L2 >> 1; u.A = (const char*)(ws + WS_WKVT) + (size_t)(512 + pm * 256) * 2048 * 2; u.B0 = (const char*)(ws + WS_MN) + (size_t)pn * 256 * 2048 * 2; u.r0 = pm * 256; u.c0 = pn * 256; u.aux = 1; }
        return true;
    }
};
struct EpiKV {
    static __device__ __forceinline__ bool keep_acc(const Unit&) { return false; }
    bf16_t* KM; bf16_t* VT;
    __device__ __forceinline__ void operator()(const f32x4 (&acc)[2][2][4][2], const Unit& u, int wr, int wc, int fr, int fq) const {
        pg8::EpiBf16 E{u.aux ? VT : KM, u.aux ? 2048 : 512, nullptr, 1.f}; E(acc, u, wr, wc, fr, fq);
    }
};
struct SchedTiles {
    const char* A; const char* B; int lda, ldb, nM, nN, nt, G, c, ibeg, iend, esz;
    __device__ __forceinline__ bool next(int i0, Unit& u) const {
        const int i = i0 + ibeg; if (i >= iend) return false;
        const int L = i * G + c; if (L >= nM * nN) return false;
        int pm, pn; pg8::tile_order(L, nM, nN, pm, pn);
        u.A = A + (size_t)pm * 256 * lda * esz; u.B0 = B + (size_t)pn * 256 * ldb * esz; u.nt = nt; u.r0 = pm * 256; u.c0 = pn * 256; u.aux = 0; return true;
    }
};
struct SchedDFT {
    unsigned char* ws; int c;
    __device__ __forceinline__ bool next(int i, Unit& u) const {
        if (i > 0 || c >= 256) return false;
        const int b = c & 7, j = c >> 3, pm = j & 15, pn = j >> 4;
        u.A = (const char*)(ws + WS_TW) + (size_t)pm * 256 * 2048 * 2; u.B0 = (const char*)(ws + WS_UT) + (size_t)(b * 512 + pn * 256) * 2048 * 2; u.nt = 32;
        u.r0 = b * SEQ + (pm & 7) * 256; u.c0 = 1024 + (pm >> 3) * 512 + pn * 256; u.aux = 0; return true;
    }
};
struct SchedProj {
    unsigned char* ws; int G, c;
    __device__ __forceinline__ bool next(int i, Unit& u) const {
        const int ti = i / 3, si = i - 3 * ti, rot = 0, s = (si + rot) % 3; const int L = ti * G + c; if (L >= 512) return false;
        int pm, pn; pg8::tile_order(L, 64, 8, pm, pn);
        const size_t co = (size_t)s * 1024 * 2;
        u.A = (const char*)(ws + WS_ACAT) + (size_t)pm * 256 * CAT_LD * 2 + co; u.B0 = (const char*)(ws + WS_BCAT) + (size_t)pn * 256 * CAT_LD * 2 + co;
        u.nt = s == 2 ? 8 : 16; u.r0 = pm * 256; u.c0 = pn * 256; u.aux = s | (((si + 1 + rot) % 3) << 2) | (si == 2 ? 32 : 0); return true;
    }
};
struct SchedGU {
    unsigned char* ws; int G, c;
    __device__ __forceinline__ bool next(int i, Unit& u) const {
        const int L = i * G + c; if (L >= 2048) return false;
        const int e = L >> 7, j = L & 127, x = j & 7, q = j >> 3, pm = q & 7, pn = 2 * x + (q >> 3);
        u.A = (const char*)(ws + WS_XIN) + (size_t)(e * 8 + pm) * 256 * 2048; u.B0 = (const char*)(ws + WS_WGUT) + ((size_t)e * 4096 + pn * 256) * 2048;
        u.nt = 16; u.r0 = (e * 8 + pm) * 256; u.c0 = pn * 128; u.aux = 0; return true;
    }
};
struct SchedDown {
    unsigned char* ws; int G, c;
    __device__ __forceinline__ bool next(int i, Unit& u) const {
        const int L = i * G + c; if (L >= 1024) return false;
        const int e = L >> 6, j = L & 63, pn = j & 7, pm = j >> 3;
        u.A = (const char*)(ws + WS_HID) + (size_t)(e * 8 + pm) * 256 * 2048; u.B0 = (const char*)(ws + WS_WDT) + ((size_t)e * 2048 + pn * 256) * 2048;
        u.nt = 16; u.r0 = (e * 8 + pm) * 256; u.c0 = pn * 256; u.aux = 0; return true;
    }
};

__global__ void __launch_bounds__(NTHR, 2) fwd_kernel(Args a) {
    extern __shared__ __attribute__((aligned(16))) unsigned char lds_raw[];
    LAS unsigned char* lds = (LAS unsigned char*)lds_raw;
    const int tid = threadIdx.x, wave = __builtin_amdgcn_readfirstlane(tid >> 6);
#define lane opaque_lane()
    const int G = gridDim.x, c = blockIdx.x;
    const int vcu = (G % 8 == 0) ? (c % 8) * (G / 8) + c / 8 : c;
    const int gw = vcu * NWAVES + wave, NGW = G * NWAVES;
    unsigned char* ws = a.ws;
    const int lo = a.ph_lo, hi = a.ph_hi;
#define IN(k) (lo <= (k) && (k) < hi)
    volatile LAS unsigned* bst = (volatile LAS unsigned*)(lds + 143360);
    if (tid < 64) ((LAS unsigned*)(lds + 143360))[tid] = 0u;
    if (tid < 256) ((LAS unsigned*)(lds + STAMP_BASE))[tid] = 0u;
    __syncthreads();
    XcdBarrier gbar = xcd_barrier_post((unsigned*)(ws + WS_CTL) + 4096, bst);
#define SEAM(k) do { if (IN(k) && IN((k) + 1)) { xcd_barrier(gbar); } STAMPN(k, 6); if (PROBE_PHASE == (k)) { STAMP(7); if (tid == 0) STAMP_EN() = 0u; } if (PROBE_PHASE == (k) + 1 && tid == 0) STAMP_EN() = 1u; } while (0)

#define PH0 if (IN(0)) { phase0(a, lds, gw, NGW, wave, lane); __syncthreads(); }
    PH0
    if (PROBE_REP == 0) { xcd_barrier(gbar); PH0 }
    SEAM(0);
    if (PROBE_PHASE == 2 && tid == 0) STAMP_EN() = 1u;
#define PH2 \
    if (!DBG_P5_FROM_XN && IN(2)) { \
          \
          \
        { SchedFold S{ws, c}; pg8::EpiBf16 E{(bf16_t*)(ws + WS_BCAT), CAT_LD, nullptr, 1.f}; pg8::gemm_phase<false, (PROBE_PHASE == 2)>(lds, 2048, 2048, S, E); } \
        { SchedKV S{ws, c}; EpiKV E{(bf16_t*)(ws + WS_KMEM), (bf16_t*)(ws + WS_VT)}; pg8::gemm_phase<false, (PROBE_PHASE == 2)>(lds, 4096, 4096, S, E); } \
        { SchedTiles S{(const char*)(ws + WS_XN), (const char*)(ws + WS_WINT), 2048, 2048, 64, 8, 32, G, c, 0, 1 << 20, 2}; pg8::EpiZ E{(bf16_t*)(ws + WS_ZM), (bf16_t*)(ws + WS_UT)}; pg8::gemm_phase<false, (PROBE_PHASE == 2)>(lds, 4096, 4096, S, E); } \
        const int csplit = 2 * ((c >> 3) & 3); \
        pg8::EpiGates8 E8{(bf16_t*)(ws + WS_G), 1.0f / (SC_H8 * SC_W8)}; \
        { SchedTiles S{(const char*)(ws + WS_XN8), (const char*)(ws + WS_WIN8), 2048, 2048, 64, 24, 16, G, c, 0, csplit, 1}; pg8::gemm_phase<true, (PROBE_PHASE == 2)>(lds, 2048, 2048, S, E8); } \
        STAMP(8); convert_experts(a, c, G, wave, lane); STAMP(9); \
        { SchedTiles S{(const char*)(ws + WS_XN8), (const char*)(ws + WS_WIN8), 2048, 2048, 64, 24, 16, G, c, csplit, 1 << 20, 1}; pg8::gemm_phase<true, (PROBE_PHASE == 2)>(lds, 2048, 2048, S, E8); } \
    }
    PH2
    if (PROBE_REP == 2) { xcd_barrier(gbar); PH2 }
    SEAM(2);
#define PH3 \
    if (!DBG_P5_FROM_XN && IN(3)) { \
        STAMPN(3, 0); { SchedDFT S{ws, c}; pg8::EpiBf16 E{(bf16_t*)(ws + WS_ACAT), CAT_LD, nullptr, 1.f}; pg8::gemm_phase<false, (PROBE_PHASE == 3)>(lds, 4096, 4096, S, E); } STAMPN(3, 1); \
        if (c < 256) { const int b = c & 7, j = c >> 3; attn_unit(a, lds, b, j & 3, j >> 2, wave, lane, tid); } STAMPN(3, 2); \
        pool_pass(a, gw, NGW, lane); STAMPN(3, 3); \
    }
    PH3
    if (PROBE_REP == 3) { xcd_barrier(gbar); PH3 }
    SEAM(3);
#define PH4 \
    if (!DBG_P5_FROM_XN && IN(4)) { SchedProj S{ws, G, c}; pg8::EpiGate E{(bf16_t*)(ws + WS_MG), (const bf16_t*)(ws + WS_G)}; pg8::gemm_phase<false, (PROBE_PHASE == 4)>(lds, 2 * CAT_LD, 2 * CAT_LD, S, E); }
    PH4
    if (PROBE_REP == 4) { xcd_barrier(gbar); PH4 }
    SEAM(4);
#define PH5 \
    if (IN(5)) { \
        SchedTiles S{(const char*)(ws + (DBG_P5_FROM_XN ? WS_XN : WS_MG)), (const char*)(ws + WS_WOT), 2048, 2048, 64, 8, 32, G, c, 0, 1 << 20, 2}; \
        pg8::EpiResid E{a.x, (bf16_t*)(ws + WS_X1B)}; pg8::gemm_phase<false, (PROBE_PHASE == 5)>(lds, 4096, 4096, S, E); \
    }
    PH5
    if (PROBE_REP == 5) { xcd_barrier(gbar); PH5 }
    SEAM(5);
#define PH6 \
    if (!DBG_SKIP_MOE && IN(6)) { STAMPN(6, 0); router_phase(a, lds, vcu, G, wave, lane, tid); __syncthreads(); STAMPN(6, 1); }
    PH6
    if (PROBE_REP == 6) { xcd_barrier(gbar); PH6 }
    SEAM(6);
#define PH7 \
    if (!DBG_SKIP_MOE && IN(7)) { STAMPN(7, 0); topk_phase(a, lds, c, wave, lane, tid); STAMPN(7, 1); }
    PH7
    if (PROBE_REP == 7) { xcd_barrier(gbar); PH7 }
    SEAM(7);
#define PH8 \
    if (!DBG_SKIP_MOE && IN(8)) { SchedGU S{ws, G, c}; pg8::EpiSwiGLU8 E{(unsigned char*)(ws + WS_HID), 1.0f / (SC_H8 * SC_W8)}; pg8::gemm_phase<true, (PROBE_PHASE == 8)>(lds, 2048, 2048, S, E); }
    PH8
    if (PROBE_REP == 8) { xcd_barrier(gbar); PH8 }
    SEAM(8);
#define PH9 \
    if (!DBG_SKIP_MOE && IN(9)) { SchedDown S{ws, G, c}; pg8::EpiBf16 E{(bf16_t*)(ws + WS_Y), 2048, (const float*)(ws + WS_SELW), 1.0f / (SC_HID8 * SC_W8)}; pg8::gemm_phase<true, (PROBE_PHASE == 9)>(lds, 2048, 2048, S, E); }
    PH9
    if (PROBE_REP == 9) { xcd_barrier(gbar); PH9 }
    SEAM(9);
    STAMPN(10, 0); if (IN(10)) combine_phase(a, gw, NGW, lane); STAMPN(10, 1);
    if (PROBE_A >= 0 && blockIdx.x == PROBE_BLK && tid == 0) { const volatile LAS unsigned long long* st = (const volatile LAS unsigned long long*)(unsigned)STAMP_BASE;
        const unsigned long long d = (st[PROBE_A] - st[PROBE_B]) * PROBE_SCALE, t0 = __builtin_amdgcn_s_memrealtime();
        if (d < 100000000ull) while (__builtin_amdgcn_s_memrealtime() - t0 < d) __builtin_amdgcn_s_sleep(8); }
#undef IN
#undef SEAM
#undef lane
}

extern "C" void kernel_launch(void* const* d_in, const int* in_sizes, int n_in, void* d_out, int out_size, void* d_ws, size_t ws_size, hipStream_t stream) {
    static int grid = 0;
    if (grid == 0) {
        if (n_in != 19 || in_sizes[0] != T * DM || out_size != T * DM || ws_size < WS_END) {
            fprintf(stderr, "kernel_launch: unexpected shapes (n_in %d, in0 %d, out %d, ws %zu, need %zu); nothing launched\n", n_in, n_in > 0 ? in_sizes[0] : -1, out_size, ws_size, (size_t)WS_END); grid = -1; return; }
        int dev = 0, cus = 0, per_cu = 0;
        if (hipGetDevice(&dev) != hipSuccess || hipDeviceGetAttribute(&cus, hipDeviceAttributeMultiprocessorCount, dev) != hipSuccess) { fprintf(stderr, "kernel_launch: device query failed\n"); grid = -1; return; }
        if (hipFuncSetAttribute((const void*)fwd_kernel, hipFuncAttributeMaxDynamicSharedMemorySize, LDS_BYTES) != hipSuccess) { fprintf(stderr, "kernel_launch: hipFuncSetAttribute failed\n"); grid = -1; return; }
        if (hipOccupancyMaxActiveBlocksPerMultiprocessor(&per_cu, (const void*)fwd_kernel, NTHR, LDS_BYTES) != hipSuccess || per_cu < 1) { fprintf(stderr, "kernel_launch: occupancy query says %d blocks per CU\n", per_cu); (void)hipGetLastError(); grid = -1; return; }
        grid = cus;
        if (grid < 256) fprintf(stderr, "kernel_launch: note: %d CUs (< 256): some single-round phases assume 256 workgroups\n", grid);
    }
    if (grid < 0) return;
    Args a{};
    a.x = (const float*)d_in[0]; a.mem = (const float*)d_in[1]; a.norm_mix_g = (const float*)d_in[2]; a.norm_mem_g = (const float*)d_in[3]; a.w_in = (const float*)d_in[4];
    a.pool_w = (const float*)d_in[5]; a.pool_scale = (const float*)d_in[6]; a.fourier_w = (const float*)d_in[7]; a.w_kv = (const float*)d_in[8]; a.proj_pool = (const float*)d_in[9];
    a.proj_fourier = (const float*)d_in[10]; a.proj_mem = (const float*)d_in[11]; a.w_out = (const float*)d_in[12]; a.norm_ffn_g = (const float*)d_in[13]; a.w_router = (const float*)d_in[14];
    a.w_gate = (const float*)d_in[15]; a.w_up = (const float*)d_in[16]; a.w_down = (const float*)d_in[17]; a.norm_final_g = (const float*)d_in[18];
    a.out = (float*)d_out; a.ws = (unsigned char*)d_ws;
#if MK_MULTI_LAUNCH
    for (int p = 0; p < NPH; ++p) { a.ph_lo = p; a.ph_hi = p + 1; hipLaunchKernelGGL(fwd_kernel, dim3(grid), dim3(NTHR), LDS_BYTES, stream, a); }
#else
    a.ph_lo = 0; a.ph_hi = NPH;
    if (hipMemsetAsync((char*)d_ws + WS_CTL, 0, 65536, stream) != hipSuccess) { fprintf(stderr, "kernel_launch: hipMemsetAsync failed\n"); return; }
    void* args[] = {&a};
    hipError_t e = hipLaunchCooperativeKernel((const void*)fwd_kernel, dim3(grid), dim3(NTHR), args, LDS_BYTES, stream);
    if (e != hipSuccess) fprintf(stderr, "kernel_launch: cooperative launch failed: %s (grid %d)\n", hipGetErrorString(e), grid);
#endif
}
```

```cpp
#include <hip/hip_runtime.h>
#include <hip/hip_cooperative_groups.h>
#include <cstdio>
#include <cstdint>
namespace cg = cooperative_groups;

#ifndef MK_MULTI_LAUNCH
#define MK_MULTI_LAUNCH 0
#endif

#ifndef PROBE_REP
#define PROBE_REP -1
#endif
#ifndef DBG_P5_FROM_XN
#define DBG_P5_FROM_XN 0
#endif
#ifndef DBG_ONLY_BRANCH
#define DBG_ONLY_BRANCH -1
#endif
#ifndef DBG_SKIP_MOE
#define DBG_SKIP_MOE 0
#endif
#define LAS __attribute__((address_space(3)))
#define GAS __attribute__((address_space(1)))
typedef unsigned short bf16_t;
typedef short bf16x8 __attribute__((ext_vector_type(8)));
typedef short s16x4 __attribute__((ext_vector_type(4)));
typedef float f32x2 __attribute__((ext_vector_type(2)));
typedef float f32x4 __attribute__((ext_vector_type(4)));
typedef float f32x16 __attribute__((ext_vector_type(16)));
typedef unsigned u32x2 __attribute__((ext_vector_type(2)));
typedef unsigned u32x4 __attribute__((ext_vector_type(4)));

constexpr int T = 16384, DM = 2048, NBATCH = 8, SEQ = 2048, MEML = 256;
constexpr int NE = 16, CAP = 256;
constexpr int CAT_LD = 1024;
constexpr int CAT_LD_OLD = 2560;
constexpr float EPS = 1e-6f;
constexpr int NWAVES = 8, NTHR = 512;
constexpr int NPH = 11;

constexpr size_t MiB = 1u << 20;
constexpr size_t A_POOL = 0, A_PQ = 32 * MiB, B_WA = 0, B_WB = 4 * MiB, B_PM = 8 * MiB;
constexpr size_t WS_CTL  = 0;
constexpr size_t WS_GWT  = 512 * 1024;
constexpr size_t WS_RMS  = 640 * 1024;
constexpr size_t WS_WINT = 1 * MiB;
constexpr size_t WS_WIN8 = 9 * MiB;
constexpr size_t WS_WKVT = 33 * MiB;
constexpr size_t WS_PPST = 37 * MiB;
constexpr size_t WS_PFT  = 41 * MiB;
constexpr size_t WS_PWBD = 45 * MiB;
constexpr size_t WS_M1BD = 47 * MiB;
constexpr size_t WS_BCAT = 49 * MiB;
constexpr size_t WS_WOT  = 61 * MiB;
constexpr size_t WS_TW   = 69 * MiB;
constexpr size_t WS_WGUT = 85 * MiB;
constexpr size_t WS_WDT  = 339 * MiB;
constexpr size_t WS_ACT  = 467 * MiB;
constexpr size_t WS_XN   = WS_ACT;
constexpr size_t WS_MN   = WS_ACT + 64 * MiB;
constexpr size_t WS_ZM   = WS_ACT + 72 * MiB;
constexpr size_t WS_G    = WS_ACT + 136 * MiB;
constexpr size_t WS_UT   = WS_ACT + 328 * MiB;
constexpr size_t WS_KMEM = WS_ACT + 344 * MiB;
constexpr size_t WS_VT   = WS_ACT + 346 * MiB;
constexpr size_t WS_ACAT = WS_ACT + 348 * MiB;
constexpr size_t WS_MG   = WS_ACT + 432 * MiB;
constexpr size_t WS_H2   = WS_ACT;
constexpr size_t WS_XIN  = WS_ACT + 32 * MiB;
constexpr size_t WS_Y    = WS_ACT + 96 * MiB;
constexpr size_t WS_HID  = WS_ACT + 224 * MiB;
constexpr size_t WS_AFF  = WS_ACT + 320 * MiB;
constexpr size_t WS_SELW = WS_ACT + 321 * MiB;
constexpr size_t WS_INV  = WS_ACT + 322 * MiB;
constexpr size_t WS_X1B  = WS_ACT + 352 * MiB;
constexpr size_t WS_XN8  = WS_ACT + 497 * MiB;
constexpr size_t WS_END  = WS_ACT + 529 * MiB;

constexpr int LDS_BYTES = 147456;

#define LDS_WAIT() asm volatile("s_waitcnt lgkmcnt(0)" ::: "memory")
#define VM_WAIT() asm volatile("s_waitcnt vmcnt(0)" ::: "memory")
__device__ __forceinline__ unsigned f2bf(float f) { unsigned u = __builtin_bit_cast(unsigned, f); return (u + 0x7fffu + ((u >> 16) & 1u)) >> 16; }
__device__ __forceinline__ unsigned pk2(float lo, float hi) { return f2bf(lo) | (f2bf(hi) << 16); }
typedef __bf16 bf16x2_t __attribute__((ext_vector_type(2)));
__device__ __forceinline__ unsigned cvt_pk_bf16(float lo, float hi) { const bf16x2_t v = __builtin_convertvector((f32x2){lo, hi}, bf16x2_t); return __builtin_bit_cast(unsigned, v); }
typedef int i32x8 __attribute__((ext_vector_type(8)));
__device__ __forceinline__ unsigned cvt4_fp8(float a, float b, float c, float d) {
    a = __builtin_fminf(__builtin_fmaxf(a, -448.f), 448.f); b = __builtin_fminf(__builtin_fmaxf(b, -448.f), 448.f);
    c = __builtin_fminf(__builtin_fmaxf(c, -448.f), 448.f); d = __builtin_fminf(__builtin_fmaxf(d, -448.f), 448.f);
    unsigned w = 0u; w = (unsigned)__builtin_amdgcn_cvt_pk_fp8_f32(a, b, (int)w, false); w = (unsigned)__builtin_amdgcn_cvt_pk_fp8_f32(c, d, (int)w, true); return w; }
constexpr float SC_W8 = 256.f, SC_H8 = 16.f, SC_HID8 = 8.f, SC_Y8 = 32.f, SC_Z8 = 16.f;
__device__ __forceinline__ float bf_lo(unsigned w) { return __builtin_bit_cast(float, w << 16); }
__device__ __forceinline__ float bf_hi(unsigned w) { return __builtin_bit_cast(float, w & 0xffff0000u); }
__device__ __forceinline__ int lane_id() { return (int)__builtin_amdgcn_mbcnt_hi(~0u, __builtin_amdgcn_mbcnt_lo(~0u, 0u)); }
__device__ __forceinline__ int opaque_lane() { int t = lane_id(); asm volatile("" : "+v"(t)); return t; }
__device__ __forceinline__ float wave_sum(float v) {
#pragma unroll
    for (int o = 1; o < 64; o <<= 1) v += __shfl_xor(v, o);
    return v;
}
__device__ __forceinline__ float fast_sigmoid(float v) { return __builtin_amdgcn_rcpf(1.0f + __builtin_amdgcn_exp2f(-1.44269504089f * v)); }


#ifndef PROBE_A
#define PROBE_A -1
#endif
#ifndef PROBE_B
#define PROBE_B 0
#endif
#ifndef PROBE_PHASE
#define PROBE_PHASE -1
#endif
#ifndef PROBE_BLK
#define PROBE_BLK 0
#endif
#define PROBE_SCALE 10
#define STAMP_BASE (143360 + 1024)
#define STAMP_EN() (((volatile LAS unsigned*)(unsigned)(STAMP_BASE + 512))[0])
#ifndef PROBE_NG
#define PROBE_NG 0
#endif
#define STAMPN(ph, i) do { if (PROBE_A >= 0 && PROBE_NG && PROBE_PHASE == (ph) && blockIdx.x == PROBE_BLK && threadIdx.x == 0) { ((volatile LAS unsigned long long*)(unsigned)STAMP_BASE)[i] = __builtin_amdgcn_s_memrealtime(); } } while (0)
#define STAMP0(i) STAMPN(0, i)
#define STAMPG(i) do { if constexpr (PRB) { STAMP(i); } } while (0)
#define STAMP(i) do { if (PROBE_A >= 0 && !PROBE_NG && blockIdx.x == PROBE_BLK && threadIdx.x == 0 && STAMP_EN()) { ((volatile LAS unsigned long long*)(unsigned)STAMP_BASE)[i] = __builtin_amdgcn_s_memrealtime(); } } while (0)

#define XB_TMO      128
#define XB_XCNT(j)  (256  + 64 * (j))
#define XB_XSUB(j)  (1280 + 64 * (j))
#define XB_XGEN(j)  (2304 + 64 * (j))
#define XB_TOP      3328
#define XB_TOPGEN   3392
#define XCD_BAR_WORDS 3456
#define XB_SPIN_CAP (1u << 18)
__device__ __forceinline__ unsigned xb_ld(unsigned* p)              { return __hip_atomic_load(p, __ATOMIC_RELAXED, __HIP_MEMORY_SCOPE_AGENT); }
__device__ __forceinline__ unsigned xb_add(unsigned* p, unsigned v) { return __hip_atomic_fetch_add(p, v, __ATOMIC_RELAXED, __HIP_MEMORY_SCOPE_AGENT); }
__device__ __forceinline__ unsigned xb_xcc_id() { return (unsigned)__builtin_amdgcn_s_getreg((3 << 11) | 20) & 0xFu; }
#define XB_SPIN(cond, bar) do { unsigned _sp = 0; while (cond) { __builtin_amdgcn_s_sleep(1); \
    if ((++_sp & 255u) == 0u) { if (xb_ld(&(bar)[XB_TMO])) break; if (_sp > XB_SPIN_CAP) { atomicAdd(&(bar)[XB_TMO], 1u); break; } } } } while (0)
struct XcdBarrier { unsigned* bar; unsigned x; volatile LAS unsigned* st; int wave; };
__device__ __forceinline__ XcdBarrier xcd_barrier_post(unsigned* bar, volatile LAS unsigned* st, int wave) {
    XcdBarrier b; b.bar = bar; b.x = xb_xcc_id(); b.st = st; b.wave = wave;
    if (wave == 0 && lane_id() == 0) (void)xb_add(&bar[XB_XCNT(b.x)], 1u);
    return b;
}
__device__ __forceinline__ void xcd_barrier_complete(unsigned* bar, unsigned x, unsigned& nloc, unsigned& nx) {
    const unsigned G = gridDim.x * gridDim.y * gridDim.z;
    unsigned sum, cnt, mine, sp = 0u;
    for (;;) {
        sum = 0u; cnt = 0u; mine = 0u;
#pragma unroll
        for (unsigned j = 0; j < 16; ++j) { const unsigned c = xb_ld(&bar[XB_XCNT(j)]); sum += c; cnt += (c > 0u) ? 1u : 0u; mine = (j == x) ? c : mine; }
        if (sum == G) break;
        __builtin_amdgcn_s_sleep(1);
        if ((++sp & 255u) == 0u) { if (xb_ld(&bar[XB_TMO])) break; if (sp > XB_SPIN_CAP) { atomicAdd(&bar[XB_TMO], 1u); break; } }
    }
    nloc = mine > 0u ? mine : 1u; nx = cnt > 0u ? cnt : 1u;
}
__device__ __forceinline__ void xcd_barrier(const XcdBarrier& b) {
    asm volatile("s_waitcnt vmcnt(0)" ::: "memory");
    __syncthreads();
    if (b.wave == 0 && lane_id() == 0) {
        unsigned* bar = b.bar;
        __builtin_amdgcn_s_waitcnt(0);
        unsigned nloc = b.st[0], nx = b.st[1];
        if (nloc == 0u) { xcd_barrier_complete(bar, b.x, nloc, nx); b.st[0] = nloc; b.st[1] = nx; }
        const unsigned old = xb_add(&bar[XB_XSUB(b.x)], 1u);
        const unsigned gen = old / nloc;
        if (old + 1u == (gen + 1u) * nloc) {
            __builtin_amdgcn_fence(__ATOMIC_RELEASE, "agent");
            asm volatile("s_waitcnt vmcnt(0)" ::: "memory");
            const unsigned og = xb_add(&bar[XB_TOP], 1u);
            const unsigned tg = og / nx;
            if (og + 1u == (tg + 1u) * nx) xb_add(&bar[XB_TOPGEN], 1u);
            else XB_SPIN(xb_ld(&bar[XB_TOPGEN]) == tg, bar);
            __builtin_amdgcn_fence(__ATOMIC_ACQUIRE, "agent");
            xb_add(&bar[XB_XGEN(b.x)], 1u);
            asm volatile("s_waitcnt vmcnt(0)" ::: "memory");
        } else {
            XB_SPIN(xb_ld(&bar[XB_XGEN(b.x)]) == gen, bar);
            __builtin_amdgcn_fence(__ATOMIC_ACQUIRE, "agent");
            asm volatile("s_waitcnt vmcnt(0)" ::: "memory");
        }
    }
    __syncthreads();
}

namespace pg8 {
typedef int i32x4v __attribute__((ext_vector_type(4)));
template <bool F8> struct FragT { bf16x8 bf[2]; };
template <> struct FragT<true> { i32x8 f8; };
constexpr int BM = 256, BK = 64, HALF = 128, HTB = HALF * BK * 2, STAGE_BYTES = 8 * HTB;
__device__ __forceinline__ int lds_byte(int r, int c) { const int st = (r >> 4) * 2 + (c >> 5), rr = r & 15, cc = c & 31, ob = rr * 64 + cc * 2; return st * 1024 + (ob ^ (((ob >> 9) & 1) << 5)); }
__device__ __forceinline__ void stage_rc(int b, int& R, int& C) { const int st = b / 1024, sb = b % 1024, swz = sb ^ (((sb >> 9) & 1) << 5); R = (st >> 1) * 16 + swz / 64; C = (st & 1) * 32 + (swz % 64) / 2; }
__device__ __forceinline__ int perm32(int rho) { const int n = rho >> 4, i = rho & 15; return 8 * (i >> 2) + 4 * n + (i & 3); }

struct Unit { const char* A; const char* B0; int nt; int r0, c0, aux; };

__device__ __forceinline__ void tile_order(int L, int nM, int nN, int& pm, int& pn) {
    const int nwg = nM * nN;
    int wgid = L; { const int q = nwg / 8, r = nwg % 8, xcd = wgid % 8, off = wgid / 8; wgid = (xcd < r ? xcd * (q + 1) : r * (q + 1) + (xcd - r) * q) + off; }
    const int nig = 8 * nN, gid = wgid / nig, fm = gid * 8, gsz = (nM - fm) < 8 ? (nM - fm) : 8;
    pm = fm + ((wgid % nig) % gsz); pn = (wgid % nig) / gsz;
}

struct NoHook { __device__ __forceinline__ void operator()(int) const {} };
template <bool FP8, bool PRB = false, class Epi, class Sched, class Hook = NoHook>
__device__ __forceinline__ void gemm_phase(const int wave, LAS unsigned char* lds, const int lda, const int ldb, const Sched& S, const Epi& E, const int hrowsB = HALF, const Hook& H = Hook()) {
    int lane = lane_id(); asm volatile("" : "+v"(lane));
    const int wid = wave, tid = wave * 64 + lane, wr = wid >> 2, wc = wid & 3, fr = lane & 15, fq = lane >> 4;
    unsigned voffA[2], voffB[2];
#pragma unroll
    for (int i = 0; i < 2; ++i) { int R, C; stage_rc(tid * 16 + i * 8192, R, C); const int Rb = (R & ~31) + perm32(R & 31);
        voffA[i] = (unsigned)(R * lda + C * 2); voffB[i] = (unsigned)(Rb * ldb + C * 2); }
    const size_t kstep = (size_t)(BK * 2);
    const size_t hstepA = (size_t)HALF * lda, hstepB = (size_t)hrowsB * ldb;
    const unsigned ldsw = (unsigned)wid * 1024u;
    const int aoff = lds_byte(wr * 64 + fr, fq * 8), boff = lds_byte(wc * 32 + fr, fq * 8);
#define PG8_SA(b, h) (((b) * 2 + (h)) * HTB)
#define PG8_SB(b, h) ((4 + (b) * 2 + (h)) * HTB)
#define PG8_STAGE(bufoff, gbase, voff) do { const char* _gb = (const char*)(gbase); asm volatile("" : "+s"(_gb)); _Pragma("unroll") for (int _i = 0; _i < 2; ++_i) { \
        unsigned _vo = (voff)[_i]; asm volatile("" : "+v"(_vo)); \
        __builtin_amdgcn_global_load_lds((const unsigned*)(_gb + _vo), (LAS unsigned*)(lds + (bufoff) + ldsw + _i * 8192), 16, 0, 0); } } while (0)
#define PG8_LDA(dst, b, h) do { _Pragma("unroll") for (int m = 0; m < 4; ++m) { if constexpr (FP8) { \
            const i32x4v lo_ = *(const LAS i32x4v*)(lds + PG8_SA(b, h) + aoff + m * 2048), hi_ = *(const LAS i32x4v*)(lds + PG8_SA(b, h) + aoff + m * 2048 + 1024); \
            dst[m].f8 = __builtin_shufflevector(lo_, hi_, 0, 1, 2, 3, 4, 5, 6, 7); } \
        else { _Pragma("unroll") for (int k = 0; k < 2; ++k) dst[m].bf[k] = *(const LAS bf16x8*)(lds + PG8_SA(b, h) + aoff + m * 2048 + k * 1024); } } } while (0)
#define PG8_LDB(dst, b, h) do { _Pragma("unroll") for (int n = 0; n < 2; ++n) { if constexpr (FP8) { \
            const i32x4v lo_ = *(const LAS i32x4v*)(lds + PG8_SB(b, h) + boff + n * 2048), hi_ = *(const LAS i32x4v*)(lds + PG8_SB(b, h) + boff + n * 2048 + 1024); \
            dst[n].f8 = __builtin_shufflevector(lo_, hi_, 0, 1, 2, 3, 4, 5, 6, 7); } \
        else { _Pragma("unroll") for (int k = 0; k < 2; ++k) dst[n].bf[k] = *(const LAS bf16x8*)(lds + PG8_SB(b, h) + boff + n * 2048 + k * 1024); } } } while (0)
#define PG8_MMA(ai, bj, At, Bt) do { __builtin_amdgcn_s_setprio(1); _Pragma("unroll") for (int m = 0; m < 4; ++m) _Pragma("unroll") for (int n = 0; n < 2; ++n) { \
        if constexpr (FP8) acc[ai][bj][m][n] = __builtin_amdgcn_mfma_scale_f32_16x16x128_f8f6f4(Bt[n].f8, At[m].f8, acc[ai][bj][m][n], 0, 0, 0, 0x7F7F7F7F, 0, 0x7F7F7F7F); \
        else { _Pragma("unroll") for (int k = 0; k < 2; ++k) acc[ai][bj][m][n] = __builtin_amdgcn_mfma_f32_16x16x32_bf16(Bt[n].bf[k], At[m].bf[k], acc[ai][bj][m][n], 0, 0, 0); } } \
        __builtin_amdgcn_s_setprio(0); } while (0)
#define PG8_WAIT_V(n) asm volatile("s_waitcnt vmcnt(" #n ")" ::: "memory")
#define PG8_WAIT_L(n) asm volatile("s_waitcnt lgkmcnt(" #n ")" ::: "memory")
#define PG8_BAR __builtin_amdgcn_s_barrier()
#define PG8_SCHED __builtin_amdgcn_sched_barrier(0)
    Unit cur, nxt; int ui = 0;
    STAMPG(0);
    if (!S.next(0, cur)) return;
    f32x4 acc[2][2][4][2];
#pragma unroll
    for (int a = 0; a < 2; ++a)
#pragma unroll
        for (int b = 0; b < 2; ++b)
#pragma unroll
            for (int m = 0; m < 4; ++m)
#pragma unroll
                for (int n = 0; n < 2; ++n) acc[a][b][m][n] = (f32x4){0.f, 0.f, 0.f, 0.f};
    FragT<FP8> At[4], B0[2], B1[2];
    const char* cA = cur.A; const char* cB0 = cur.B0;
    PG8_STAGE(PG8_SB(0, 0), cB0, voffB); PG8_STAGE(PG8_SB(0, 1), cB0 + hstepB, voffB); PG8_STAGE(PG8_SA(0, 0), cA, voffA); PG8_STAGE(PG8_SA(0, 1), cA + hstepA, voffA);
    if (wr == 1) PG8_BAR;
    PG8_WAIT_V(2); PG8_BAR;
    PG8_STAGE(PG8_SB(1, 0), cB0 + kstep, voffB); PG8_STAGE(PG8_SA(1, 0), cA + kstep, voffA); PG8_STAGE(PG8_SB(1, 1), cB0 + hstepB + kstep, voffB);
    PG8_WAIT_V(6); PG8_BAR;
    STAMPG(1);
    for (;;) {
        const bool has_next = S.next(ui + 1, nxt);
        const char* nA = has_next ? nxt.A : cA; const char* nB0 = has_next ? nxt.B0 : cB0;
        const int nt = cur.nt;
        for (int t = 0; t < nt; t += 2) {
            const bool last = (t == nt - 2);
            const char* a1 = cA + (size_t)(t + 1) * kstep;
            const char* a2 = last ? nA : cA + (size_t)(t + 2) * kstep;
            const char* b20 = last ? nB0 : cB0 + (size_t)(t + 2) * kstep; const char* b21 = b20 + hstepB;
            const char* a3 = a2 + kstep; const char* b30 = b20 + kstep; const char* b31 = b21 + kstep;
            PG8_LDB(B0, 0, 0); PG8_LDB(B1, 0, 1); PG8_SCHED; PG8_LDA(At, 0, 0); PG8_STAGE(PG8_SA(1, 1), a1 + hstepA, voffA);
            PG8_WAIT_V(8); PG8_WAIT_L(0); PG8_BAR; PG8_MMA(0, 0, At, B0); PG8_MMA(0, 1, At, B1); PG8_BAR; PG8_SCHED;
            PG8_LDA(At, 0, 1); PG8_STAGE(PG8_SB(0, 0), b20, voffB); PG8_STAGE(PG8_SB(0, 1), b21, voffB); PG8_STAGE(PG8_SA(0, 0), a2, voffA);
            PG8_WAIT_V(8); PG8_WAIT_L(0); PG8_BAR; PG8_MMA(1, 0, At, B0); PG8_MMA(1, 1, At, B1); PG8_BAR; PG8_SCHED;
            PG8_LDB(B0, 1, 0); PG8_LDB(B1, 1, 1); PG8_SCHED; PG8_LDA(At, 1, 0); PG8_STAGE(PG8_SA(0, 1), a2 + hstepA, voffA);
            PG8_WAIT_V(8); PG8_WAIT_L(0); PG8_BAR; PG8_MMA(0, 0, At, B0); PG8_MMA(0, 1, At, B1); PG8_BAR; PG8_SCHED;
            PG8_LDA(At, 1, 1); PG8_STAGE(PG8_SB(1, 0), b30, voffB); PG8_STAGE(PG8_SB(1, 1), b31, voffB); PG8_STAGE(PG8_SA(1, 0), a3, voffA);
            PG8_WAIT_V(8); PG8_WAIT_L(0); PG8_BAR; PG8_MMA(1, 0, At, B0); PG8_MMA(1, 1, At, B1); PG8_BAR; PG8_SCHED;
        }
        if (wr == 0) PG8_BAR;
        if (ui == 0) STAMPG(2); STAMPG(4);
        E(acc, cur, wr, wc, fr, fq);
        if (PROBE_A >= 0 && PRB) { asm volatile("s_waitcnt vmcnt(0)" ::: "memory"); } if (ui == 0) STAMPG(3); STAMPG(5);
        if (!has_next) break;
        H(ui);
        if (!Epi::keep_acc(cur)) {
#pragma unroll
        for (int a = 0; a < 2; ++a)
#pragma unroll
            for (int b = 0; b < 2; ++b)
#pragma unroll
                for (int m = 0; m < 4; ++m)
#pragma unroll
                    for (int n = 0; n < 2; ++n) acc[a][b][m][n] = (f32x4){0.f, 0.f, 0.f, 0.f}; }
        cur = nxt; cA = nA; cB0 = nB0; ++ui;
        if (wr == 1) PG8_BAR;
    }
    PG8_WAIT_V(0);
    PG8_BAR;
    STAMPG(6);
#undef PG8_SA
#undef PG8_SB
#undef PG8_STAGE
#undef PG8_LDA
#undef PG8_LDB
#undef PG8_MMA
#undef PG8_WAIT_V
#undef PG8_WAIT_L
#undef PG8_BAR
#undef PG8_SCHED
}

struct EpiBf16 {
    static __device__ __forceinline__ bool keep_acc(const Unit&) { return false; }
    bf16_t* O; int ldc; const float* rowscale; float mul;
    __device__ __forceinline__ void operator()(const f32x4 (&acc)[2][2][4][2], const Unit& u, int wr, int wc, int fr, int fq) const {
        const int row0 = u.r0 + wr * 64 + fr, col0 = u.c0 + wc * 32 + 8 * fq;
#pragma unroll
        for (int ai = 0; ai < 2; ++ai)
#pragma unroll
            for (int m = 0; m < 4; ++m) { const int row = row0 + ai * HALF + m * 16; const float sc = rowscale ? rowscale[row] * mul : mul;
                bf16_t* rowp = O + (size_t)row * ldc + col0;
#pragma unroll
                for (int bj = 0; bj < 2; ++bj) { const f32x4 v0 = acc[ai][bj][m][0] * sc, v1 = acc[ai][bj][m][1] * sc;
                    u32x4 w; w.x = cvt_pk_bf16(v0[0], v0[1]); w.y = cvt_pk_bf16(v0[2], v0[3]); w.z = cvt_pk_bf16(v1[0], v1[1]); w.w = cvt_pk_bf16(v1[2], v1[3]);
                    *(u32x4*)(rowp + bj * HALF) = w; } }
    }
};
struct EpiDFT {
    static __device__ __forceinline__ bool keep_acc(const Unit&) { return false; }
    bf16_t* O;
    __device__ __forceinline__ void operator()(const f32x4 (&acc)[2][2][4][2], const Unit& u, int wr, int wc, int fr, int fq) const {
        const int tab = u.aux & 3, m0 = (u.aux >> 2) * 256 + wr * 64 + fr, col0 = u.c0 + wc * 32 + 8 * fq; const unsigned sgn = (tab & 1) ? 0x80008000u : 0u;
#pragma unroll
        for (int ai = 0; ai < 2; ++ai)
#pragma unroll
            for (int m = 0; m < 4; ++m) { const int s = 2 * (m0 + ai * HALF + m * 16) + (tab >> 1);
                bf16_t* rowp = O + (size_t)(u.r0 + s) * CAT_LD + col0; bf16_t* mirp = O + (size_t)(u.r0 + SEQ - s) * CAT_LD + col0;
#pragma unroll
                for (int bj = 0; bj < 2; ++bj) { const f32x4 v0 = acc[ai][bj][m][0], v1 = acc[ai][bj][m][1];
                    u32x4 w; w.x = cvt_pk_bf16(v0[0], v0[1]); w.y = cvt_pk_bf16(v0[2], v0[3]); w.z = cvt_pk_bf16(v1[0], v1[1]); w.w = cvt_pk_bf16(v1[2], v1[3]);
                    *(u32x4*)(rowp + bj * HALF) = w;
                    if (s != 0) { w.x ^= sgn; w.y ^= sgn; w.z ^= sgn; w.w ^= sgn; *(u32x4*)(mirp + bj * HALF) = w; } } }
    }
};
struct EpiFp8 {
    static __device__ __forceinline__ bool keep_acc(const Unit&) { return false; }
    unsigned char* O; int ldc; const float* rowscale; float mul;
    __device__ __forceinline__ void operator()(const f32x4 (&acc)[2][2][4][2], const Unit& u, int wr, int wc, int fr, int fq) const {
        const int row0 = u.r0 + wr * 64 + fr, col0 = u.c0 + wc * 32 + 8 * fq;
#pragma unroll
        for (int ai = 0; ai < 2; ++ai)
#pragma unroll
            for (int m = 0; m < 4; ++m) { const int row = row0 + ai * HALF + m * 16; const float sc = rowscale ? rowscale[row] * mul : mul;
                unsigned char* rowp = O + (size_t)row * ldc + col0;
#pragma unroll
                for (int bj = 0; bj < 2; ++bj) { const f32x4 v0 = acc[ai][bj][m][0] * sc, v1 = acc[ai][bj][m][1] * sc;
                    u32x2 w; w.x = cvt4_fp8(v0[0], v0[1], v0[2], v0[3]); w.y = cvt4_fp8(v1[0], v1[1], v1[2], v1[3]);
                    *(u32x2*)(rowp + bj * HALF) = w; } }
    }
};
struct EpiZ {
    static __device__ __forceinline__ bool keep_acc(const Unit&) { return false; }
    bf16_t* ZM; bf16_t* UEO;
    __device__ __forceinline__ void operator()(const f32x4 (&acc)[2][2][4][2], const Unit& u, int wr, int wc, int fr, int fq) const {
        if (u.aux) {
            const int row0 = u.r0 + wr * 64 + fr, col0 = u.c0 + wc * 32 + 8 * fq;
#pragma unroll
            for (int ai = 0; ai < 2; ++ai)
#pragma unroll
                for (int m = 0; m < 4; ++m) { bf16_t* rowp = UEO + (size_t)(row0 + ai * HALF + m * 16) * 1024 + col0;
                    const f32x4 e0 = acc[ai][0][m][0] + acc[ai][1][m][0], e1 = acc[ai][0][m][1] + acc[ai][1][m][1], o0 = acc[ai][0][m][0] - acc[ai][1][m][0], o1 = acc[ai][0][m][1] - acc[ai][1][m][1];
                    u32x4 w; w.x = cvt_pk_bf16(e0[0], e0[1]); w.y = cvt_pk_bf16(e0[2], e0[3]); w.z = cvt_pk_bf16(e1[0], e1[1]); w.w = cvt_pk_bf16(e1[2], e1[3]);
                    *(u32x4*)rowp = w;
                    w.x = cvt_pk_bf16(o0[0], o0[1]); w.y = cvt_pk_bf16(o0[2], o0[3]); w.z = cvt_pk_bf16(o1[0], o1[1]); w.w = cvt_pk_bf16(o1[2], o1[3]);
                    *(u32x4*)(rowp + (size_t)NBATCH * 512 * 1024) = w; }
            return; }
        const int row0 = u.r0 + wr * 64 + fr, col0 = u.c0 + wc * 32 + 8 * fq; bf16_t* O = ZM;
#pragma unroll
        for (int ai = 0; ai < 2; ++ai)
#pragma unroll
            for (int m = 0; m < 4; ++m) { bf16_t* rowp = O + (size_t)(row0 + ai * HALF + m * 16) * 2048 + col0;
#pragma unroll
                for (int bj = 0; bj < 2; ++bj) { const f32x4 v0 = acc[ai][bj][m][0], v1 = acc[ai][bj][m][1];
                    u32x4 w; w.x = cvt_pk_bf16(v0[0], v0[1]); w.y = cvt_pk_bf16(v0[2], v0[3]); w.z = cvt_pk_bf16(v1[0], v1[1]); w.w = cvt_pk_bf16(v1[2], v1[3]);
                    *(u32x4*)(rowp + bj * HALF) = w; } }
    }
};
struct EpiGates8 {
    static __device__ __forceinline__ bool keep_acc(const Unit&) { return false; }
    unsigned char* G; float inmul;
    __device__ __forceinline__ void operator()(const f32x4 (&acc)[2][2][4][2], const Unit& u, int wr, int wc, int fr, int fq) const {
        const float sc = inmul * -1.44269504089f;
        unsigned char* tp = G + ((size_t)(u.c0 >> 8) * 64 + (u.r0 >> 8)) * 65536 + (size_t)((wr * 4 + wc) * 8) * 1024 + (fq * 16 + fr) * 16;
#pragma unroll
        for (int ai = 0; ai < 2; ++ai)
#pragma unroll
            for (int m = 0; m < 4; ++m) { u32x4 w;
                { const f32x4 a0 = acc[ai][0][m][0] * sc, a1 = acc[ai][0][m][1] * sc; w.x = cvt4_fp8(a0[0], a0[1], a0[2], a0[3]); w.y = cvt4_fp8(a1[0], a1[1], a1[2], a1[3]); }
                { const f32x4 a0 = acc[ai][1][m][0] * sc, a1 = acc[ai][1][m][1] * sc; w.z = cvt4_fp8(a0[0], a0[1], a0[2], a0[3]); w.w = cvt4_fp8(a1[0], a1[1], a1[2], a1[3]); }
                *(u32x4*)(tp + (ai * 4 + m) * 1024) = w; }
    }
};
struct EpiGate {
    static __device__ __forceinline__ bool keep_acc(const Unit& u) { return (u.aux & 32) == 0; }
    bf16_t* MG; const unsigned char* G;
    static __device__ __forceinline__ f32x2 onepexp(unsigned w, bool hi) {
        const f32x2 a = hi ? __builtin_amdgcn_cvt_pk_f32_fp8((int)w, true) : __builtin_amdgcn_cvt_pk_f32_fp8((int)w, false);
        f32x2 e; e.x = __builtin_amdgcn_exp2f(a.x); e.y = __builtin_amdgcn_exp2f(a.y); return e + (f32x2){1.0f, 1.0f}; }
    static __device__ __forceinline__ f32x2 rcp2(f32x2 d) { f32x2 r; r.x = __builtin_amdgcn_rcpf(d.x); r.y = __builtin_amdgcn_rcpf(d.y); return r; }
    __device__ __forceinline__ void operator()(f32x4 (&acc)[2][2][4][2], const Unit& u, int wr, int wc, int fr, int fq) const {
        if (u.aux & 32) run<true>(acc, u, wr, wc, fr, fq); else run<false>(acc, u, wr, wc, fr, fq);
    }
    template <bool LAST>
    __device__ __forceinline__ void run(f32x4 (&acc)[2][2][4][2], const Unit& u, int wr, int wc, int fr, int fq) const {
        const int row0 = u.r0 + wr * 64 + fr, col0 = u.c0 + wc * 32 + 8 * fq; const int gs = u.aux & 3, gn = (u.aux >> 2) & 3;
        u32x4 qc[2][4], qn[2][4];
        const unsigned char* gpb = G + ((size_t)(gs * 8 + (u.c0 >> 8)) * 64 + (u.r0 >> 8)) * 65536 + (size_t)((wr * 4 + wc) * 8) * 1024 + (fq * 16 + fr) * 16;
        const unsigned char* gqb = G + ((size_t)(gn * 8 + (u.c0 >> 8)) * 64 + (u.r0 >> 8)) * 65536 + (size_t)((wr * 4 + wc) * 8) * 1024 + (fq * 16 + fr) * 16;
#pragma unroll
        for (int ai = 0; ai < 2; ++ai)
#pragma unroll
            for (int m = 0; m < 4; ++m) { qc[ai][m] = __builtin_nontemporal_load((const u32x4*)(gpb + (ai * 4 + m) * 1024));
                if (!LAST) qn[ai][m] = *(const u32x4*)(gqb + (ai * 4 + m) * 1024); }
#pragma unroll
        for (int ai = 0; ai < 2; ++ai) {
#pragma unroll
            for (int m = 0; m < 4; ++m) { const int row = row0 + ai * HALF + m * 16;
#pragma unroll
                for (int bj = 0; bj < 2; ++bj) {
                    const unsigned c0_ = bj ? qc[ai][m].z : qc[ai][m].x, c1_ = bj ? qc[ai][m].w : qc[ai][m].y;
                    f32x2 f[4];
#pragma unroll
                    for (int q = 0; q < 4; ++q) { const unsigned wc_ = (q < 2) ? c0_ : c1_; f[q] = rcp2(onepexp(wc_, (q & 1) != 0));
                        if (!LAST) { const unsigned n0_ = bj ? qn[ai][m].z : qn[ai][m].x, n1_ = bj ? qn[ai][m].w : qn[ai][m].y; const unsigned wn_ = (q < 2) ? n0_ : n1_; f[q] = f[q] * onepexp(wn_, (q & 1) != 0); } }
                    const f32x4 a0 = acc[ai][bj][m][0], a1 = acc[ai][bj][m][1];
                    const f32x2 p0 = __builtin_shufflevector(a0, a0, 0, 1) * f[0], p1 = __builtin_shufflevector(a0, a0, 2, 3) * f[1], p2 = __builtin_shufflevector(a1, a1, 0, 1) * f[2], p3 = __builtin_shufflevector(a1, a1, 2, 3) * f[3];
                    if (LAST) { u32x4 w; w.x = cvt_pk_bf16(p0.x, p0.y); w.y = cvt_pk_bf16(p1.x, p1.y); w.z = cvt_pk_bf16(p2.x, p2.y); w.w = cvt_pk_bf16(p3.x, p3.y);
                        *(u32x4*)(MG + (size_t)row * 2048 + col0 + bj * HALF) = w; }
                    else { acc[ai][bj][m][0] = __builtin_shufflevector(p0, p1, 0, 1, 2, 3); acc[ai][bj][m][1] = __builtin_shufflevector(p2, p3, 0, 1, 2, 3); } } } }
    }
};
struct EpiResid {
    static __device__ __forceinline__ bool keep_acc(const Unit&) { return false; }
    const bf16_t* XN; const float* RMS; const float* Gm; bf16_t* O;
    __device__ __forceinline__ void operator()(const f32x4 (&acc)[2][2][4][2], const Unit& u, int wr, int wc, int fr, int fq) const {
        const int row0 = u.r0 + wr * 64 + fr, col0 = u.c0 + wc * 32 + 8 * fq;
        float rg[2][8];
#pragma unroll
        for (int bj = 0; bj < 2; ++bj) { const f32x4 g0 = *(const f32x4*)(Gm + col0 + bj * HALF), g1 = *(const f32x4*)(Gm + col0 + bj * HALF + 4);
            rg[bj][0] = __builtin_amdgcn_rcpf(g0.x); rg[bj][1] = __builtin_amdgcn_rcpf(g0.y); rg[bj][2] = __builtin_amdgcn_rcpf(g0.z); rg[bj][3] = __builtin_amdgcn_rcpf(g0.w);
            rg[bj][4] = __builtin_amdgcn_rcpf(g1.x); rg[bj][5] = __builtin_amdgcn_rcpf(g1.y); rg[bj][6] = __builtin_amdgcn_rcpf(g1.z); rg[bj][7] = __builtin_amdgcn_rcpf(g1.w); }
#pragma unroll
        for (int ai = 0; ai < 2; ++ai) {
            u32x4 xq[4][2]; float rmq[4];
#pragma unroll
            for (int m = 0; m < 4; ++m) { const int row = row0 + ai * HALF + m * 16; const size_t off = (size_t)row * 2048 + col0; rmq[m] = RMS[row];
#pragma unroll
                for (int bj = 0; bj < 2; ++bj) xq[m][bj] = *(const u32x4*)(XN + off + bj * HALF); }
#pragma unroll
            for (int m = 0; m < 4; ++m) { const int row = row0 + ai * HALF + m * 16; const size_t off = (size_t)row * 2048 + col0; const f32x2 rm2 = (f32x2){rmq[m], rmq[m]};
#pragma unroll
                for (int bj = 0; bj < 2; ++bj) { const u32x4 xn = xq[m][bj];
                    const f32x4 a0 = acc[ai][bj][m][0], a1 = acc[ai][bj][m][1];
                    const f32x2 x0 = (f32x2){bf_lo(xn.x), bf_hi(xn.x)}, x1 = (f32x2){bf_lo(xn.y), bf_hi(xn.y)}, x2 = (f32x2){bf_lo(xn.z), bf_hi(xn.z)}, x3 = (f32x2){bf_lo(xn.w), bf_hi(xn.w)};
                    const f32x2 g0 = (f32x2){rg[bj][0], rg[bj][1]} * rm2, g1 = (f32x2){rg[bj][2], rg[bj][3]} * rm2, g2 = (f32x2){rg[bj][4], rg[bj][5]} * rm2, g3 = (f32x2){rg[bj][6], rg[bj][7]} * rm2;
                    const f32x2 p0 = x0 * g0 + __builtin_shufflevector(a0, a0, 0, 1), p1 = x1 * g1 + __builtin_shufflevector(a0, a0, 2, 3), p2 = x2 * g2 + __builtin_shufflevector(a1, a1, 0, 1), p3 = x3 * g3 + __builtin_shufflevector(a1, a1, 2, 3);
                    u32x4 w; w.x = cvt_pk_bf16(p0.x, p0.y); w.y = cvt_pk_bf16(p1.x, p1.y); w.z = cvt_pk_bf16(p2.x, p2.y); w.w = cvt_pk_bf16(p3.x, p3.y);
                    *(u32x4*)(O + off + bj * HALF) = w; } } }
    }
};
struct EpiSwiGLU8 {
    static __device__ __forceinline__ bool keep_acc(const Unit&) { return false; }
    unsigned char* H; float inmul;
    __device__ __forceinline__ void operator()(const f32x4 (&acc)[2][2][4][2], const Unit& u, int wr, int wc, int fr, int fq) const {
        const int row0 = u.r0 + wr * 64 + fr, col0 = u.c0 + wc * 32 + 8 * fq;
        const float K = inmul * inmul * SC_HID8, iK = 1.0f / K, l2 = __builtin_log2f(iK), kk = -1.44269504089f * inmul;
        const f32x2 k2 = (f32x2){kk, kk}, l22 = (f32x2){l2, l2}, iK2 = (f32x2){iK, iK};
#pragma unroll
        for (int ai = 0; ai < 2; ++ai)
#pragma unroll
            for (int m = 0; m < 4; ++m) { unsigned char* rowp = H + (size_t)(row0 + ai * HALF + m * 16) * 2048 + col0;
                f32x2 h[4];
#pragma unroll
                for (int n = 0; n < 2; ++n)
#pragma unroll
                    for (int p = 0; p < 2; ++p) { const f32x4 g4 = acc[ai][0][m][n], u4 = acc[ai][1][m][n];
                        const f32x2 g2 = p ? __builtin_shufflevector(g4, g4, 2, 3) : __builtin_shufflevector(g4, g4, 0, 1), u2 = p ? __builtin_shufflevector(u4, u4, 2, 3) : __builtin_shufflevector(u4, u4, 0, 1);
                        const f32x2 ar = g2 * k2 + l22; f32x2 d; d.x = __builtin_amdgcn_exp2f(ar.x); d.y = __builtin_amdgcn_exp2f(ar.y); d = d + iK2;
                        f32x2 r; r.x = __builtin_amdgcn_rcpf(d.x); r.y = __builtin_amdgcn_rcpf(d.y);
                        h[2 * n + p] = (g2 * u2) * r; }
                u32x2 w; w.x = cvt4_fp8(h[0].x, h[0].y, h[1].x, h[1].y); w.y = cvt4_fp8(h[2].x, h[2].y, h[3].x, h[3].y);
                *(u32x2*)rowp = w; }
    }
};
}

struct Args {
    const float* x; const float* mem; const float* norm_mix_g; const float* norm_mem_g; const float* w_in; const float* pool_w; const float* pool_scale; const float* fourier_w;
    const float* w_kv; const float* proj_pool; const float* proj_fourier; const float* proj_mem; const float* w_out; const float* norm_ffn_g; const float* w_router;
    const float* w_gate; const float* w_up; const float* w_down; const float* norm_final_g;
    float* out; unsigned char* ws; int ph_lo, ph_hi;
};

template <bool FP8>
__device__ __forceinline__ void p0_tile64(const float* W, int N, int k0, int n0, void* WT, int ldt, int drow0, const float* kscale, float mul, int lane) {
    if constexpr (FP8) {
        const int lr = lane >> 4, lc = 4 * (lane & 15);
        f32x4 v[16];
#pragma unroll
        for (int i = 0; i < 16; ++i) v[i] = __builtin_nontemporal_load((const f32x4*)(W + (size_t)(k0 + 16 * lr + i) * N + n0 + lc));
#pragma unroll
        for (int i = 0; i < 16; ++i) { float sc = mul; if (kscale) sc *= kscale[k0 + 16 * lr + i]; v[i] = v[i] * sc; }
#pragma unroll
        for (int n = 0; n < 4; ++n) { u32x4 o;
            o.x = cvt4_fp8(v[0][n], v[1][n], v[2][n], v[3][n]); o.y = cvt4_fp8(v[4][n], v[5][n], v[6][n], v[7][n]);
            o.z = cvt4_fp8(v[8][n], v[9][n], v[10][n], v[11][n]); o.w = cvt4_fp8(v[12][n], v[13][n], v[14][n], v[15][n]);
            *(u32x4*)((unsigned char*)WT + (size_t)(drow0 + lc + n) * ldt + k0 + 16 * lr) = o; }
    } else {
        const int kq = lane & 7, cg = lane >> 3;
        f32x4 v[2][8];
#pragma unroll
        for (int h = 0; h < 2; ++h)
#pragma unroll
            for (int i = 0; i < 8; ++i) v[h][i] = __builtin_nontemporal_load((const f32x4*)(W + (size_t)(k0 + 8 * kq + i) * N + n0 + 32 * h + 4 * cg));
        if (kscale) {
#pragma unroll
            for (int i = 0; i < 8; ++i) { const float sc = kscale[k0 + 8 * kq + i]; v[0][i] = v[0][i] * sc; v[1][i] = v[1][i] * sc; } }
#pragma unroll
        for (int h = 0; h < 2; ++h)
#pragma unroll
            for (int n = 0; n < 4; ++n) { u32x4 o;
                o.x = cvt_pk_bf16(v[h][0][n], v[h][1][n]); o.y = cvt_pk_bf16(v[h][2][n], v[h][3][n]); o.z = cvt_pk_bf16(v[h][4][n], v[h][5][n]); o.w = cvt_pk_bf16(v[h][6][n], v[h][7][n]);
                *(u32x4*)((bf16_t*)WT + (size_t)(drow0 + 32 * h + 4 * cg + n) * ldt + k0 + 8 * kq) = o; }
    }
}
__device__ __forceinline__ void rms_row_to_bf16(const float* xrow, const float* g, bf16_t* orow, unsigned char* orow8, int lane) {
    const f32x4* xr = (const f32x4*)xrow + lane; const f32x4* gr = (const f32x4*)g + lane;
    f32x4 v[8]; float s = 0.f;
#pragma unroll
    for (int j = 0; j < 8; ++j) { v[j] = __builtin_nontemporal_load(xr + 64 * j); s += (v[j].x * v[j].x + v[j].y * v[j].y) + (v[j].z * v[j].z + v[j].w * v[j].w); }
    const float inv = 1.0f / sqrtf(wave_sum(s) * (1.f / DM) + EPS);
    u32x2* o8 = (u32x2*)orow + lane;
#pragma unroll
    for (int j = 0; j < 8; ++j) { const f32x4 gg = gr[64 * j]; const f32x4 h = v[j] * inv * gg; u32x2 w; w.x = cvt_pk_bf16(h.x, h.y); w.y = cvt_pk_bf16(h.z, h.w); o8[64 * j] = w;
        if (orow8) ((unsigned*)orow8)[64 * j + lane] = cvt4_fp8(h.x * SC_H8, h.y * SC_H8, h.z * SC_H8, h.w * SC_H8); }
}

struct ExItem { const float* src; unsigned char* dst; int k0, n0, drow0; };
__device__ __forceinline__ ExItem ex_item(const Args& a, int r) {
    constexpr int I_EX = 32 * 32; const int idx = (r % 3 == 2) ? 32768 + r / 3 : r - r / 3; const int mat = idx / I_EX, w = idx % I_EX, type = mat / 16, e = mat % 16, kb = w / 32, nb = w % 32, n0 = nb * 64;
    ExItem it; it.src = (type == 0 ? a.w_gate : (type == 1 ? a.w_up : a.w_down)) + (size_t)e * 2048 * 2048; it.k0 = kb * 64; it.n0 = n0;
    if (type < 2) { it.dst = a.ws + WS_WGUT + (size_t)e * 4096 * 2048; it.drow0 = ((n0 >> 7) << 8) + (n0 & 127) + (type == 1 ? 128 : 0); }
    else { it.dst = a.ws + WS_WDT + (size_t)e * 2048 * 2048; it.drow0 = n0; }
    return it;
}
__device__ __forceinline__ void ex_load(const ExItem& it, f32x4 (&v)[16], int lane) {
    const int lr = lane >> 4, lc = 4 * (lane & 15);
#pragma unroll
    for (int i = 0; i < 16; ++i) v[i] = __builtin_nontemporal_load((const f32x4*)(it.src + (size_t)(it.k0 + 16 * lr + i) * 2048 + it.n0 + lc));
}
__device__ __forceinline__ void ex_store(const ExItem& it, const f32x4 (&v)[16], int lane) {
    const int lr = lane >> 4, lc = 4 * (lane & 15);
#pragma unroll
    for (int n = 0; n < 4; ++n) { u32x4 o;
        o.x = cvt4_fp8(v[0][n] * SC_W8, v[1][n] * SC_W8, v[2][n] * SC_W8, v[3][n] * SC_W8); o.y = cvt4_fp8(v[4][n] * SC_W8, v[5][n] * SC_W8, v[6][n] * SC_W8, v[7][n] * SC_W8);
        o.z = cvt4_fp8(v[8][n] * SC_W8, v[9][n] * SC_W8, v[10][n] * SC_W8, v[11][n] * SC_W8); o.w = cvt4_fp8(v[12][n] * SC_W8, v[13][n] * SC_W8, v[14][n] * SC_W8, v[15][n] * SC_W8);
        __builtin_nontemporal_store(o, (u32x4*)(it.dst + (size_t)(it.drow0 + lc + n) * 2048 + it.k0 + 16 * lr)); }
}
__device__ __forceinline__ void convert_experts(const Args& a, int c, int G, int wave, int lane, int part, int nparts, int down = 0) {
    constexpr int NEXP = 48 * 32 * 32;
    int start, cnt;
    if (G == 256) { if (c >= 64 && c < 96) { cnt = 160; start = (c - 64) * 160; } else if (c < 64) { cnt = 176; start = 5120 + c * 176; } else if (c < 128) { cnt = 224; start = 16384 + (c - 96) * 224; } else { cnt = 200; start = 23552 + (c - 128) * 200; } }
    else { const int per = (NEXP + G - 1) / G; start = c * per; cnt = (start + per <= NEXP) ? per : (NEXP > start ? NEXP - start : 0); }
    { const int per = (cnt + nparts - 1) / nparts, s2 = start + part * per, e2 = (s2 + per < start + cnt) ? s2 + per : start + cnt; start = s2; cnt = e2 > s2 ? e2 - s2 : 0; }
    const int end = start + cnt;
#define EX_NEXT(r_) do { while ((r_) < end && (((r_) % 3 == 2) != (down != 0))) (r_) += NWAVES; } while (0)
    int r = start + wave; EX_NEXT(r); if (r >= end) return;
    f32x4 va[16], vb[16];
    ExItem ia = ex_item(a, r), ib; ex_load(ia, va, lane);
    for (;;) {
        int rn = r + NWAVES; EX_NEXT(rn); const bool hb = rn < end; if (hb) { ib = ex_item(a, rn); ex_load(ib, vb, lane); }
        ex_store(ia, va, lane);
        if (!hb) break;
        r = rn;
        rn = r + NWAVES; EX_NEXT(rn); const bool ha = rn < end; if (ha) { ia = ex_item(a, rn); ex_load(ia, va, lane); }
        ex_store(ib, vb, lane);
        if (!ha) break;
        r = rn;
    }
#undef EX_NEXT
}
__device__ __forceinline__ void rms_row2_to_bf16(const float* xrow, const float* g, bf16_t* orow, unsigned char* orow8, float* rms2, int lane) {
    const f32x4* xr = (const f32x4*)xrow + lane; const f32x4* gr = (const f32x4*)g + lane;
    f32x4 v[2][8]; float s0 = 0.f, s1 = 0.f;
#pragma unroll
    for (int j = 0; j < 8; ++j) { v[0][j] = __builtin_nontemporal_load(xr + 64 * j); v[1][j] = __builtin_nontemporal_load(xr + 512 + 64 * j); }
#pragma unroll
    for (int j = 0; j < 8; ++j) { s0 += (v[0][j].x * v[0][j].x + v[0][j].y * v[0][j].y) + (v[0][j].z * v[0][j].z + v[0][j].w * v[0][j].w); s1 += (v[1][j].x * v[1][j].x + v[1][j].y * v[1][j].y) + (v[1][j].z * v[1][j].z + v[1][j].w * v[1][j].w); }
    const float r0 = sqrtf(wave_sum(s0) * (1.f / DM) + EPS), r1 = sqrtf(wave_sum(s1) * (1.f / DM) + EPS), inv0 = 1.0f / r0, inv1 = 1.0f / r1;
    if (lane == 0) { rms2[0] = r0; rms2[1] = r1; }
    u32x2* o8 = (u32x2*)orow + lane; unsigned* of8 = (unsigned*)orow8 + lane;
#pragma unroll
    for (int j = 0; j < 8; ++j) { const f32x4 gg = gr[64 * j]; const f32x4 h0 = v[0][j] * inv0 * gg, h1 = v[1][j] * inv1 * gg;
        u32x2 w0; w0.x = cvt_pk_bf16(h0.x, h0.y); w0.y = cvt_pk_bf16(h0.z, h0.w); o8[64 * j] = w0;
        u32x2 w1; w1.x = cvt_pk_bf16(h1.x, h1.y); w1.y = cvt_pk_bf16(h1.z, h1.w); o8[512 + 64 * j] = w1;
        of8[64 * j] = cvt4_fp8(h0.x * SC_H8, h0.y * SC_H8, h0.z * SC_H8, h0.w * SC_H8); of8[512 + 64 * j] = cvt4_fp8(h1.x * SC_H8, h1.y * SC_H8, h1.z * SC_H8, h1.w * SC_H8); }
}
__device__ __forceinline__ void phase0(const Args& a, LAS unsigned char* lds, int gw, int NGW, int wave, int lane) {
    unsigned char* ws = a.ws;
    STAMP0(0);
    LAS float* tab = (LAS float*)lds;
    { const int t_ = wave * 64 + lane; if (t_ < 128) { tab[t_] = cospif((float)t_ * (1.0f / 64.0f)); tab[128 + t_] = -sinpif((float)t_ * (1.0f / 64.0f)); } }
    __syncthreads();
    auto stream_part = [&]() {
        constexpr int I_WIN = 32 * 128, I_KV = 32 * 16, I_PP = 16 * 32, I_PF = 8 * 32, I_PM = 8 * 32, I_WO = 32 * 32;
        constexpr int NITEMS = I_WIN + I_KV + I_PP + I_PF + I_PM + I_WO;
        for (int it = gw; it < NITEMS; it += NGW) {
            int r = it;
            if (r < I_WIN) { const int kb = r / 128, nb = r % 128;
                if (nb < 32) p0_tile64<false>(a.w_in, 8192, kb * 64, nb * 64, ws + WS_WINT, 2048, nb * 64, nullptr, 1.f, lane);
                else p0_tile64<true>(a.w_in, 8192, kb * 64, nb * 64, ws + WS_WIN8, 2048, (nb - 32) * 64, nullptr, SC_W8, lane);
                continue; } r -= I_WIN;
            if (r < I_KV) { const int kb = r / 16, nb = r % 16; p0_tile64<false>(a.w_kv, 1024, kb * 64, nb * 64, ws + WS_WKVT, 2048, nb * 64, nullptr, 1.f, lane); continue; } r -= I_KV;
            if (r < I_PP) { const int kb = r / 32, nb = r % 32; p0_tile64<false>(a.proj_pool, 2048, kb * 64, nb * 64, ws + WS_PPST, 1024, nb * 64, a.pool_scale, 1.f, lane); continue; } r -= I_PP;
            if (r < I_PF) { const int kb = r / 32, nb = r % 32; p0_tile64<false>(a.proj_fourier, 2048, kb * 64, nb * 64, ws + WS_PFT, 1024, nb * 64, nullptr, 1.f, lane); continue; } r -= I_PF;
            if (r < I_PM) { const int kb = r / 32, nb = r % 32; p0_tile64<false>(a.proj_mem, 2048, kb * 64, nb * 64, (bf16_t*)(ws + WS_BCAT + B_PM), CAT_LD, nb * 64, nullptr, 1.f, lane); continue; } r -= I_PM;
            { const int kb = r / 32, nb = r % 32; p0_tile64<false>(a.w_out, 2048, kb * 64, nb * 64, ws + WS_WOT, 2048, nb * 64, nullptr, 1.f, lane); }
        }
        for (int m = 2 * gw; m < T; m += 2 * NGW) rms_row2_to_bf16(a.x + (size_t)m * DM, a.norm_mix_g, (bf16_t*)(ws + WS_XN) + (size_t)m * DM, ws + WS_XN8 + (size_t)m * DM, (float*)(ws + WS_RMS) + m, lane);
        for (int m = gw; m < NBATCH * MEML; m += NGW) rms_row_to_bf16(a.mem + (size_t)m * DM, a.norm_mem_g, (bf16_t*)(ws + WS_MN) + (size_t)m * DM, nullptr, lane);
    };
    auto table_part = [&]() {
        const int gt = gw * 64 + lane, NGT = NGW * 64;
        for (int i = gt; i < 1024 * 128; i += NGT) { const int row = i >> 7, col = (i & 127) * 8, g = row >> 8, c = row & 255;
            u32x4 o = (u32x4){0u, 0u, 0u, 0u};
            if ((col >> 8) == g) { const float* p = a.pool_w + ((size_t)g * 256 + c) * 256 + (col & 255); const f32x4 v0 = *(const f32x4*)p, v1 = *(const f32x4*)(p + 4);
                o.x = pk2(v0.x, v0.y); o.y = pk2(v0.z, v0.w); o.z = pk2(v1.x, v1.y); o.w = pk2(v1.z, v1.w); }
            *(u32x4*)((bf16_t*)(ws + WS_PWBD) + (size_t)row * 1024 + col) = o; }
        for (int i = gt; i < 16 * 2048; i += NGT) { const int e = i >> 11, d = i & 2047; ((bf16_t*)(ws + WS_GWT))[i] = (bf16_t)f2bf(a.norm_ffn_g[d] * a.w_router[d * 16 + e]); }
        for (int i = gt; i < 1024 * 512; i += NGT) { const int row = i >> 9, col = i & 511, cs = row >> 9, g = (row >> 7) & 3, c = row & 127, g2 = col >> 7, d = col & 127;
            float v = 0.f;
            if (g2 == g) { const float* fw = a.fourier_w + (size_t)g * 128 * 128 + d; const LAS float* tb = tab + (cs ? 128 : 0);
    #pragma unroll 32
                for (int j = 0; j < 128; ++j) v += tb[(c * j) & 127] * fw[(size_t)j * 128]; }
            ((bf16_t*)(ws + WS_M1BD))[(size_t)row * 1024 + col] = (bf16_t)f2bf(v); }
        for (int i = gt; i < 2048 * 128; i += NGT) { const int R = i >> 7, s0 = (i & 127) * 8, tab = R >> 9, m = R & 511;
            float v[8];
    #pragma unroll
            for (int j = 0; j < 8; ++j) { const int s = s0 + j; const float ang = (tab & 2) ? (float)(((2 * m + 1) * s) & 2047) * (1.0f / 1024.0f) : (float)((m * s) & 1023) * (1.0f / 512.0f);
                v[j] = ((tab & 1) ? sinpif(ang) : cospif(ang)) * (1.0f / 512.0f); }
            u32x4 o; o.x = pk2(v[0], v[1]); o.y = pk2(v[2], v[3]); o.z = pk2(v[4], v[5]); o.w = pk2(v[6], v[7]);
            *(u32x4*)((bf16_t*)(ws + WS_TW) + (size_t)R * 1024 + s0) = o; }
    };
    if (wave >= 4) { table_part(); stream_part(); } else { stream_part(); table_part(); }
    STAMP0(5);
}

__device__ __forceinline__ void dft_nyquist_rows(const Args& a, int widx, int nw, int lane) {
    const bf16_t* UE = (const bf16_t*)(a.ws + WS_UT); bf16_t* PQ = (bf16_t*)(a.ws + WS_ACAT + A_PQ);
    for (int r = widx; r < NBATCH * 512; r += nw) {
        const u32x4* p = (const u32x4*)(UE + (size_t)r * 1024 + lane * 16);
        const u32x4 v0 = p[0], v1 = p[1];
        float s = 0.f;
#define NYQ_ACC(V_) s += (bf_lo(V_.x) - bf_hi(V_.x)) + (bf_lo(V_.y) - bf_hi(V_.y)) + (bf_lo(V_.z) - bf_hi(V_.z)) + (bf_lo(V_.w) - bf_hi(V_.w));
        NYQ_ACC(v0) NYQ_ACC(v1)
#undef NYQ_ACC
        s = wave_sum(s) * (1.0f / 512.0f);
        if (lane == 0) { bf16_t* o = PQ + (size_t)((r >> 9) * SEQ + SEQ / 2) * CAT_LD + (r & 511); o[0] = (bf16_t)f2bf(s); o[512] = (bf16_t)f2bf(0.f); }
    }
}

__device__ __forceinline__ void pool_pass(const Args& a, int itbeg, int itend, int nw, int lane) {
    const bf16_t* ZM = (const bf16_t*)(a.ws + WS_ZM); bf16_t* AC = (bf16_t*)(a.ws + WS_ACAT);
    for (int it = itbeg; it < itend; it += nw) {
        const int run = it >> 1, hf = it & 1, chunk = hf * 64 + lane, ch0 = chunk * 8, g = chunk >> 5, hw = 1 << g;
        const int t0 = run * 8, b = t0 >> 11, s0 = t0 & 2047; const bf16_t* base = ZM + (size_t)b * SEQ * 2048 + ch0;
        u32x4 rw[23];
#pragma unroll
        for (int r = 0; r < 23; ++r) { const int d = r - 8, s = s0 + d; rw[r] = (u32x4){0u, 0u, 0u, 0u};
            if (d >= -hw && d < 8 + hw - 1 && s >= 0 && s < SEQ) rw[r] = *(const u32x4*)(base + (size_t)s * 2048); }
        float sum[8];
#pragma unroll
        for (int j = 0; j < 8; ++j) sum[j] = 0.f;
#pragma unroll
        for (int r = 0; r < 16; ++r) { const int d = r - 8; if (d >= -hw && d < hw) { const u32x4 w = rw[r];
            sum[0] += bf_lo(w.x); sum[1] += bf_hi(w.x); sum[2] += bf_lo(w.y); sum[3] += bf_hi(w.y); sum[4] += bf_lo(w.z); sum[5] += bf_hi(w.z); sum[6] += bf_lo(w.w); sum[7] += bf_hi(w.w); } }
#pragma unroll
        for (int i = 0; i < 8; ++i) { const int s = s0 + i; const int lo = (s - hw) < 0 ? 0 : (s - hw), hi = (s + hw) > SEQ ? SEQ : (s + hw); const float rc = 1.0f / (float)(hi - lo);
            const u32x4 c = rw[8 + i];
            u32x4 o; o.x = cvt_pk_bf16(sum[0] * rc - bf_lo(c.x), sum[1] * rc - bf_hi(c.x)); o.y = cvt_pk_bf16(sum[2] * rc - bf_lo(c.y), sum[3] * rc - bf_hi(c.y));
            o.z = cvt_pk_bf16(sum[4] * rc - bf_lo(c.z), sum[5] * rc - bf_hi(c.z)); o.w = cvt_pk_bf16(sum[6] * rc - bf_lo(c.w), sum[7] * rc - bf_hi(c.w));
            *(u32x4*)(AC + (size_t)(t0 + i) * CAT_LD + ch0) = o;
            if (i < 7) { u32x4 wa = (u32x4){0u, 0u, 0u, 0u}, wd = wa;
#pragma unroll
                for (int k = 0; k < 4; ++k) { const int h2 = 1 << k; if (hw == h2) { wa = rw[8 + i + h2]; wd = rw[8 + i - h2]; } }
                sum[0] += bf_lo(wa.x) - bf_lo(wd.x); sum[1] += bf_hi(wa.x) - bf_hi(wd.x); sum[2] += bf_lo(wa.y) - bf_lo(wd.y); sum[3] += bf_hi(wa.y) - bf_hi(wd.y);
                sum[4] += bf_lo(wa.z) - bf_lo(wd.z); sum[5] += bf_hi(wa.z) - bf_hi(wd.z); sum[6] += bf_lo(wa.w) - bf_lo(wd.w); sum[7] += bf_hi(wa.w) - bf_hi(wd.w); } }
    }
}

constexpr int ATT_KSTR = 272, ATT_VSTR = 520, ATT_VOFF = 256 * ATT_KSTR;
__device__ __forceinline__ void attn_unit(const Args& a, LAS unsigned char* lds, int b, int h, int qb, int wave, int lane, int tid) {
    const bf16_t* ZM = (const bf16_t*)(a.ws + WS_ZM); const bf16_t* KM = (const bf16_t*)(a.ws + WS_KMEM); const bf16_t* VT = (const bf16_t*)(a.ws + WS_VT); bf16_t* AC = (bf16_t*)(a.ws + WS_ACAT);
    asm volatile("" : "+v"(tid), "+v"(lane));
    const int l31 = lane & 31, hh = lane >> 5;
#pragma unroll
    for (int i = 0; i < 8; ++i) { const int ch = tid + 512 * i, row = ch >> 4, cc = ch & 15;
        const u32x4 v = *(const u32x4*)(KM + (size_t)(b * MEML + row) * 512 + h * 128 + 8 * cc);
        *(LAS u32x4*)(lds + row * ATT_KSTR + 16 * cc) = v; }
#pragma unroll
    for (int i = 0; i < 8; ++i) { const int ch = tid + 512 * i, row = ch >> 5, cc = ch & 31;
        const u32x4 v = *(const u32x4*)(VT + (size_t)(h * 128 + row) * 2048 + b * MEML + 8 * cc);
        LAS unsigned* d = (LAS unsigned*)(lds + ATT_VOFF + row * ATT_VSTR + 16 * cc); d[0] = v.x; d[1] = v.y; d[2] = v.z; d[3] = v.w; }
    const int t = b * SEQ + qb * 256 + wave * 32 + l31;
    bf16x8 qf[8];
    const bf16_t* qp = ZM + (size_t)t * 2048 + 1536 + h * 128 + 8 * hh;
#pragma unroll
    for (int ks = 0; ks < 8; ++ks) qf[ks] = *(const bf16x8*)(qp + 16 * ks);
    __syncthreads();
    f32x16 sc[8];
    const LAS unsigned char* kp = lds + l31 * ATT_KSTR + 16 * hh;
#pragma unroll
    for (int kt = 0; kt < 8; ++kt) { f32x16 acc;
#pragma unroll
        for (int r = 0; r < 16; ++r) acc[r] = 0.f;
#pragma unroll
        for (int ks = 0; ks < 8; ++ks) { const bf16x8 kf = *(const LAS bf16x8*)(kp + (32 * kt) * ATT_KSTR + 32 * ks); acc = __builtin_amdgcn_mfma_f32_32x32x16_bf16(kf, qf[ks], acc, 0, 0, 0); }
        sc[kt] = acc; }
    float mx = -3.0e38f;
#pragma unroll
    for (int kt = 0; kt < 8; ++kt)
#pragma unroll
        for (int r = 0; r < 16; ++r) mx = fmaxf(mx, sc[kt][r]);
    mx = fmaxf(mx, __shfl_xor(mx, 32));
    const float cs = 0.08838834764831845f * 1.44269504089f;
    float sum = 0.f;
#pragma unroll
    for (int kt = 0; kt < 8; ++kt)
#pragma unroll
        for (int r = 0; r < 16; ++r) { const float p = __builtin_amdgcn_exp2f((sc[kt][r] - mx) * cs); sc[kt][r] = p; sum += p; }
    sum += __shfl_xor(sum, 32);
    const float rinv = 1.0f / sum;
    bf16x8 pf[8][2];
#pragma unroll
    for (int kt = 0; kt < 8; ++kt)
#pragma unroll
        for (int s = 0; s < 2; ++s) { u32x4 w; w.x = cvt_pk_bf16(sc[kt][8 * s + 0], sc[kt][8 * s + 1]); w.y = cvt_pk_bf16(sc[kt][8 * s + 2], sc[kt][8 * s + 3]);
            w.z = cvt_pk_bf16(sc[kt][8 * s + 4], sc[kt][8 * s + 5]); w.w = cvt_pk_bf16(sc[kt][8 * s + 6], sc[kt][8 * s + 7]); pf[kt][s] = __builtin_bit_cast(bf16x8, w); }
#pragma unroll
    for (int dt = 0; dt < 4; ++dt) { f32x16 o;
#pragma unroll
        for (int r = 0; r < 16; ++r) o[r] = 0.f;
        const LAS unsigned char* vp = lds + ATT_VOFF + (32 * dt + l31) * ATT_VSTR + 8 * hh;
#pragma unroll
        for (int kt = 0; kt < 8; ++kt)
#pragma unroll
            for (int s = 0; s < 2; ++s) { const u32x2 v0 = *(const LAS u32x2*)(vp + 64 * kt + 32 * s), v1 = *(const LAS u32x2*)(vp + 64 * kt + 32 * s + 16);
                const u32x4 vv = (u32x4){v0.x, v0.y, v1.x, v1.y};
                o = __builtin_amdgcn_mfma_f32_32x32x16_bf16(__builtin_bit_cast(bf16x8, vv), pf[kt][s], o, 0, 0, 0); }
        bf16_t* op = (bf16_t*)(a.ws + WS_XN8) + (size_t)t * CAT_LD + h * 128 + 32 * dt + 4 * hh;
#pragma unroll
        for (int rg = 0; rg < 4; ++rg) { u32x2 w; w.x = cvt_pk_bf16(o[4 * rg + 0] * rinv, o[4 * rg + 1] * rinv); w.y = cvt_pk_bf16(o[4 * rg + 2] * rinv, o[4 * rg + 3] * rinv);
            *(u32x2*)(op + 8 * rg) = w; } }
    __syncthreads();
}

__device__ __forceinline__ void router_phase(const Args& a, LAS unsigned char* lds, int vcu, int G, int wave, int lane, int tid) {
    const bf16_t* X1 = (const bf16_t*)(a.ws + WS_X1B); const bf16_t* GWT = (const bf16_t*)(a.ws + WS_GWT); unsigned char* H2 = (unsigned char*)(a.ws + WS_H2); float* AFF = (float*)(a.ws + WS_AFF);
    LAS float* part = (LAS float*)lds;
    LAS float* ssq = (LAS float*)(lds + 32768);
    LAS float* invs = (LAS float*)(lds + 32768 + 2048);
    const int fr = lane & 15, fq = lane >> 4;
    bf16x8 bfrag[8];
#pragma unroll
    for (int ks = 0; ks < 8; ++ks) bfrag[ks] = *(const bf16x8*)(GWT + (size_t)fr * 2048 + 256 * wave + 32 * ks + 8 * fq);
    f32x4 gg[8];
#pragma unroll
    for (int j = 0; j < 8; ++j) gg[j] = ((const f32x4*)a.norm_ffn_g)[64 * j + lane];
    STAMPN(6, 2);
    for (int blk = vcu; blk < T / 64; blk += G) { const int row0 = blk * 64;
#pragma unroll
        for (int rt = 0; rt < 4; ++rt) { f32x4 acc = (f32x4){0.f, 0.f, 0.f, 0.f}; float sq = 0.f;
            const bf16_t* xp = X1 + (size_t)(row0 + 16 * rt + fr) * DM + 256 * wave + 8 * fq;
            bf16x8 af[8];
#pragma unroll
            for (int ks = 0; ks < 8; ++ks) af[ks] = *(const bf16x8*)(xp + 32 * ks);
#pragma unroll
            for (int ks = 0; ks < 8; ++ks) { acc = __builtin_amdgcn_mfma_f32_16x16x32_bf16(af[ks], bfrag[ks], acc, 0, 0, 0);
                const u32x4 w = __builtin_bit_cast(u32x4, af[ks]);
                const float v0 = bf_lo(w.x), v1 = bf_hi(w.x), v2 = bf_lo(w.y), v3 = bf_hi(w.y), v4 = bf_lo(w.z), v5 = bf_hi(w.z), v6 = bf_lo(w.w), v7 = bf_hi(w.w);
                sq += (v0 * v0 + v1 * v1) + (v2 * v2 + v3 * v3) + (v4 * v4 + v5 * v5) + (v6 * v6 + v7 * v7); }
            sq += __shfl_xor(sq, 16); sq += __shfl_xor(sq, 32);
            if (fq == 0) ssq[wave * 64 + 16 * rt + fr] = sq;
#pragma unroll
            for (int j = 0; j < 4; ++j) part[(wave * 64 + 16 * rt + 4 * fq + j) * 16 + fr] = acc[j]; }
        __syncthreads(); STAMPN(6, 3);
#pragma unroll
        for (int ps = 0; ps < 2; ++ps) { const int row = 32 * ps + (tid >> 4), e = tid & 15;
            float s = 0.f, q = 0.f;
#pragma unroll
            for (int w = 0; w < 8; ++w) { s += part[(w * 64 + row) * 16 + e]; q += ssq[w * 64 + row]; }
            const float inv = 1.0f / sqrtf(q * (1.f / DM) + EPS), lg = s * inv;
            float mx = lg;
#pragma unroll
            for (int o = 1; o < 16; o <<= 1) mx = fmaxf(mx, __shfl_xor(mx, o));
            const float ex = __expf(lg - mx); float su = ex;
#pragma unroll
            for (int o = 1; o < 16; o <<= 1) su += __shfl_xor(su, o);
            const int t = row0 + row, b = t >> 11, sx = t & 2047;
            AFF[((size_t)b * 16 + e) * SEQ + sx] = ex / su;
            if (e == 0) invs[row] = inv; }
        __syncthreads(); STAMPN(6, 4);
#pragma unroll
        for (int hf = 0; hf < 2; ++hf) { u32x2 xw[4][8];
#pragma unroll
            for (int r = 0; r < 4; ++r) { const u32x2* xr = (const u32x2*)(X1 + (size_t)(row0 + 8 * wave + 4 * hf + r) * DM) + lane;
#pragma unroll
                for (int j = 0; j < 8; ++j) xw[r][j] = __builtin_nontemporal_load(xr + 64 * j); }
#pragma unroll
            for (int r = 0; r < 4; ++r) { const int row = 8 * wave + 4 * hf + r; const float inv = invs[row] * SC_H8; unsigned* hr = (unsigned*)(H2 + (size_t)(row0 + row) * DM) + lane;
#pragma unroll
                for (int j = 0; j < 8; ++j) { const u32x2 w = xw[r][j];
                    hr[64 * j] = cvt4_fp8(bf_lo(w.x) * inv * gg[j].x, bf_hi(w.x) * inv * gg[j].y, bf_lo(w.y) * inv * gg[j].z, bf_hi(w.y) * inv * gg[j].w); } } }
        __syncthreads();
    }
}

__device__ __forceinline__ int wave_isum(int v) {
#pragma unroll
    for (int o = 1; o < 64; o <<= 1) v += __shfl_xor(v, o);
    return v;
}
__device__ __forceinline__ int wave_excl_scan(int v, int ln) {
    int x = v;
#pragma unroll
    for (int o = 1; o < 64; o <<= 1) { const int y = __shfl(x, (ln - o) & 63); x += (ln >= o) ? y : 0; }
    return x - v;
}
__device__ __forceinline__ void topk_phase(const Args& a, LAS unsigned char* lds, int c, int wave, int ln, int tid) {
    if (c >= 256) return;
    const int b = c & 7, e = (c >> 3) & 15, half = c >> 7;
    LAS int* list = (LAS int*)(lds + 1024);
    const float* AFF = (const float*)(a.ws + WS_AFF) + ((size_t)b * 16 + e) * SEQ;
    unsigned u[32];
#pragma unroll
    for (int i = 0; i < 8; ++i) { const u32x4 w = *(const u32x4*)(AFF + 32 * ln + 4 * i); u[4 * i] = w.x; u[4 * i + 1] = w.y; u[4 * i + 2] = w.z; u[4 * i + 3] = w.w; }
    unsigned Tv = 0u;
#pragma unroll 1
    for (int bit = 30; bit >= 0; --bit) { const unsigned cand = Tv | (1u << bit);
        int cnt = 0;
#pragma unroll
        for (int i = 0; i < 32; ++i) cnt += __builtin_popcountll(__builtin_amdgcn_ballot_w64(u[i] >= cand));
        if (cnt >= CAP) Tv = cand; }
    int ngt_l = 0, ntie_l = 0;
#pragma unroll
    for (int i = 0; i < 32; ++i) { ngt_l += (u[i] > Tv) ? 1 : 0; ntie_l += (u[i] == Tv) ? 1 : 0; }
    const int need = CAP - wave_isum(ngt_l);
    int tr = wave_excl_scan(ntie_l, ln);
    asm volatile("" : "+s"(Tv));
    unsigned selmask = 0u; int nsel_l = 0;
#pragma unroll
    for (int i = 0; i < 32; ++i) { const bool t = (u[i] == Tv); const bool s = (u[i] > Tv) || (t && tr < need); tr += t ? 1 : 0; selmask |= s ? (1u << i) : 0u; nsel_l += s ? 1 : 0; }
    int slot = wave_excl_scan(nsel_l, ln);
    u32x2* INV = (u32x2*)(a.ws + WS_INV);
    if ((ln >> 3) == wave) {
#pragma unroll
        for (int i = 0; i < 32; ++i) { const int s = 32 * ln + i; const bool sl = (selmask >> i) & 1u;
            if (half == 0) INV[((size_t)b * SEQ + s) * 16 + e] = (u32x2){sl ? (unsigned)slot : 0xffffffffu, u[i]};
            if (sl) { list[slot] = s; ++slot; } }
    }
    __syncthreads();
    const unsigned char* H2 = (const unsigned char*)(a.ws + WS_H2); unsigned char* XIN = (unsigned char*)(a.ws + WS_XIN);
    for (int q = half * (CAP / NWAVES / 2); q < (half + 1) * (CAP / NWAVES / 2); q += 8) {
        u32x4 v[8][2];
#pragma unroll
        for (int i = 0; i < 8; ++i) { const int s = list[wave + NWAVES * (q + i)];
            const u32x4* src = (const u32x4*)(H2 + ((size_t)b * SEQ + s) * DM) + ln; v[i][0] = src[0]; v[i][1] = src[64]; }
#pragma unroll
        for (int i = 0; i < 8; ++i) { const int slot2 = wave + NWAVES * (q + i);
            u32x4* dst = (u32x4*)(XIN + (((size_t)e * 8 + b) * CAP + slot2) * DM) + ln; dst[0] = v[i][0]; dst[64] = v[i][1]; }
    }
    __syncthreads();
}

__device__ __forceinline__ void combine_phase(const Args& a, int gw, int NGW, int lane) {
    const unsigned char* Y = a.ws + WS_Y; const u32x2* INV = (const u32x2*)(a.ws + WS_INV); const bf16_t* X1 = (const bf16_t*)(a.ws + WS_X1B);
    for (int t = 2 * gw; t < T; t += 2 * NGW) { const int b = t >> 11;
        const u32x2 iv = __builtin_nontemporal_load(INV + (size_t)t * 16 + (lane & 31));
        u32x2 xr0[8], xr1[8];
        { const u32x2* r0 = (const u32x2*)(X1 + (size_t)t * DM) + lane; const u32x2* r1 = r0 + DM / 4;
#pragma unroll
            for (int j = 0; j < 8; ++j) { xr0[j] = __builtin_nontemporal_load(r0 + 64 * j); xr1[j] = __builtin_nontemporal_load(r1 + 64 * j); } }
        const int myinv = (int)iv.x; const unsigned wbits = iv.y; const float myw = __builtin_bit_cast(float, wbits) * (1.0f / SC_Y8);
        const unsigned long long bal = __builtin_amdgcn_ballot_w64(myinv >= 0 && lane < 32);
        unsigned m0 = (unsigned)bal & 0xffffu, m1 = ((unsigned)bal >> 16) & 0xffffu;
        f32x4 v0[8], v1[8];
#pragma unroll
        for (int j = 0; j < 8; ++j) { v0[j] = (f32x4){bf_lo(xr0[j].x), bf_hi(xr0[j].x), bf_lo(xr0[j].y), bf_hi(xr0[j].y)}; v1[j] = (f32x4){bf_lo(xr1[j].x), bf_hi(xr1[j].x), bf_lo(xr1[j].y), bf_hi(xr1[j].y)}; }
        while (m0 | m1) {
            unsigned ya[2][8], yb[2][8]; float wa[2], wb[2]; bool ha[2], hb[2];
#pragma unroll
            for (int k = 0; k < 2; ++k) {
                ha[k] = m0 != 0u; wa[k] = 0.f;
                if (ha[k]) { const int e = __builtin_ctz(m0); m0 &= m0 - 1u; const int s = __builtin_amdgcn_readlane(myinv, e); wa[k] = __builtin_bit_cast(float, __builtin_amdgcn_readlane(__builtin_bit_cast(int, myw), e));
                    const unsigned* yr = (const unsigned*)(Y + (((size_t)e * 8 + b) * CAP + s) * DM) + lane;
#pragma unroll
                    for (int j = 0; j < 8; ++j) ya[k][j] = __builtin_nontemporal_load(yr + 64 * j); }
                hb[k] = m1 != 0u; wb[k] = 0.f;
                if (hb[k]) { const int e = __builtin_ctz(m1); m1 &= m1 - 1u; const int s = __builtin_amdgcn_readlane(myinv, 16 + e); wb[k] = __builtin_bit_cast(float, __builtin_amdgcn_readlane(__builtin_bit_cast(int, myw), 16 + e));
                    const unsigned* yr = (const unsigned*)(Y + (((size_t)e * 8 + b) * CAP + s) * DM) + lane;
#pragma unroll
                    for (int j = 0; j < 8; ++j) yb[k][j] = __builtin_nontemporal_load(yr + 64 * j); } }
#pragma unroll
            for (int k = 0; k < 2; ++k) {
                if (ha[k]) { const float w = wa[k];
#pragma unroll
                    for (int j = 0; j < 8; ++j) { const f32x2 lo = __builtin_amdgcn_cvt_pk_f32_fp8((int)ya[k][j], false), hi = __builtin_amdgcn_cvt_pk_f32_fp8((int)ya[k][j], true);
                        v0[j].x += lo.x * w; v0[j].y += lo.y * w; v0[j].z += hi.x * w; v0[j].w += hi.y * w; } }
                if (hb[k]) { const float w = wb[k];
#pragma unroll
                    for (int j = 0; j < 8; ++j) { const f32x2 lo = __builtin_amdgcn_cvt_pk_f32_fp8((int)yb[k][j], false), hi = __builtin_amdgcn_cvt_pk_f32_fp8((int)yb[k][j], true);
                        v1[j].x += lo.x * w; v1[j].y += lo.y * w; v1[j].z += hi.x * w; v1[j].w += hi.y * w; } } }
        }
        float q0 = 0.f, q1 = 0.f;
#pragma unroll
        for (int j = 0; j < 8; ++j) { q0 += (v0[j].x * v0[j].x + v0[j].y * v0[j].y) + (v0[j].z * v0[j].z + v0[j].w * v0[j].w); q1 += (v1[j].x * v1[j].x + v1[j].y * v1[j].y) + (v1[j].z * v1[j].z + v1[j].w * v1[j].w); }
        const float i0 = 1.0f / sqrtf(wave_sum(q0) * (1.f / DM) + EPS), i1 = 1.0f / sqrtf(wave_sum(q1) * (1.f / DM) + EPS);
        f32x4* o0 = (f32x4*)(a.out + (size_t)t * DM) + lane; f32x4* o1 = o0 + DM / 4;
#pragma unroll
        for (int j = 0; j < 8; ++j) { const f32x4 gg = ((const f32x4*)a.norm_final_g)[64 * j + lane]; __builtin_nontemporal_store(v0[j] * i0 * gg, o0 + 64 * j); __builtin_nontemporal_store(v1[j] * i1 * gg, o1 + 64 * j); }
    }
}

using pg8::Unit;
struct SchedFold {
    unsigned char* ws; int c;
    __device__ __forceinline__ bool next(int i, Unit& u) const {
        if (i > 0 || c >= 64) return false;
        const int L = c & 31, pm = L & 7, pn = L >> 3;
        if (c < 32) { const size_t ko = (size_t)pn * 256 * 2; u.A = (const char*)(ws + WS_PPST) + (size_t)pm * 256 * 1024 * 2 + ko; u.B0 = (const char*)(ws + WS_PWBD) + (size_t)pn * 256 * 1024 * 2 + ko; u.nt = 4; u.c0 = pn * 256; u.r0 = pm * 256; }
        else { const size_t ko = (size_t)(pn & 1) * 256 * 2; u.A = (const char*)(ws + WS_PFT) + (size_t)pm * 256 * 1024 * 2 + ko; u.B0 = (const char*)(ws + WS_M1BD) + (size_t)pn * 256 * 1024 * 2 + ko; u.nt = 4; u.c0 = pn * 256; u.r0 = 2048 + pm * 256; }
        u.aux = 0; return true;
    }
};
struct SchedKV {
    unsigned char* ws; int c;
    __device__ __forceinline__ bool next(int i, Unit& u) const {
        if (i > 0 || c < 64 || c >= 96) return false;
        const int L = c - 64; u.nt = 32;
        if (L < 16) { const int pm = L & 7, pn = L >> 3; u.A = (const char*)(ws + WS_MN) + (size_t)pm * 256 * 2048 * 2; u.B0 = (const char*)(ws + WS_WKVT) + (size_t)pn * 256 * 2048 * 2; u.r0 = pm * 256; u.c0 = pn * 256; u.aux = 0; }
        else { const int L2 = L - 16, pm = L2 & 1, pn = L2 >> 1; u.A = (const char*)(ws + WS_WKVT) + (size_t)(512 + pm * 256) * 2048 * 2; u.B0 = (const char*)(ws + WS_MN) + (size_t)pn * 256 * 2048 * 2; u.r0 = pm * 256; u.c0 = pn * 256; u.aux = 1; }
        return true;
    }
};
struct EpiKV {
    static __device__ __forceinline__ bool keep_acc(const Unit&) { return false; }
    bf16_t* KM; bf16_t* VT;
    __device__ __forceinline__ void operator()(const f32x4 (&acc)[2][2][4][2], const Unit& u, int wr, int wc, int fr, int fq) const {
        pg8::EpiBf16 E{u.aux ? VT : KM, u.aux ? 2048 : 512, nullptr, 1.f}; E(acc, u, wr, wc, fr, fq);
    }
};
struct SchedTiles {
    const char* A; const char* B; int lda, ldb, nM, nN, nt, G, c, ibeg, iend, esz;
    __device__ __forceinline__ bool next(int i0, Unit& u) const {
        const int i = i0 + ibeg; if (i >= iend) return false;
        const int L = i * G + c; if (L >= nM * nN) return false;
        int pm, pn; pg8::tile_order(L, nM, nN, pm, pn);
        u.A = A + (size_t)pm * 256 * lda * esz; u.B0 = B + (size_t)pn * 256 * ldb * esz; u.nt = nt; u.r0 = pm * 256; u.c0 = pn * 256; u.aux = 0; return true;
    }
};
struct SchedMix {
    unsigned char* ws; int G, c, ibeg, iend;
    __device__ __forceinline__ bool next(int i0, Unit& u) const {
        const int i = i0 + ibeg; if (i >= iend) return false;
        const int L = i * G + c; if (L >= 384) return false;
        u.nt = 32;
        int pm, pi; pg8::tile_order(L, 64, 6, pm, pi); const int pn = pi < 4 ? pi : pi + 2;
        u.A = (const char*)(ws + WS_XN) + (size_t)pm * 256 * 4096; u.B0 = (const char*)(ws + WS_WINT) + (size_t)pn * 256 * 4096; u.r0 = pm * 256; u.c0 = pn * 256; u.aux = 0;
        return true;
    }
};
struct SchedSwap {
    unsigned char* ws; int c, i1;
    __device__ __forceinline__ bool next(int i, Unit& u) const {
        if (i > 0 || !i1 || c < 128 || c >= 256) return false;
        const int U = c - 128, pm = U & 1, pn = U >> 1, b = pn >> 3, st = pn & 7;
        u.A = (const char*)(ws + WS_WINT) + (size_t)(1024 + pm * 256) * 4096; u.B0 = (const char*)(ws + WS_XN) + (size_t)(b * SEQ + st * 128) * 4096; u.nt = 32;
        u.r0 = b * 512 + pm * 256; u.c0 = st * 128; u.aux = 1; return true;
    }
};
struct SchedDFT {
    unsigned char* ws; int c;
    __device__ __forceinline__ bool next(int i, Unit& u) const {
        if (i > 0 || c >= 128) return false;
        const int b = c & 7, j = c >> 3, tab = j & 3, rt = (j >> 2) & 1, pn = j >> 3;
        u.A = (const char*)(ws + WS_TW) + (size_t)(tab * 512 + rt * 256) * 1024 * 2; u.B0 = (const char*)(ws + WS_UT) + (size_t)(((tab >> 1) * NBATCH + b) * 512 + pn * 256) * 1024 * 2; u.nt = 16;
        u.r0 = b * SEQ; u.c0 = (tab & 1) * 512 + pn * 256; u.aux = tab | (rt << 2); return true;
    }
};
struct SchedProj {
    unsigned char* ws; int G, c;
    __device__ __forceinline__ bool next(int i, Unit& u) const {
        const int ti = i / 3, si = i - 3 * ti, rot = 0, s = (si + rot) % 3; const int L = ti * G + c; if (L >= 512) return false;
        int pm, pn; pg8::tile_order(L, 64, 8, pm, pn);
        const char* ab = s == 0 ? (const char*)(ws + WS_ACAT + A_POOL) : (s == 1 ? (const char*)(ws + WS_ACAT + A_PQ) : (const char*)(ws + WS_XN8));
        const char* bb = (const char*)(ws + WS_BCAT) + (s == 0 ? B_WA : (s == 1 ? B_WB : B_PM));
        u.A = ab + (size_t)pm * 256 * CAT_LD * 2; u.B0 = bb + (size_t)pn * 256 * CAT_LD * 2;
        u.nt = s == 2 ? 8 : 16; u.r0 = pm * 256; u.c0 = pn * 256; u.aux = s | (((si + 1 + rot) % 3) << 2) | (si == 2 ? 32 : 0); return true;
    }
};
struct SchedGU {
    unsigned char* ws; int G, c;
    __device__ __forceinline__ bool next(int i, Unit& u) const {
        const int L = i * G + c; if (L >= 2048) return false;
        const int e = L >> 7, j = L & 127, x = j & 7, q = j >> 3, pm = q & 7, pn = 2 * x + (q >> 3);
        u.A = (const char*)(ws + WS_XIN) + (size_t)(e * 8 + pm) * 256 * 2048; u.B0 = (const char*)(ws + WS_WGUT) + ((size_t)e * 4096 + pn * 256) * 2048;
        u.nt = 16; u.r0 = (e * 8 + pm) * 256; u.c0 = pn * 128; u.aux = 0; return true;
    }
};
struct SchedDown {
    unsigned char* ws; int G, c;
    __device__ __forceinline__ bool next(int i, Unit& u) const {
        const int L = i * G + c; if (L >= 1024) return false;
        const int rd = L >> 8, cc = L & 255, x = cc & 7, q = cc >> 3, e = 4 * rd + (q & 3), pm = 2 * (x & 3) + ((q >> 2) & 1), pn = 4 * (x >> 2) + (q >> 3);
        u.A = (const char*)(ws + WS_HID) + (size_t)(e * 8 + pm) * 256 * 2048; u.B0 = (const char*)(ws + WS_WDT) + ((size_t)e * 2048 + pn * 256) * 2048;
        u.nt = 16; u.r0 = (e * 8 + pm) * 256; u.c0 = pn * 256; u.aux = 0; return true;
    }
};

struct ConvHook { const Args& a; int c, G, wave, u0, u1, down;
    __device__ __forceinline__ void operator()(int ui) const { const int nxt = ui + 1; int part = -1; if (nxt == u0) part = 0; if (nxt == u1) part = 1;
        if (part >= 0) convert_experts(a, c, G, wave, opaque_lane(), part, 2, down); } };

__global__ void __launch_bounds__(NTHR, 2) fwd_kernel(Args a) {
    extern __shared__ __attribute__((aligned(16))) unsigned char lds_raw[];
    LAS unsigned char* lds = (LAS unsigned char*)lds_raw;
    const int wave = __builtin_amdgcn_readfirstlane((int)threadIdx.x >> 6);
#define lane opaque_lane()
#define tid (wave * 64 + opaque_lane())
    const int G = gridDim.x, c = blockIdx.x;
    const int vcu = (G % 8 == 0) ? (c % 8) * (G / 8) + c / 8 : c;
    const int gw = vcu * NWAVES + wave, NGW = G * NWAVES;
    unsigned char* ws = a.ws;
    const int lo = a.ph_lo, hi = a.ph_hi;
#define IN(k) (lo <= (k) && (k) < hi)
    volatile LAS unsigned* bst = (volatile LAS unsigned*)(lds + 143360);
    if (tid < 64) ((LAS unsigned*)(lds + 143360))[tid] = 0u;
    if (tid < 256) ((LAS unsigned*)(lds + STAMP_BASE))[tid] = 0u;
    __syncthreads();
    XcdBarrier gbar = xcd_barrier_post((unsigned*)(ws + WS_CTL) + 4096, bst, wave);
#define SEAM(k) do { if (IN(k) && IN((k) + 1)) { xcd_barrier(gbar); } STAMPN(k, 6); if (PROBE_PHASE == (k)) { STAMP(7); if (tid == 0) STAMP_EN() = 0u; } if (PROBE_PHASE == (k) + 1 && tid == 0) STAMP_EN() = 1u; } while (0)

#define PH0 if (IN(0)) { phase0(a, lds, gw, NGW, wave, lane); __syncthreads(); }
    PH0
    if (PROBE_REP == 0) { xcd_barrier(gbar); PH0 }
    SEAM(0);
    if (PROBE_PHASE == 2 && tid == 0) STAMP_EN() = 1u;
#define PH2 \
    if (!DBG_P5_FROM_XN && IN(2)) { \
          \
          \
        { SchedFold S{ws, c}; pg8::EpiBf16 E{(bf16_t*)(ws + WS_BCAT), CAT_LD, nullptr, 1.f}; pg8::gemm_phase<false, (PROBE_PHASE == 2)>(wave, lds, 2048, 2048, S, E); } \
        { SchedKV S{ws, c}; EpiKV E{(bf16_t*)(ws + WS_KMEM), (bf16_t*)(ws + WS_VT)}; pg8::gemm_phase<false, (PROBE_PHASE == 2)>(wave, lds, 4096, 4096, S, E); } \
          \
          \
        const int grp = (c >> 3) & 3, ms = grp < 3 ? grp : 2, ga = grp == 3 ? 1 : 0, gb = grp == 3 ? 5 : grp + 2; \
        pg8::EpiZ EZ{(bf16_t*)(ws + WS_ZM), (bf16_t*)(ws + WS_UT)}; pg8::EpiGates8 E8{ws + WS_G, 1.0f / (SC_H8 * SC_W8)}; \
        { SchedMix S{ws, G, c, 0, ms}; pg8::gemm_phase<false, (PROBE_PHASE == 2)>(wave, lds, 4096, 4096, S, EZ); } \
        if (grp < 3) convert_experts(a, c, G, wave, lane, 0, 2); \
        { SchedMix S{ws, G, c, ms, 2}; pg8::gemm_phase<false, (PROBE_PHASE == 2)>(wave, lds, 4096, 4096, S, EZ); } \
        { SchedSwap S{ws, c, 1}; pg8::gemm_phase<false, (PROBE_PHASE == 2)>(wave, lds, 4096, 4096, S, EZ, 1024); } \
        { SchedTiles S{(const char*)(ws + WS_XN8), (const char*)(ws + WS_WIN8), 2048, 2048, 64, 24, 16, G, c, 0, 1 << 20, 1}; ConvHook CH{a, c, G, wave, grp == 3 ? ga : -1, gb, 0}; \
          pg8::gemm_phase<true, (PROBE_PHASE == 2)>(wave, lds, 2048, 2048, S, E8, pg8::HALF, CH); } \
    }
    PH2
    if (PROBE_REP == 2) { xcd_barrier(gbar); PH2 }
    SEAM(2);
#define PH3 \
    if (!DBG_P5_FROM_XN && IN(3)) { \
          \
        STAMPN(3, 0); { SchedDFT S{ws, c}; pg8::EpiDFT E{(bf16_t*)(ws + WS_ACAT + A_PQ)}; pg8::gemm_phase<false, (PROBE_PHASE == 3)>(wave, lds, 2048, 2048, S, E); } STAMPN(3, 1); \
        if (c >= 128 && c < 256) { const int b = c & 7, j = ((c >> 3) - 16) * 2; attn_unit(a, lds, b, j & 3, j >> 2, wave, lane, tid); int j2 = j + 1; asm volatile("" : "+s"(j2) :: "memory"); attn_unit(a, lds, b, j2 & 3, j2 >> 2, wave, lane, tid); STAMPN(3, 2); \
            dft_nyquist_rows(a, (c - 128) * NWAVES + wave, 128 * NWAVES, lane); } \
        if (c < 256) pool_pass(a, (c >> 7) * 2048 + (c & 127) * NWAVES + wave, (c >> 7) * 2048 + 2048, 128 * NWAVES, lane); STAMPN(3, 3); \
    }
    PH3
    if (PROBE_REP == 3) { xcd_barrier(gbar); PH3 }
    SEAM(3);
#define PH4 \
    if (!DBG_P5_FROM_XN && IN(4)) { SchedProj S{ws, G, c}; pg8::EpiGate E{(bf16_t*)(ws + WS_MG), ws + WS_G}; pg8::gemm_phase<false, (PROBE_PHASE == 4)>(wave, lds, 2 * CAT_LD, 2 * CAT_LD, S, E); }
    PH4
    if (PROBE_REP == 4) { xcd_barrier(gbar); PH4 }
    SEAM(4);
#define PH5 \
    if (IN(5)) { \
        SchedTiles S{(const char*)(ws + (DBG_P5_FROM_XN ? WS_XN : WS_MG)), (const char*)(ws + WS_WOT), 2048, 2048, 64, 8, 32, G, c, 0, 1 << 20, 2}; \
        pg8::EpiResid E{(const bf16_t*)(ws + WS_XN), (const float*)(ws + WS_RMS), a.norm_mix_g, (bf16_t*)(ws + WS_X1B)}; pg8::gemm_phase<false, (PROBE_PHASE == 5)>(wave, lds, 4096, 4096, S, E); \
    }
    PH5
    if (PROBE_REP == 5) { xcd_barrier(gbar); PH5 }
    SEAM(5);
#define PH6 \
    if (!DBG_SKIP_MOE && IN(6)) { STAMPN(6, 0); router_phase(a, lds, vcu, G, wave, lane, tid); __syncthreads(); STAMPN(6, 1); }
    PH6
    if (PROBE_REP == 6) { xcd_barrier(gbar); PH6 }
    SEAM(6);
#define PH7 \
    if (!DBG_SKIP_MOE && IN(7)) { STAMPN(7, 0); topk_phase(a, lds, c, wave, lane, tid); STAMPN(7, 1); }
    PH7
    if (PROBE_REP == 7) { xcd_barrier(gbar); PH7 }
    SEAM(7);
#define PH8 \
    if (!DBG_SKIP_MOE && IN(8)) { SchedGU S{ws, G, c}; pg8::EpiSwiGLU8 E{(unsigned char*)(ws + WS_HID), 1.0f / (SC_H8 * SC_W8)}; const int g8 = (c >> 3) & 3; ConvHook CH8{a, c, G, wave, g8 + 1, g8 + 4, 1};         \
        pg8::gemm_phase<true, (PROBE_PHASE == 8)>(wave, lds, 2048, 2048, S, E, pg8::HALF, CH8); }
    PH8
    if (PROBE_REP == 8) { xcd_barrier(gbar); PH8 }
    SEAM(8);
#define PH9 \
    if (!DBG_SKIP_MOE && IN(9)) { SchedDown S{ws, G, c}; pg8::EpiFp8 E{ws + WS_Y, 2048, nullptr, SC_Y8 / (SC_HID8 * SC_W8)}; pg8::gemm_phase<true, (PROBE_PHASE == 9)>(wave, lds, 2048, 2048, S, E); }
    PH9
    if (PROBE_REP == 9) { xcd_barrier(gbar); PH9 }
    SEAM(9);
    STAMPN(10, 0); if (IN(10)) combine_phase(a, gw, NGW, lane); STAMPN(10, 1);
    if (PROBE_A >= 0 && blockIdx.x == PROBE_BLK && tid == 0) { const volatile LAS unsigned long long* st = (const volatile LAS unsigned long long*)(unsigned)STAMP_BASE;
        const unsigned long long d = (st[PROBE_A] - st[PROBE_B]) * PROBE_SCALE, t0 = __builtin_amdgcn_s_memrealtime();
        if (d < 100000000ull) while (__builtin_amdgcn_s_memrealtime() - t0 < d) __builtin_amdgcn_s_sleep(8); }
#undef IN
#undef SEAM
#undef lane
#undef tid
}

extern "C" void kernel_launch(void* const* d_in, const int* in_sizes, int n_in, void* d_out, int out_size, void* d_ws, size_t ws_size, hipStream_t stream) {
    static int grid = 0;
    if (grid == 0) {
        if (n_in != 19 || in_sizes[0] != T * DM || out_size != T * DM || ws_size < WS_END) {
            fprintf(stderr, "kernel_launch: unexpected shapes (n_in %d, in0 %d, out %d, ws %zu, need %zu); nothing launched\n", n_in, n_in > 0 ? in_sizes[0] : -1, out_size, ws_size, (size_t)WS_END); grid = -1; return; }
        int dev = 0, cus = 0, per_cu = 0;
        if (hipGetDevice(&dev) != hipSuccess || hipDeviceGetAttribute(&cus, hipDeviceAttributeMultiprocessorCount, dev) != hipSuccess) { fprintf(stderr, "kernel_launch: device query failed\n"); grid = -1; return; }
        if (hipFuncSetAttribute((const void*)fwd_kernel, hipFuncAttributeMaxDynamicSharedMemorySize, LDS_BYTES) != hipSuccess) { fprintf(stderr, "kernel_launch: hipFuncSetAttribute failed\n"); grid = -1; return; }
        if (hipOccupancyMaxActiveBlocksPerMultiprocessor(&per_cu, (const void*)fwd_kernel, NTHR, LDS_BYTES) != hipSuccess || per_cu < 1) { fprintf(stderr, "kernel_launch: occupancy query says %d blocks per CU\n", per_cu); (void)hipGetLastError(); grid = -1; return; }
        grid = cus;
        if (grid < 256) fprintf(stderr, "kernel_launch: note: %d CUs (< 256): some single-round phases assume 256 workgroups\n", grid);
    }
    if (grid < 0) return;
    Args a{};
    a.x = (const float*)d_in[0]; a.mem = (const float*)d_in[1]; a.norm_mix_g = (const float*)d_in[2]; a.norm_mem_g = (const float*)d_in[3]; a.w_in = (const float*)d_in[4];
    a.pool_w = (const float*)d_in[5]; a.pool_scale = (const float*)d_in[6]; a.fourier_w = (const float*)d_in[7]; a.w_kv = (const float*)d_in[8]; a.proj_pool = (const float*)d_in[9];
    a.proj_fourier = (const float*)d_in[10]; a.proj_mem = (const float*)d_in[11]; a.w_out = (const float*)d_in[12]; a.norm_ffn_g = (const float*)d_in[13]; a.w_router = (const float*)d_in[14];
    a.w_gate = (const float*)d_in[15]; a.w_up = (const float*)d_in[16]; a.w_down = (const float*)d_in[17]; a.norm_final_g = (const float*)d_in[18];
    a.out = (float*)d_out; a.ws = (unsigned char*)d_ws;
#if MK_MULTI_LAUNCH
    for (int p = 0; p < NPH; ++p) { a.ph_lo = p; a.ph_hi = p + 1; hipLaunchKernelGGL(fwd_kernel, dim3(grid), dim3(NTHR), LDS_BYTES, stream, a); }
#else
    a.ph_lo = 0; a.ph_hi = NPH;
    if (hipMemsetAsync((char*)d_ws + WS_CTL, 0, 65536, stream) != hipSuccess) { fprintf(stderr, "kernel_launch: hipMemsetAsync failed\n"); return; }
    void* args[] = {&a};
    hipError_t e = hipLaunchCooperativeKernel((const void*)fwd_kernel, dim3(grid), dim3(NTHR), args, LDS_BYTES, stream);
    if (e != hipSuccess) fprintf(stderr, "kernel_launch: cooperative launch failed: %s (grid %d)\n", hipGetErrorString(e), grid);
#endif
}
```
